# Optimizing an MI355X kernel written in HIP

```python
import jax
import jax.numpy as jnp
from jax import lax
import numpy as np

D_MODEL = 1024
BATCH = 8
SEQ = 4096
DEPTH = 2

GRID_W = 64
CTX_LEN = 256
NORM_EPS = 1e-6
ROPE_BASE = 10000.0
Q_BLOCK = 128

MLA_HEADS = 8
MLA_NOPE = 64
MLA_ROPE = 32
MLA_QK = MLA_NOPE + MLA_ROPE
MLA_V = 64
MLA_Q_RANK = 384
MLA_KV_RANK = 256

RET_HEADS = 4
RET_DK = 64
RET_DV = 64
RET_CHUNK = 128
RET_EPS = 1e-5

RWKV_HEADS = 4
RWKV_N = 64
RWKV_DECAY_LORA = 64
RWKV_A_LORA = 64
RWKV_G_LORA = 128
RWKV_EPS = 64e-5
RWKV_DECAY_SCALE = 0.606531

N_EXPERTS = 16
EC_FACTOR = 2
EXPERT_FF = 1024

MLA_W = MLA_HEADS * MLA_V
RET_W = RET_HEADS * RET_DV
RWKV_W = RWKV_HEADS * RWKV_N
MIX_W = MLA_W + RET_W + RWKV_W

MLA_COLS = MLA_Q_RANK + MLA_KV_RANK + MLA_ROPE
RET_COLS = 2 * RET_HEADS * RET_DK + 2 * RET_W
RWKV_COLS = 3 * RWKV_W + 2 * RWKV_DECAY_LORA + RWKV_A_LORA + RWKV_G_LORA
IN_COLS = MLA_COLS + RET_COLS + RWKV_COLS
RWKV_SPLITS = [RWKV_W, 2 * RWKV_W, 3 * RWKV_W, 3 * RWKV_W + RWKV_DECAY_LORA,
               3 * RWKV_W + 2 * RWKV_DECAY_LORA, 3 * RWKV_W + 2 * RWKV_DECAY_LORA + RWKV_A_LORA]

kernel_name = 'hybrid_mla_retention_rwkv7_ecmoe_dit'


def rms_norm(x, w, eps=NORM_EPS):
    xf = x.astype(jnp.float32)
    y = xf * lax.rsqrt(jnp.mean(xf * xf, axis=-1, keepdims=True) + eps)
    return (y * w.astype(jnp.float32)).astype(x.dtype)


def head_layer_norm(y, w, n_heads, eps):
    shp = y.shape
    yf = y.astype(jnp.float32).reshape(shp[:-1] + (n_heads, shp[-1] // n_heads))
    mu = jnp.mean(yf, axis=-1, keepdims=True)
    var = jnp.mean(jnp.square(yf - mu), axis=-1, keepdims=True)
    yf = ((yf - mu) * lax.rsqrt(var + eps)).reshape(shp)
    return (yf * w.astype(jnp.float32)).astype(y.dtype)


def rotate_half_pairs(x, cos, sin):
    p = x.shape[-1] // 2
    c = cos[:, None, :].astype(x.dtype)
    s = sin[:, None, :].astype(x.dtype)
    x1, x2 = x[..., :p], x[..., p:]
    return jnp.concatenate([x1 * c - x2 * s, x1 * s + x2 * c], axis=-1)


def axial_rope_tables(rows):
    row = jnp.repeat(jnp.arange(rows, dtype=jnp.float32), GRID_W)
    col = jnp.tile(jnp.arange(GRID_W, dtype=jnp.float32), rows)
    n_freq = MLA_ROPE // 4
    inv = ROPE_BASE ** (-jnp.arange(n_freq, dtype=jnp.float32) / n_freq)
    ang = jnp.concatenate([row[:, None] * inv, col[:, None] * inv], axis=-1)
    return jnp.cos(ang), jnp.sin(ang)


def seq_rope_tables(pos):
    inv = ROPE_BASE ** (-jnp.linspace(0.0, 1.0, RET_DK // 2, dtype=jnp.float32))
    ang = pos.astype(jnp.float32)[:, None] * inv
    return jnp.cos(ang), jnp.sin(ang)


def token_shift(p, mu):
    zero = jnp.zeros_like(p[:, :1])
    prev = jnp.concatenate([zero, p[:, :-1]], axis=1)
    nxt = jnp.concatenate([p[:, 1:], zero], axis=1)
    return p + (0.5 * (prev + nxt) - p) * mu.astype(p.dtype)


def mla_project(cq, ckv, k_rope, q_norm_w, w_uq, kv_norm_w, w_ukv, q_gain, k_gain, rope):
    b, t, _ = cq.shape
    q = (rms_norm(cq, q_norm_w) @ w_uq).reshape(b, t, MLA_HEADS, MLA_QK)
    kv = (rms_norm(ckv, kv_norm_w) @ w_ukv).reshape(b, t, MLA_HEADS, MLA_NOPE + MLA_V)
    k_nope, v = kv[..., :MLA_NOPE], kv[..., MLA_NOPE:]
    k_r = jnp.broadcast_to(k_rope[:, :, None, :], (b, t, MLA_HEADS, MLA_ROPE))
    k = jnp.concatenate([k_nope, k_r], axis=-1)
    q = rms_norm(q, q_gain)
    k = rms_norm(k, k_gain)
    if rope is not None:
        cos, sin = rope
        q = jnp.concatenate([q[..., :MLA_NOPE], rotate_half_pairs(q[..., MLA_NOPE:], cos, sin)], axis=-1)
        k = jnp.concatenate([k[..., :MLA_NOPE], rotate_half_pairs(k[..., MLA_NOPE:], cos, sin)], axis=-1)
    return q, k, v


def attend_blocks(q, k, v):
    b, t, h, dq = q.shape
    qb = q.reshape(b, t // Q_BLOCK, Q_BLOCK, h, dq).transpose(1, 0, 2, 3, 4)
    scale = dq ** -0.5

    def one(qblk):
        s = jnp.einsum('bqhd,bkhd->bhqk', qblk, k).astype(jnp.float32) * scale
        pr = jax.nn.softmax(s, axis=-1).astype(v.dtype)
        return jnp.einsum('bhqk,bkhd->bqhd', pr, v)

    o = lax.map(one, qb)
    return o.transpose(1, 0, 2, 3, 4).reshape(b, t, h * v.shape[-1])


def retention_scan(q, k, v, log_g, r0):
    b, h, t, _ = q.shape
    n = t // RET_CHUNK

    def chunks(a):
        return a.reshape(b, h, n, RET_CHUNK, a.shape[-1]).transpose(2, 0, 1, 3, 4)

    i = jnp.arange(RET_CHUNK, dtype=jnp.float32)
    diff = i[:, None] - i[None, :]
    dmat = jnp.where(diff >= 0, jnp.exp(log_g[:, None, None] * jnp.maximum(diff, 0.0)), 0.0)
    xi = jnp.exp(log_g[:, None] * (i + 1.0))[..., None]
    zeta = jnp.exp(log_g[:, None] * (RET_CHUNK - 1.0 - i))[..., None]
    g_chunk = jnp.exp(log_g * RET_CHUNK)[:, None, None]

    def step(r, blk):
        qc, kc, vc = blk
        att = jnp.einsum('bhid,bhjd->bhij', qc, kc) * dmat
        o = jnp.einsum('bhij,bhjv->bhiv', att, vc) + jnp.einsum('bhid,bhdv->bhiv', qc, r) * xi
        r = g_chunk * r + jnp.einsum('bhjd,bhjv->bhdv', kc * zeta, vc)
        return r, o

    r, o = lax.scan(step, r0, (chunks(q), chunks(k), chunks(v)))
    return o.transpose(1, 2, 0, 3, 4).reshape(b, h, t, -1), r


def retention_prep(p, rope):
    q, k, v, g = jnp.split(p, [RET_HEADS * RET_DK, 2 * RET_HEADS * RET_DK,
                               2 * RET_HEADS * RET_DK + RET_W], axis=-1)
    b, t, _ = q.shape
    cos, sin = rope
    q = rotate_half_pairs(q.reshape(b, t, RET_HEADS, RET_DK), cos, sin)
    k = rotate_half_pairs(k.reshape(b, t, RET_HEADS, RET_DK), cos, sin) * (RET_DK ** -0.5)
    v = v.reshape(b, t, RET_HEADS, RET_DV)
    heads = lambda a: jnp.transpose(a, (0, 2, 1, 3)).astype(jnp.float32)
    return heads(q), heads(k), heads(v), g


def retention_mixer(p_lat, p_ctx, need_ctx, decay_logits, gn_w, rope_lat, rope_ctx):
    ql, kl, vl, gl = retention_prep(p_lat, rope_lat)
    qc, kc, vc, gc = retention_prep(p_ctx, rope_ctx)
    log_g = jax.nn.log_sigmoid(decay_logits.astype(jnp.float32))
    r0 = jnp.zeros((ql.shape[0], RET_HEADS, RET_DK, RET_DV), jnp.float32)
    flip = lambda a: jnp.flip(a, axis=2)
    oc_f, rc_f = retention_scan(qc, kc, vc, log_g[0], r0)
    ol_f, _ = retention_scan(ql, kl, vl, log_g[0], rc_f)
    oc_b, rc_b = retention_scan(flip(qc), flip(kc), flip(vc), log_g[1], r0)
    ol_b, _ = retention_scan(flip(ql), flip(kl), flip(vl), log_g[1], rc_b)

    def finish(o, g):
        b, h, t, dv = o.shape
        o = jnp.transpose(o, (0, 2, 1, 3)).reshape(b, t, h * dv).astype(g.dtype)
        return head_layer_norm(o, gn_w, RET_HEADS, RET_EPS) * jax.nn.silu(g)

    out_lat = finish(ol_f + flip(ol_b), gl)
    out_ctx = finish(oc_f + flip(oc_b), gc) if need_ctx else None
    return out_lat, out_ctx


def rwkv_features(p, mu, w0, w2, a0, a2, g2, k_k, k_a):
    f32 = jnp.float32
    p = token_shift(p, mu)
    r, k, v, wdf, wdb, ad, gd = jnp.split(p, RWKV_SPLITS, axis=-1)
    b, t, _ = r.shape
    heads = lambda z: z.reshape(b, t, RWKV_HEADS, RWKV_N)
    w0f = w0.astype(f32)
    w2f = w2.astype(f32)
    w_fwd = jnp.exp(-RWKV_DECAY_SCALE * jax.nn.sigmoid(w0f[0] + jnp.tanh(wdf.astype(f32)) @ w2f[0]))
    w_bwd = jnp.exp(-RWKV_DECAY_SCALE * jax.nn.sigmoid(w0f[1] + jnp.tanh(wdb.astype(f32)) @ w2f[1]))
    a = jax.nn.sigmoid(a0.astype(f32) + ad.astype(f32) @ a2.astype(f32))
    g = jax.nn.sigmoid(gd) @ g2
    kf = k.astype(f32)
    kk = heads(kf * k_k.astype(f32))
    kk = kk / jnp.maximum(jnp.sqrt(jnp.sum(kk * kk, axis=-1, keepdims=True)), 1e-12)
    kf = kf * (1.0 + (a - 1.0) * k_a.astype(f32))
    return (heads(r.astype(f32)), heads(w_fwd), heads(w_bwd), heads(kf), heads(v.astype(f32)), kk, heads(a), g)


def rwkv_scan(r, w, k, v, kk, a, s0):
    xs = tuple(jnp.moveaxis(z, 1, 0) for z in (r, w, k, v, kk, a))

    def step(s, inp):
        rt, wt, kt, vt, kkt, at = inp
        skk = jnp.einsum('bhvk,bhk->bhv', s, kkt)
        s = s * wt[:, :, None, :] - skk[..., None] * (kkt * at)[:, :, None, :] + vt[..., None] * kt[:, :, None, :]
        return s, jnp.einsum('bhvk,bhk->bhv', s, rt)

    s, y = lax.scan(step, s0, xs)
    return jnp.moveaxis(y, 0, 1), s


def rwkv_mixer(p_lat, p_ctx, need_ctx, mu, w0, w2, a0, a2, g2, k_k, k_a, r_k, ln_w):
    rl, wfl, wbl, kl, vl, kkl, al, gl = rwkv_features(p_lat, mu, w0, w2, a0, a2, g2, k_k, k_a)
    rc, wfc, wbc, kc, vc, kkc, ac, gc = rwkv_features(p_ctx, mu, w0, w2, a0, a2, g2, k_k, k_a)
    s0 = jnp.zeros((rl.shape[0], RWKV_HEADS, RWKV_N, RWKV_N), jnp.float32)
    flip = lambda z: jnp.flip(z, axis=1)
    yc_f, sc_f = rwkv_scan(rc, wfc, kc, vc, kkc, ac, s0)
    yl_f, _ = rwkv_scan(rl, wfl, kl, vl, kkl, al, sc_f)
    yc_b, sc_b = rwkv_scan(flip(rc), flip(wbc), flip(kc), flip(vc), flip(kkc), flip(ac), s0)
    yl_b, _ = rwkv_scan(flip(rl), flip(wbl), flip(kl), flip(vl), flip(kkl), flip(al), sc_b)

    def finish(y, r, k, v, g):
        b, t = y.shape[:2]
        o = head_layer_norm(y.reshape(b, t, RWKV_W), ln_w, RWKV_HEADS, RWKV_EPS)
        bonus = (jnp.sum(r * k * r_k.astype(jnp.float32), axis=-1, keepdims=True) * v).reshape(b, t, RWKV_W)
        return ((o + bonus) * g.astype(jnp.float32)).astype(g.dtype)

    out_lat = finish(yl_f + flip(yl_b), rl, kl, vl, gl)
    out_ctx = finish(yc_f + flip(yc_b), rc, kc, vc, gc) if need_ctx else None
    return out_lat, out_ctx


def hybrid_mixer(u, uc, rope_axial, rope_ret_lat, rope_ret_ctx, need_ctx, w_in,
                 mla_q_norm_w, mla_w_uq, mla_kv_norm_w, mla_w_ukv, mla_q_gain, mla_k_gain,
                 ret_decay, ret_gn_w, rwkv_mu, rwkv_w0, rwkv_w2, rwkv_a0, rwkv_a2, rwkv_g2,
                 rwkv_k_k, rwkv_k_a, rwkv_r_k, rwkv_ln_w, w_out):
    b, t, _ = u.shape
    p = u @ w_in
    pc = uc @ w_in

    def mla_parts(z):
        return jnp.split(z[..., :MLA_COLS], [MLA_Q_RANK, MLA_Q_RANK + MLA_KV_RANK], axis=-1)

    ql, kl, vl = mla_project(*mla_parts(p), mla_q_norm_w, mla_w_uq, mla_kv_norm_w, mla_w_ukv,
                             mla_q_gain, mla_k_gain, rope_axial)
    qc, kc, vc = mla_project(*mla_parts(pc), mla_q_norm_w, mla_w_uq, mla_kv_norm_w, mla_w_ukv,
                             mla_q_gain, mla_k_gain, None)
    mla_lat = attend_blocks(ql, jnp.concatenate([kc, kl], axis=1), jnp.concatenate([vc, vl], axis=1))

    ret_lat, ret_ctx = retention_mixer(p[..., MLA_COLS:MLA_COLS + RET_COLS], pc[..., MLA_COLS:MLA_COLS + RET_COLS],
                                       need_ctx, ret_decay, ret_gn_w, rope_ret_lat, rope_ret_ctx)
    rwkv_lat, rwkv_ctx = rwkv_mixer(p[..., MLA_COLS + RET_COLS:], pc[..., MLA_COLS + RET_COLS:], need_ctx,
                                    rwkv_mu, rwkv_w0, rwkv_w2, rwkv_a0, rwkv_a2, rwkv_g2,
                                    rwkv_k_k, rwkv_k_a, rwkv_r_k, rwkv_ln_w)
    y = jnp.concatenate([mla_lat, ret_lat.astype(mla_lat.dtype), rwkv_lat.astype(mla_lat.dtype)], axis=-1) @ w_out
    if not need_ctx:
        return y, None
    mla_ctx = attend_blocks(qc, kc, vc)
    yc = jnp.concatenate([mla_ctx, ret_ctx.astype(mla_ctx.dtype), rwkv_ctx.astype(mla_ctx.dtype)], axis=-1) @ w_out
    return y, yc


def expert_choice_ffn(h, router_w, w_gate, w_up, w_down):
    b, n, d = h.shape
    cap = max(1, EC_FACTOR * n // N_EXPERTS)
    aff = jax.nn.softmax((h @ router_w).astype(jnp.float32), axis=-1)
    gate, idx = lax.top_k(jnp.swapaxes(aff, 1, 2), cap)
    xe = jax.vmap(lambda hb, ib: hb[ib])(h, idx)
    hid = jax.nn.silu(jnp.einsum('becd,edf->becf', xe, w_gate)) * jnp.einsum('becd,edf->becf', xe, w_up)
    ye = jnp.einsum('becf,efd->becd', hid, w_down) * gate[..., None].astype(h.dtype)
    scatter = lambda yb, ib: jnp.zeros((n, d), yb.dtype).at[ib.reshape(-1)].add(yb.reshape(-1, d))
    return jax.vmap(scatter)(ye, idx)


def setup_inputs(seed: int = 0) -> dict:
    key = jax.random.key(seed)
    ks = jax.random.split(key, 32)
    f32 = jnp.float32
    nrm = lambda k, shape, s: jax.random.normal(k, shape, f32) * s
    L = DEPTH
    ret_logit = np.log(2.0 ** (5.0 + np.arange(RET_HEADS)) - 1.0).astype(np.float32)
    return {
        'x': nrm(ks[0], (BATCH, SEQ, D_MODEL), 1.0),
        'c': nrm(ks[1], (BATCH, D_MODEL), 1.0),
        'ctx': nrm(ks[2], (BATCH, CTX_LEN, D_MODEL), 1.0),
        'c_ctx': nrm(ks[3], (D_MODEL,), 1.0),
        'mod_w': nrm(ks[4], (L, D_MODEL, 6 * D_MODEL), 0.5 * D_MODEL ** -0.5),
        'mod_b': nrm(ks[5], (L, 6 * D_MODEL), 0.02),
        'norm1_w': 1.0 + nrm(ks[6], (L, D_MODEL), 0.02),
        'norm2_w': 1.0 + nrm(ks[7], (L, D_MODEL), 0.02),
        'w_in': nrm(ks[8], (L, D_MODEL, IN_COLS), D_MODEL ** -0.5),
        'mla_q_norm_w': 1.0 + nrm(ks[9], (L, MLA_Q_RANK), 0.02),
        'mla_w_uq': nrm(ks[10], (L, MLA_Q_RANK, MLA_HEADS * MLA_QK), MLA_Q_RANK ** -0.5),
        'mla_kv_norm_w': 1.0 + nrm(ks[11], (L, MLA_KV_RANK), 0.02),
        'mla_w_ukv': nrm(ks[12], (L, MLA_KV_RANK, MLA_HEADS * (MLA_NOPE + MLA_V)), MLA_KV_RANK ** -0.5),
        'mla_q_gain': 1.0 + nrm(ks[13], (L, MLA_QK), 0.02),
        'mla_k_gain': 1.0 + nrm(ks[14], (L, MLA_QK), 0.02),
        'ret_decay': jnp.asarray(ret_logit)[None, None, :] + nrm(ks[15], (L, 2, RET_HEADS), 0.05),
        'ret_gn_w': 1.0 + nrm(ks[16], (L, RET_W), 0.02),
        'rwkv_mu': jax.random.uniform(ks[17], (L, RWKV_COLS), f32),
        'rwkv_w0': jax.random.uniform(ks[18], (L, 2, RWKV_W), f32, minval=-4.0, maxval=1.0),
        'rwkv_w2': nrm(ks[19], (L, 2, RWKV_DECAY_LORA, RWKV_W), 0.5 * RWKV_DECAY_LORA ** -0.5),
        'rwkv_a0': nrm(ks[20], (L, RWKV_W), 0.5),
        'rwkv_a2': nrm(ks[21], (L, RWKV_A_LORA, RWKV_W), 0.5 * RWKV_A_LORA ** -0.5),
        'rwkv_g2': nrm(ks[22], (L, RWKV_G_LORA, RWKV_W), RWKV_G_LORA ** -0.5),
        'rwkv_k_k': 0.85 + nrm(ks[23], (L, RWKV_W), 0.02),
        'rwkv_k_a': 1.0 + nrm(ks[24], (L, RWKV_W), 0.02),
        'rwkv_r_k': nrm(ks[25], (L, RWKV_HEADS, RWKV_N), 0.1),
        'rwkv_ln_w': 1.0 + nrm(ks[26], (L, RWKV_W), 0.02),
        'w_out': nrm(ks[27], (L, MIX_W, D_MODEL), MIX_W ** -0.5),
        'router_w': nrm(ks[28], (L, D_MODEL, N_EXPERTS), D_MODEL ** -0.5),
        'exp_w_gate': nrm(ks[29], (L, N_EXPERTS, D_MODEL, EXPERT_FF), D_MODEL ** -0.5),
        'exp_w_up': nrm(ks[30], (L, N_EXPERTS, D_MODEL, EXPERT_FF), D_MODEL ** -0.5),
        'exp_w_down': nrm(ks[31], (L, N_EXPERTS, EXPERT_FF, D_MODEL), EXPERT_FF ** -0.5),
    }


def reference(x, c, ctx, c_ctx, mod_w, mod_b, norm1_w, norm2_w, w_in,
              mla_q_norm_w, mla_w_uq, mla_kv_norm_w, mla_w_ukv, mla_q_gain, mla_k_gain,
              ret_decay, ret_gn_w, rwkv_mu, rwkv_w0, rwkv_w2, rwkv_a0, rwkv_a2, rwkv_g2,
              rwkv_k_k, rwkv_k_a, rwkv_r_k, rwkv_ln_w, w_out, router_w,
              exp_w_gate, exp_w_up, exp_w_down):
    n_lat = x.shape[1]
    n_ctx = ctx.shape[1]
    ROWS = n_lat // GRID_W
    rope_axial = axial_rope_tables(ROWS)
    rope_ret_ctx = seq_rope_tables(jnp.arange(n_ctx))
    rope_ret_lat = seq_rope_tables(n_ctx + jnp.arange(n_lat))
    silu_c = jax.nn.silu(c)
    silu_cc = jax.nn.silu(c_ctx)
    xc = ctx
    for l in range(DEPTH):
        need_ctx = l < DEPTH - 1
        mod = (silu_c @ mod_w[l] + mod_b[l])[:, None, :]
        mod_c = (silu_cc @ mod_w[l] + mod_b[l])[None, None, :]
        sh1, sc1, ga1, sh2, sc2, ga2 = jnp.split(mod, 6, axis=-1)
        csh1, csc1, cga1, csh2, csc2, cga2 = jnp.split(mod_c, 6, axis=-1)
        u = rms_norm(x, norm1_w[l]) * (1.0 + sc1) + sh1
        uc = rms_norm(xc, norm1_w[l]) * (1.0 + csc1) + csh1
        y, yc = hybrid_mixer(u, uc, rope_axial, rope_ret_lat, rope_ret_ctx, need_ctx, w_in[l],
                             mla_q_norm_w[l], mla_w_uq[l], mla_kv_norm_w[l], mla_w_ukv[l],
                             mla_q_gain[l], mla_k_gain[l], ret_decay[l], ret_gn_w[l],
                             rwkv_mu[l], rwkv_w0[l], rwkv_w2[l], rwkv_a0[l], rwkv_a2[l], rwkv_g2[l],
                             rwkv_k_k[l], rwkv_k_a[l], rwkv_r_k[l], rwkv_ln_w[l], w_out[l])
        x = x + ga1 * y
        h = rms_norm(x, norm2_w[l]) * (1.0 + sc2) + sh2
        x = x + ga2 * expert_choice_ffn(h, router_w[l], exp_w_gate[l], exp_w_up[l], exp_w_down[l])
        if need_ctx:
            xc = xc + cga1 * yc
            hc = rms_norm(xc, norm2_w[l]) * (1.0 + csc2) + csh2
            xc = xc + cga2 * expert_choice_ffn(hc, router_w[l], exp_w_gate[l], exp_w_up[l], exp_w_down[l])
    return x
```

```cpp
#include <hip/hip_runtime.h>
#include <hip/hip_cooperative_groups.h>
#include <cstdio>
#include <cstdint>
namespace cg = cooperative_groups;

typedef unsigned short bf16_t;
typedef short bf16x8 __attribute__((ext_vector_type(8)));
typedef short s16x4 __attribute__((ext_vector_type(4)));
typedef float f32x4 __attribute__((ext_vector_type(4)));
typedef float f32x2 __attribute__((ext_vector_type(2)));
typedef float f32x16 __attribute__((ext_vector_type(16)));
typedef unsigned u32x4 __attribute__((ext_vector_type(4)));
typedef unsigned u32x2 __attribute__((ext_vector_type(2)));
#define LAS __attribute__((address_space(3)))
#define DI __device__ __forceinline__

constexpr int DM = 1024, NBATCH = 8, SEQ = 4096, CTXL = 256, SB = 4352, T = 34816;
constexpr int NPC = 2816;
constexpr int INC = 2784;
constexpr int QKVC = 1792;
constexpr int C_KR = 640, C_RQ = 672, C_RK = 928, C_RV = 1184, C_RG = 1440, C_RW = 1696;
constexpr int C_OF = 1696, C_OB = 1952, C_YF = 2208, C_YB = 2464;
constexpr int NE = 16, CAPL = 512, CAPC = 32;
constexpr int XE_LROWS = 65536, XE_ROWS = 65536 + 4096;
constexpr int NTHR = 512;
constexpr int LDS_BYTES = 160 * 1024;

constexpr size_t MiB = 1048576;
constexpr size_t OFF_BAR = 0, OFF_CNT = 32768, OFF_MOD = 1 * MiB, OFF_BONUS = 2 * MiB, OFF_AFFL = 3 * MiB, OFF_AFFC = 5 * MiB,
                 OFF_IDX = 6 * MiB, OFF_GATE = 6 * MiB + 512 * 1024, OFF_INVL = 7 * MiB, OFF_INVC = 9 * MiB, OFF_WSM = 10 * MiB,
                 OFF_XC = 31 * MiB, OFF_ACT = 39 * MiB, OFF_ARENA = 107 * MiB;
constexpr size_t WSM_STRIDE = 11010048, WSM_WIN = 0, WSM_WQKV = 5767168, WSM_WOUT = 8060928, WSM_W2F = 10158080, WSM_W2B = 10190848,
                 WSM_A2 = 10223616, WSM_G2 = 10256384;
constexpr size_t AR_P = 0, AR_QKV = 187 * MiB, AR_KF = 306 * MiB, AR_OPS = 357 * MiB, OPS_STRIDE = 17 * MiB;
constexpr size_t AR_WGU = 0, AR_WD = 64 * MiB, AR_XE = 96 * MiB, AR_HID = 232 * MiB;
constexpr size_t WS_END = OFF_ARENA + 425 * MiB;

struct Params { const float* in[32]; float* out; unsigned char* ws; int G; int pad; };

DI float bf2f(unsigned v) { return __uint_as_float(v << 16); }
DI bf16_t f2bf(float f) { return __builtin_bit_cast(bf16_t, (__bf16)f); }
typedef __bf16 bf16x2n __attribute__((ext_vector_type(2)));
DI unsigned pk2(float lo, float hi) { const f32x2 v = {lo, hi}; return __builtin_bit_cast(unsigned, __builtin_convertvector(v, bf16x2n)); }
DI float lo_f(unsigned w) { return __uint_as_float(w << 16); }
DI float hi_f(unsigned w) { return __uint_as_float(w & 0xffff0000u); }
DI float wave_sum(float v) { for (int o = 32; o >= 1; o >>= 1) v += __shfl_xor(v, o); return v; }
DI float dppf(float x, const int ctrl_sel) { return x; }
template <int CTRL> DI float dpp_mov(float x) { return __builtin_bit_cast(float, __builtin_amdgcn_update_dpp(0, __builtin_bit_cast(int, x), CTRL, 0xf, 0xf, true)); }
DI float row16_sum(float x) { x += dpp_mov<0xB1>(x); x += dpp_mov<0x4E>(x); x += dpp_mov<0x141>(x); x += dpp_mov<0x140>(x); return x; }
DI float sigmoidf_(float x) { return 1.f / (1.f + __expf(-x)); }
DI float siluf_(float x) { return x / (1.f + __expf(-x)); }
DI int tok_b(int tok) { return tok / SB; }

namespace pg8 {
constexpr int BM = 256, BK = 64, HALF = 128, HTB = HALF * BK * 2, STAGE_BYTES = 8 * HTB, NXCD = 8, WGM = 8;
DI int lds_byte(int r, int c) { const int st = (r >> 4) * 2 + (c >> 5), rr = r & 15, cc = c & 31, ob = rr * 64 + cc * 2; return st * 1024 + (ob ^ (((ob >> 9) & 1) << 5)); }
DI void stage_rc(int b, int& R, int& C) { const int st = b / 1024, sb = b % 1024, swz = sb ^ (((sb >> 9) & 1) << 5); R = (st >> 1) * 16 + swz / 64; C = (st & 1) * 32 + (swz % 64) / 2; }
DI int perm32(int rho) { const int n = rho >> 4, i = rho & 15; return 8 * (i >> 2) + 4 * n + (i & 3); }

struct Unit { int pm, pn, arow, brow; };
struct Gemm { const bf16_t* A; const bf16_t* Bt; int lda, ldb, K; };

struct Sched {
    int nM, nN, nwg, G, c, mode;
    DI void init(int nM_, int nN_, int G_, int c_, int mode_) { nM = nM_; nN = nN_; nwg = nM * nN; G = G_; c = c_; mode = mode_; }
    DI bool next(int i, Unit& u) const {
        const long L = (long)i * G + c; if (L >= nwg) return false;
        int wgid = (int)L; { const int q = nwg / NXCD, r = nwg % NXCD, xcd = wgid % NXCD, off = wgid / NXCD; wgid = (xcd < r ? xcd * (q + 1) : r * (q + 1) + (xcd - r) * q) + off; }
        const int nig = WGM * nN, gid = wgid / nig, fm = gid * WGM, gsz = (nM - fm) < WGM ? (nM - fm) : WGM;
        int pm = fm + ((wgid % nig) % gsz); const int pn = (wgid % nig) / gsz;
        u.pn = pn;
        if (mode == 0) { u.pm = pm; u.arow = pm * 256; u.brow = pn * 256; }
        else if (mode == 1) { pm = pm + pm / 16 + 1; u.pm = pm; u.arow = pm * 256; u.brow = pn * 256; }
        else { const int e = pm < 256 ? (pm >> 4) : (pm - 256); u.pm = pm; u.arow = pm * 256; u.brow = e * (nN * 256) + pn * 256; }
        return true;
    }
};

struct EpiBf16 {
    static constexpr bool PERM = true;
    bf16_t* O; int ldc;
    DI void operator()(const f32x4 (&acc)[2][2][4][2], const Unit& u, int wr, int wc, int fr, int fq) const {
        const int row0 = u.pm * BM + wr * 64 + fr, col0 = u.pn * BM + wc * 32 + 8 * fq;
#pragma unroll
        for (int ai = 0; ai < 2; ++ai)
#pragma unroll
            for (int m = 0; m < 4; ++m) { bf16_t* rowp = O + (size_t)(row0 + ai * HALF + m * 16) * ldc + col0;
#pragma unroll
                for (int bj = 0; bj < 2; ++bj) { const f32x4 v0 = acc[ai][bj][m][0], v1 = acc[ai][bj][m][1];
                    u32x4 w; w.x = pk2(v0[0], v0[1]); w.y = pk2(v0[2], v0[3]); w.z = pk2(v1[0], v1[1]); w.w = pk2(v1[2], v1[3]);
                    *(u32x4*)(rowp + bj * HALF) = w; } }
    }
};
struct EpiGate {
    static constexpr bool PERM = true;
    bf16_t* O; int ldc; const float* gate;
    DI void operator()(const f32x4 (&acc)[2][2][4][2], const Unit& u, int wr, int wc, int fr, int fq) const {
        const int row0 = u.pm * BM + wr * 64 + fr, col0 = u.pn * BM + wc * 32 + 8 * fq;
#pragma unroll
        for (int ai = 0; ai < 2; ++ai)
#pragma unroll
            for (int m = 0; m < 4; ++m) { const int row = row0 + ai * HALF + m * 16; const float g = gate[row]; bf16_t* rowp = O + (size_t)row * ldc + col0;
#pragma unroll
                for (int bj = 0; bj < 2; ++bj) { const f32x4 v0 = acc[ai][bj][m][0] * g, v1 = acc[ai][bj][m][1] * g;
                    u32x4 w; w.x = pk2(v0[0], v0[1]); w.y = pk2(v0[2], v0[3]); w.z = pk2(v1[0], v1[1]); w.w = pk2(v1[2], v1[3]);
                    *(u32x4*)(rowp + bj * HALF) = w; } }
    }
};
struct EpiSwiglu {
    static constexpr bool PERM = true;
    bf16_t* O; int ldc;
    DI void operator()(const f32x4 (&acc)[2][2][4][2], const Unit& u, int wr, int wc, int fr, int fq) const {
        const int row0 = u.pm * BM + wr * 64 + fr, col0 = u.pn * 128 + wc * 16 + 4 * fq;
#pragma unroll
        for (int ai = 0; ai < 2; ++ai)
#pragma unroll
            for (int m = 0; m < 4; ++m) { bf16_t* rowp = O + (size_t)(row0 + ai * HALF + m * 16) * ldc + col0;
#pragma unroll
                for (int bj = 0; bj < 2; ++bj) { const f32x4 g = acc[ai][bj][m][0], up = acc[ai][bj][m][1];
                    u32x2 w; w.x = pk2(siluf_(g[0]) * up[0], siluf_(g[1]) * up[1]); w.y = pk2(siluf_(g[2]) * up[2], siluf_(g[3]) * up[3]);
                    *(u32x2*)(rowp + bj * 64) = w; } }
    }
};
struct EpiResid {
    static constexpr bool PERM = false;
    const float* xold_lat; const float* xold_ctx; float* xnew_lat; float* xnew_ctx; const float* modl;
    DI void operator()(const f32x4 (&acc)[2][2][4][2], const Unit& u, int wr, int wc, int fr, int fq) const {
        const int b = u.pm / 17, w = u.pm % 17;
        const float* xo = (w == 0) ? xold_ctx + (size_t)(b * 256) * DM : xold_lat + (size_t)(b * 4096 + (w - 1) * 256) * DM;
        float* xn = (w == 0) ? xnew_ctx + (size_t)(b * 256) * DM : xnew_lat + (size_t)(b * 4096 + (w - 1) * 256) * DM;
        const float* ga = modl + (size_t)((w == 0) ? 8 : b) * 6144 + 2048;
        const int r0 = wr * 64 + fr, col0 = u.pn * BM + wc * 32 + 4 * fq;
        f32x4 gv[2][2];
#pragma unroll
        for (int bj = 0; bj < 2; ++bj)
#pragma unroll
            for (int n = 0; n < 2; ++n) gv[bj][n] = *(const f32x4*)(ga + col0 + bj * HALF + n * 16);
#pragma unroll
        for (int ai = 0; ai < 2; ++ai)
#pragma unroll
            for (int m = 0; m < 4; ++m) { const size_t ro = (size_t)(r0 + ai * HALF + m * 16) * DM + col0;
#pragma unroll
                for (int bj = 0; bj < 2; ++bj)
#pragma unroll
                    for (int n = 0; n < 2; ++n) { const f32x4 o = *(const f32x4*)(xo + ro + bj * HALF + n * 16); *(f32x4*)(xn + ro + bj * HALF + n * 16) = o + gv[bj][n] * acc[ai][bj][m][n]; }
                asm volatile("" ::: "memory"); }
    }
};

template <class Epi>
DI void gemm_phase(LAS unsigned char* lds, const Gemm g, const Sched& S, const Epi& E, const int tid) {
    const int wid = __builtin_amdgcn_readfirstlane(tid >> 6), lane = tid & 63, wr = wid >> 2, wc = wid & 3, fr = lane & 15, fq = lane >> 4;
    const int K = g.K, nt = K / BK;
    unsigned voffA[2], voffB[2];
#pragma unroll
    for (int i = 0; i < 2; ++i) { int R, C; stage_rc(tid * 16 + i * 8192, R, C); const int Rb = Epi::PERM ? ((R & ~31) + perm32(R & 31)) : R;
        voffA[i] = (unsigned)(R * g.lda + C) * 2u; voffB[i] = (unsigned)(Rb * g.ldb + C) * 2u; }
    const size_t kstep = (size_t)(BK * 2);
    const size_t hstepA = (size_t)HALF * g.lda * 2, hstepB = (size_t)HALF * g.ldb * 2;
    const unsigned ldsw = (unsigned)wid * 1024u;
    const int aoff = lds_byte(wr * 64 + fr, fq * 8), boff = lds_byte(wc * 32 + fr, fq * 8);
#define PG8_SA(b, h) (((b) * 2 + (h)) * HTB)
#define PG8_SB(b, h) ((4 + (b) * 2 + (h)) * HTB)
#define PG8_STAGE(bufoff, gbase, voff) do { _Pragma("unroll") for (int _i = 0; _i < 2; ++_i) \
        __builtin_amdgcn_global_load_lds((const unsigned*)((const char*)(gbase) + (voff)[_i]), (LAS unsigned*)(lds + (bufoff) + ldsw + _i * 8192), 16, 0, 0); } while (0)
#define PG8_LDA(dst, b, h) do { _Pragma("unroll") for (int m = 0; m < 4; ++m) _Pragma("unroll") for (int k = 0; k < 2; ++k) dst[m][k] = *(const LAS bf16x8*)(lds + PG8_SA(b, h) + aoff + m * 2048 + k * 1024); } while (0)
#define PG8_LDB(dst, b, h) do { _Pragma("unroll") for (int n = 0; n < 2; ++n) _Pragma("unroll") for (int k = 0; k < 2; ++k) dst[n][k] = *(const LAS bf16x8*)(lds + PG8_SB(b, h) + boff + n * 2048 + k * 1024); } while (0)
#define PG8_MMA(ai, bj, At, Bt) do { __builtin_amdgcn_s_setprio(1); _Pragma("unroll") for (int m = 0; m < 4; ++m) _Pragma("unroll") for (int n = 0; n < 2; ++n) _Pragma("unroll") for (int k = 0; k < 2; ++k) \
        acc[ai][bj][m][n] = __builtin_amdgcn_mfma_f32_16x16x32_bf16(Bt[n][k], At[m][k], acc[ai][bj][m][n], 0, 0, 0); __builtin_amdgcn_s_setprio(0); } while (0)
#define PG8_WAIT_V(n) asm volatile("s_waitcnt vmcnt(" #n ")" ::: "memory")
#define PG8_WAIT_L(n) asm volatile("s_waitcnt lgkmcnt(" #n ")" ::: "memory")
#define PG8_BAR __builtin_amdgcn_s_barrier()
#define PG8_SCHED __builtin_amdgcn_sched_barrier(0)
    Unit cur, nxt; int ui = 0;
    if (!S.next(0, cur)) return;
    f32x4 acc[2][2][4][2];
#pragma unroll
    for (int a = 0; a < 2; ++a)
#pragma unroll
        for (int b = 0; b < 2; ++b)
#pragma unroll
            for (int m = 0; m < 4; ++m)
#pragma unroll
                for (int n = 0; n < 2; ++n) acc[a][b][m][n] = (f32x4){0.f, 0.f, 0.f, 0.f};
    bf16x8 At[4][2], B0[2][2], B1[2][2];
    const char* cA = (const char*)g.A + (size_t)cur.arow * g.lda * 2; const char* cB = (const char*)g.Bt + (size_t)cur.brow * g.ldb * 2;
    PG8_STAGE(PG8_SB(0, 0), cB, voffB); PG8_STAGE(PG8_SA(0, 0), cA, voffA); PG8_STAGE(PG8_SB(0, 1), cB + hstepB, voffB); PG8_STAGE(PG8_SA(0, 1), cA + hstepA, voffA);
    if (wr == 1) PG8_BAR;
    PG8_WAIT_V(4); PG8_BAR;
    PG8_STAGE(PG8_SB(1, 0), cB + kstep, voffB); PG8_STAGE(PG8_SA(1, 0), cA + kstep, voffA); PG8_STAGE(PG8_SB(1, 1), cB + hstepB + kstep, voffB);
    PG8_WAIT_V(6); PG8_BAR;
    for (;;) {
        const bool has_next = S.next(ui + 1, nxt);
        const char* nA = has_next ? (const char*)g.A + (size_t)nxt.arow * g.lda * 2 : cA; const char* nB = has_next ? (const char*)g.Bt + (size_t)nxt.brow * g.ldb * 2 : cB;
        for (int t = 0; t < nt; t += 2) {
            const bool last = (t == nt - 2);
            const char* a1 = cA + (size_t)(t + 1) * kstep;
            const char* a2 = last ? nA : cA + (size_t)(t + 2) * kstep; const char* b2 = last ? nB : cB + (size_t)(t + 2) * kstep;
            const char* a3 = a2 + kstep; const char* b3 = b2 + kstep;
            PG8_LDB(B0, 0, 0); PG8_SCHED; PG8_LDA(At, 0, 0); PG8_STAGE(PG8_SA(1, 1), a1 + hstepA, voffA);
            PG8_WAIT_L(8); PG8_BAR; PG8_WAIT_L(0); PG8_MMA(0, 0, At, B0); PG8_BAR; PG8_SCHED;
            PG8_LDB(B1, 0, 1); PG8_STAGE(PG8_SB(0, 0), b2, voffB);
            PG8_BAR; PG8_WAIT_L(0); PG8_MMA(0, 1, At, B1); PG8_BAR;
            PG8_LDA(At, 0, 1); PG8_STAGE(PG8_SA(0, 0), a2, voffA);
            PG8_BAR; PG8_WAIT_L(0); PG8_MMA(1, 0, At, B0); PG8_BAR; PG8_SCHED;
            PG8_STAGE(PG8_SB(0, 1), b2 + hstepB, voffB);
            PG8_WAIT_V(6); PG8_BAR; PG8_MMA(1, 1, At, B1); PG8_BAR;
            PG8_LDB(B0, 1, 0); PG8_SCHED; PG8_LDA(At, 1, 0); PG8_STAGE(PG8_SA(0, 1), a2 + hstepA, voffA);
            PG8_WAIT_L(8); PG8_BAR; PG8_WAIT_L(0); PG8_MMA(0, 0, At, B0); PG8_BAR; PG8_SCHED;
            PG8_LDB(B1, 1, 1); PG8_STAGE(PG8_SB(1, 0), b3, voffB);
            PG8_BAR; PG8_WAIT_L(0); PG8_MMA(0, 1, At, B1); PG8_BAR;
            PG8_LDA(At, 1, 1); PG8_STAGE(PG8_SA(1, 0), a3, voffA);
            PG8_BAR; PG8_WAIT_L(0); PG8_MMA(1, 0, At, B0); PG8_BAR; PG8_SCHED;
            PG8_STAGE(PG8_SB(1, 1), b3 + hstepB, voffB);
            PG8_WAIT_V(6); PG8_BAR; PG8_MMA(1, 1, At, B1); PG8_BAR;
        }
        E(acc, cur, wr, wc, fr, fq);
        if (!has_next) break;
#pragma unroll
        for (int a = 0; a < 2; ++a)
#pragma unroll
            for (int b = 0; b < 2; ++b)
#pragma unroll
                for (int m = 0; m < 4; ++m)
#pragma unroll
                    for (int n = 0; n < 2; ++n) acc[a][b][m][n] = (f32x4){0.f, 0.f, 0.f, 0.f};
        cur = nxt; cA = nA; cB = nB; ++ui;
    }
    PG8_WAIT_V(0);
    if (wr == 0) PG8_BAR;
    PG8_BAR;
#undef PG8_SA
#undef PG8_SB
#undef PG8_STAGE
#undef PG8_LDA
#undef PG8_LDB
#undef PG8_MMA
#undef PG8_WAIT_V
#undef PG8_WAIT_L
#undef PG8_BAR
#undef PG8_SCHED
}
}

struct Ctx {
    const float* const* in; float* out; unsigned char* ws; int G, bid, tid, wave, lane; LAS unsigned char* lds;
    DI float* modv(int l) const { return (float*)(ws + OFF_MOD) + (size_t)l * 9 * 6144; }
    DI bf16_t* wsm(int l, size_t off) const { return (bf16_t*)(ws + OFF_WSM + (size_t)l * WSM_STRIDE + off); }
    DI bf16_t* act() const { return (bf16_t*)(ws + OFF_ACT); }
    DI bf16_t* pbuf() const { return (bf16_t*)(ws + OFF_ARENA + AR_P); }
    DI bf16_t* qkv() const { return (bf16_t*)(ws + OFF_ARENA + AR_QKV); }
    DI bf16_t* kf() const { return (bf16_t*)(ws + OFF_ARENA + AR_KF); }
    DI bf16_t* ops(int i) const { return (bf16_t*)(ws + OFF_ARENA + AR_OPS + (size_t)i * OPS_STRIDE); }
    DI float* xc() const { return (float*)(ws + OFF_XC); }
    DI float* bonus() const { return (float*)(ws + OFF_BONUS); }
    DI int* cnt() const { return (int*)(ws + OFF_CNT); }
};

DI void phase_mod(const Ctx& C) {
    LAS float* sl = (LAS float*)C.lds;
    LAS float* red = (LAS float*)(C.lds + 40960);
    const float* cv = C.in[1]; const float* ccx = C.in[3];
    for (int i = C.tid; i < 9 * 1024; i += NTHR) { const int s = i >> 10, k = i & 1023; const float v = (s < 8) ? cv[s * 1024 + k] : ccx[k]; sl[i] = siluf_(v); }
    __syncthreads();
    for (int item = C.bid; item < 192; item += C.G) {
        const int l = item / 96, col = (item % 96) * 64 + C.lane;
        const float* W = C.in[4] + (size_t)l * 1024 * 6144 + col;
        float acc[9];
#pragma unroll
        for (int j = 0; j < 9; ++j) acc[j] = 0.f;
        const int k0 = C.wave * 128;
#pragma unroll 4
        for (int k = 0; k < 128; ++k) { const float w = W[(size_t)(k0 + k) * 6144];
#pragma unroll
            for (int j = 0; j < 9; ++j) acc[j] += sl[j * 1024 + k0 + k] * w; }
#pragma unroll
        for (int j = 0; j < 9; ++j) red[(C.wave * 9 + j) * 64 + C.lane] = acc[j];
        __syncthreads();
        for (int o = C.tid; o < 9 * 64; o += NTHR) { const int j = o >> 6, ln = o & 63; float s = 0.f;
            for (int w = 0; w < 8; ++w) s += red[(w * 9 + j) * 64 + ln];
            const int cc = (item % 96) * 64 + ln;
            C.modv(l)[(size_t)j * 6144 + cc] = s + C.in[5][(size_t)l * 6144 + cc]; }
        __syncthreads();
    }
}

struct TJob { const float* src; int ldsrc, Ks, Ns; const float* kscale; bf16_t* dst; int lddst, row0, col0, nkt, nnt, rowmap; };
DI void tconv_tile(const TJob& J, int kt, int nt, LAS float* lds, const int tid) {
    const int k0 = kt * 64, n0 = nt * 64;
    { const int kk = tid >> 3, nn = (tid & 7) * 8; const int k = k0 + kk; float v[8];
#pragma unroll
      for (int j = 0; j < 8; ++j) v[j] = 0.f;
      if (J.src && k < J.Ks) { const float* sp = J.src + (size_t)k * J.ldsrc + n0 + nn;
          if (n0 + nn + 7 < J.Ns) { const f32x4 a = *(const f32x4*)sp, b = *(const f32x4*)(sp + 4); v[0] = a[0]; v[1] = a[1]; v[2] = a[2]; v[3] = a[3]; v[4] = b[0]; v[5] = b[1]; v[6] = b[2]; v[7] = b[3]; }
          else {
#pragma unroll
              for (int j = 0; j < 8; ++j) if (n0 + nn + j < J.Ns) v[j] = sp[j]; }
          const float sc = J.kscale ? J.kscale[k] : 1.f;
#pragma unroll
          for (int j = 0; j < 8; ++j) v[j] *= sc; }
#pragma unroll
      for (int j = 0; j < 8; ++j) lds[kk * 65 + nn + j] = v[j]; }
    __syncthreads();
    { const int n = tid >> 3, kq = (tid & 7) * 8; float v[8];
#pragma unroll
      for (int j = 0; j < 8; ++j) v[j] = lds[(kq + j) * 65 + n];
      const int nl = n0 + n; int dr;
      if (J.rowmap == 0) dr = nl; else dr = 8 * (nl >> 2) + (nl & 3) + (J.rowmap == 2 ? 4 : 0);
      u32x4 w; w.x = pk2(v[0], v[1]); w.y = pk2(v[2], v[3]); w.z = pk2(v[4], v[5]); w.w = pk2(v[6], v[7]);
      *(u32x4*)(J.dst + (size_t)(J.row0 + dr) * J.lddst + J.col0 + k0 + kq) = w; }
    __syncthreads();
}
DI TJob small_job(const Ctx& C, int l, int j) {
    TJob J; J.kscale = nullptr; J.rowmap = 0; J.row0 = 0; J.col0 = 0;
    switch (j) {
    case 0: J.src = C.in[8] + (size_t)l * 1024 * INC; J.ldsrc = INC; J.Ks = 1024; J.Ns = INC; J.dst = C.wsm(l, WSM_WIN); J.lddst = 1024; J.nkt = 16; J.nnt = 44; break;
    case 1: J.src = C.in[10] + (size_t)l * 384 * 768; J.ldsrc = 768; J.Ks = 384; J.Ns = 768; J.kscale = C.in[9] + l * 384; J.dst = C.wsm(l, WSM_WQKV); J.lddst = 640; J.nkt = 6; J.nnt = 12; break;
    case 2: J.src = C.in[12] + (size_t)l * 256 * 1024; J.ldsrc = 1024; J.Ks = 256; J.Ns = 1024; J.kscale = C.in[11] + l * 256; J.dst = C.wsm(l, WSM_WQKV); J.lddst = 640; J.row0 = 768; J.col0 = 384; J.nkt = 4; J.nnt = 16; break;
    case 3: J.src = nullptr; J.ldsrc = 0; J.Ks = 0; J.Ns = 0; J.dst = C.wsm(l, WSM_WQKV); J.lddst = 640; J.row0 = 0; J.col0 = 384; J.nkt = 4; J.nnt = 12; break;
    case 4: J.src = nullptr; J.ldsrc = 0; J.Ks = 0; J.Ns = 0; J.dst = C.wsm(l, WSM_WQKV); J.lddst = 640; J.row0 = 768; J.col0 = 0; J.nkt = 6; J.nnt = 16; break;
    case 5: J.src = C.in[27] + (size_t)l * 1024 * 1024; J.ldsrc = 1024; J.Ks = 1024; J.Ns = 1024; J.dst = C.wsm(l, WSM_WOUT); J.lddst = 1024; J.nkt = 16; J.nnt = 16; break;
    case 6: J.src = C.in[19] + (size_t)(l * 2 + 0) * 64 * 256; J.ldsrc = 256; J.Ks = 64; J.Ns = 256; J.dst = C.wsm(l, WSM_W2F); J.lddst = 64; J.nkt = 1; J.nnt = 4; break;
    case 7: J.src = C.in[19] + (size_t)(l * 2 + 1) * 64 * 256; J.ldsrc = 256; J.Ks = 64; J.Ns = 256; J.dst = C.wsm(l, WSM_W2B); J.lddst = 64; J.nkt = 1; J.nnt = 4; break;
    case 8: J.src = C.in[21] + (size_t)l * 64 * 256; J.ldsrc = 256; J.Ks = 64; J.Ns = 256; J.dst = C.wsm(l, WSM_A2); J.lddst = 64; J.nkt = 1; J.nnt = 4; break;
    default: J.src = C.in[22] + (size_t)l * 128 * 256; J.ldsrc = 256; J.Ks = 128; J.Ns = 256; J.dst = C.wsm(l, WSM_G2); J.lddst = 128; J.nkt = 2; J.nnt = 4; break;
    }
    return J;
}
DI void phase_wconv_small(const Ctx& C) {
    LAS float* lds = (LAS float*)C.lds;
    int base = 0;
    for (int l = 0; l < 2; ++l)
        for (int j = 0; j < 10; ++j) {
            const TJob J = small_job(C, l, j); const int ntile = J.nkt * J.nnt;
            int first = (C.bid - base % C.G + C.G) % C.G;
            for (int t = first; t < ntile; t += C.G) tconv_tile(J, t / J.nnt, t % J.nnt, lds, C.tid);
            base += ntile;
        }
}
DI void phase_wconv_experts(const Ctx& C, int l) {
    LAS float* lds = (LAS float*)C.lds;
    for (int t = C.bid; t < 48 * 256; t += C.G) {
        const int mat = t >> 8, tile = t & 255, e = mat / 3, kind = mat % 3;
        TJob J; J.kscale = nullptr; J.ldsrc = 1024; J.Ks = 1024; J.Ns = 1024; J.col0 = 0; J.nkt = 16; J.nnt = 16; J.lddst = 1024;
        if (kind < 2) { J.src = C.in[29 + kind] + (size_t)(l * 16 + e) * 1048576; J.dst = (bf16_t*)(C.ws + OFF_ARENA + AR_WGU); J.row0 = e * 2048; J.rowmap = 1 + kind; }
        else { J.src = C.in[31] + (size_t)(l * 16 + e) * 1048576; J.dst = (bf16_t*)(C.ws + OFF_ARENA + AR_WD); J.row0 = e * 1024; J.rowmap = 0; }
        tconv_tile(J, tile >> 4, tile & 15, lds, C.tid);
    }
}

DI const float* tok_row(const float* lat, const float* ctxp, int tok) { const int b = tok / SB, s = tok - b * SB; return (s < CTXL) ? ctxp + (size_t)(b * CTXL + s) * DM : lat + (size_t)(b * SEQ + s - CTXL) * DM; }

DI void norm_mod_store(const f32x4 (&v)[4], const float* nw, const float* modrow, int shoff, int scoff, bf16_t* dst, int lane) {
    float ss = 0.f;
#pragma unroll
    for (int j = 0; j < 4; ++j) ss += v[j][0] * v[j][0] + v[j][1] * v[j][1] + v[j][2] * v[j][2] + v[j][3] * v[j][3];
    ss = wave_sum(ss);
    const float rstd = rsqrtf(ss * (1.f / 1024.f) + 1e-6f);
#pragma unroll
    for (int j = 0; j < 4; ++j) { const int c = j * 256 + lane * 4;
        const f32x4 w = *(const f32x4*)(nw + c), sc = *(const f32x4*)(modrow + scoff + c), sh = *(const f32x4*)(modrow + shoff + c);
        const f32x4 o = v[j] * rstd * w * (sc + 1.f) + sh;
        u32x2 pkd; pkd.x = pk2(o[0], o[1]); pkd.y = pk2(o[2], o[3]); *(u32x2*)(dst + c) = pkd; }
}

DI void phase_u(const Ctx& C, int l, const float* lat, const float* ctxp) {
    const int gw = C.bid * 8 + C.wave, GW = C.G * 8;
    for (int tok = gw; tok < T; tok += GW) {
        const int b = tok / SB, s = tok - b * SB; const float* xr = tok_row(lat, ctxp, tok);
        f32x4 v[4];
#pragma unroll
        for (int j = 0; j < 4; ++j) v[j] = *(const f32x4*)(xr + j * 256 + C.lane * 4);
        norm_mod_store(v, C.in[6] + l * 1024, C.modv(l) + (size_t)((s < CTXL) ? 8 : b) * 6144, 0, 1024, C.act() + (size_t)tok * DM, C.lane);
    }
}

DI void phase_ret_prep(const Ctx& C) {
    const int gw = C.bid * 8 + C.wave, GW = C.G * 8;
    const int hh = C.lane >> 4, i2 = (C.lane & 15) * 2;
    const float inv0 = exp2f(-(float)i2 * (13.287712379549449f / 31.f)), inv1 = exp2f(-(float)(i2 + 1) * (13.287712379549449f / 31.f));
    for (int tok = gw; tok < T; tok += GW) {
        const int s = tok % SB; bf16_t* pr = C.pbuf() + (size_t)tok * NPC;
        float c0, s0, c1, s1; sincosf((float)s * inv0, &s0, &c0); sincosf((float)s * inv1, &s1, &c1);
#pragma unroll
        for (int qk = 0; qk < 2; ++qk) { bf16_t* base = pr + (qk ? C_RK : C_RQ) + hh * 64 + i2; const float sc = qk ? 0.125f : 1.f;
            const unsigned a = *(const unsigned*)base, bq = *(const unsigned*)(base + 32);
            const float x10 = lo_f(a), x11 = hi_f(a), x20 = lo_f(bq), x21 = hi_f(bq);
            *(unsigned*)base = pk2((x10 * c0 - x20 * s0) * sc, (x11 * c1 - x21 * s1) * sc);
            *(unsigned*)(base + 32) = pk2((x10 * s0 + x20 * c0) * sc, (x11 * s1 + x21 * c1) * sc); }
    }
}

DI float shift_val(float pc, float pp, float pn, float mu) { return pc + (0.5f * (pp + pn) - pc) * mu; }
DI void phase_rwkv_prep(const Ctx& C, int l) {
    LAS bf16_t* X = (LAS bf16_t*)C.lds;
    LAS bf16_t* AL = (LAS bf16_t*)(C.lds + 64 * 328 * 2);
    const float* mu = C.in[17] + l * 1088;
    const bf16_t* P = C.pbuf();
    const int lane = C.lane, wave = C.wave;
    for (int tile = C.bid; tile < 544; tile += C.G) {
        const int b = tile / 68, tt = tile % 68; const int s0 = tt * 64; const int tok0 = b * SB + s0;
        const int sfirst = (s0 < CTXL) ? 0 : CTXL, slast = (s0 < CTXL) ? CTXL - 1 : SB - 1;
        { const int ti = C.tid >> 3, s = s0 + ti; const bf16_t* pc = P + (size_t)(tok0 + ti) * NPC + C_RW + 768;
          const bool hp = s > sfirst, hn = s < slast;
#pragma unroll
          for (int jj = 0; jj < 5; ++jj) { const int col = (C.tid & 7) * 8 + 64 * jj;
              const u32x4 vc = *(const u32x4*)(pc + col); u32x4 vp = {0u, 0u, 0u, 0u}, vn = {0u, 0u, 0u, 0u};
              if (hp) vp = *(const u32x4*)(pc - NPC + col); if (hn) vn = *(const u32x4*)(pc + NPC + col);
              unsigned o[4];
#pragma unroll
              for (int q = 0; q < 4; ++q) { float a = shift_val(lo_f(vc[q]), lo_f(vp[q]), lo_f(vn[q]), mu[768 + col + 2 * q]);
                  float bq = shift_val(hi_f(vc[q]), hi_f(vp[q]), hi_f(vn[q]), mu[768 + col + 2 * q + 1]);
                  if (col < 128) { a = tanhf(a); bq = tanhf(bq); } else if (col >= 192) { a = sigmoidf_(a); bq = sigmoidf_(bq); }
                  o[q] = pk2(a, bq); }
              *(LAS u32x4*)(X + ti * 328 + col) = (u32x4){o[0], o[1], o[2], o[3]}; } }
        __syncthreads();
        { const int tg = wave & 3, ch = wave >> 2; const int tk = tg * 16 + (lane & 15); const int tok = tok0 + tk;
#pragma unroll
          for (int mat = 0; mat < 4; ++mat) {
              const int Kd = (mat == 3) ? 128 : 64; const int xoff = (mat == 3) ? 192 : mat * 64;
              const bf16_t* W = C.wsm(l, mat == 0 ? WSM_W2F : mat == 1 ? WSM_W2B : mat == 2 ? WSM_A2 : WSM_G2);
#pragma unroll
              for (int nt = 0; nt < 8; ++nt) { f32x4 acc = {0.f, 0.f, 0.f, 0.f};
                  for (int ks = 0; ks < Kd / 32; ++ks) {
                      const bf16x8 wf = *(const bf16x8*)(W + (size_t)(ch * 128 + nt * 16 + (lane & 15)) * Kd + ks * 32 + 8 * (lane >> 4));
                      const bf16x8 xf = *(const LAS bf16x8*)(X + tk * 328 + xoff + ks * 32 + 8 * (lane >> 4));
                      acc = __builtin_amdgcn_mfma_f32_16x16x32_bf16(wf, xf, acc, 0, 0, 0); }
                  const int n0 = ch * 128 + nt * 16 + 4 * (lane >> 4);
                  float o[4];
                  if (mat < 2) { const float* w0 = C.in[18] + (size_t)(l * 2 + mat) * 256 + n0;
#pragma unroll
                      for (int q = 0; q < 4; ++q) o[q] = 1.f - __expf(-0.606531f * sigmoidf_(w0[q] + acc[q]));
                      u32x2 w; w.x = pk2(o[0], o[1]); w.y = pk2(o[2], o[3]); *(u32x2*)(C.ops(1 + mat) + (size_t)tok * 256 + n0) = w; }
                  else if (mat == 2) { const float* a0 = C.in[20] + l * 256 + n0;
#pragma unroll
                      for (int q = 0; q < 4; ++q) o[q] = sigmoidf_(a0[q] + acc[q]);
                      u32x2 w; w.x = pk2(o[0], o[1]); w.y = pk2(o[2], o[3]); *(LAS u32x2*)(AL + tk * 264 + n0) = w; }
                  else { u32x2 w; w.x = pk2(acc[0], acc[1]); w.y = pk2(acc[2], acc[3]); *(u32x2*)(C.ops(3) + (size_t)tok * 256 + n0) = w; } } } }
        __syncthreads();
        { const int c4 = lane * 4;
          const f32x4 mur = *(const f32x4*)(mu + c4), muk = *(const f32x4*)(mu + 256 + c4), muv = *(const f32x4*)(mu + 512 + c4);
          const f32x4 kkw = *(const f32x4*)(C.in[23] + l * 256 + c4), kaw = *(const f32x4*)(C.in[24] + l * 256 + c4), rkw = *(const f32x4*)(C.in[25] + l * 256 + c4);
          for (int q8 = 0; q8 < 8; ++q8) { const int ti = wave * 8 + q8, s = s0 + ti, tok = tok0 + ti;
              const bf16_t* pc = P + (size_t)tok * NPC + C_RW + c4; const bool hp = s > sfirst, hn = s < slast;
              f32x4 rs, ks_, vs;
#pragma unroll
              for (int part = 0; part < 3; ++part) { const u32x2 vc = *(const u32x2*)(pc + part * 256); u32x2 vp = {0u, 0u}, vn = {0u, 0u};
                  if (hp) vp = *(const u32x2*)(pc - NPC + part * 256); if (hn) vn = *(const u32x2*)(pc + NPC + part * 256);
                  const f32x4 m = part == 0 ? mur : part == 1 ? muk : muv; f32x4 o;
                  o[0] = shift_val(lo_f(vc.x), lo_f(vp.x), lo_f(vn.x), m[0]); o[1] = shift_val(hi_f(vc.x), hi_f(vp.x), hi_f(vn.x), m[1]);
                  o[2] = shift_val(lo_f(vc.y), lo_f(vp.y), lo_f(vn.y), m[2]); o[3] = shift_val(hi_f(vc.y), hi_f(vp.y), hi_f(vn.y), m[3]);
                  if (part == 0) rs = o; else if (part == 1) ks_ = o; else vs = o; }
              const u32x2 aw = *(const LAS u32x2*)(AL + ti * 264 + c4); const f32x4 a = {lo_f(aw.x), hi_f(aw.x), lo_f(aw.y), hi_f(aw.y)};
              f32x4 kk = ks_ * kkw; float nn = kk[0] * kk[0] + kk[1] * kk[1] + kk[2] * kk[2] + kk[3] * kk[3]; nn = row16_sum(nn);
              kk = kk * (1.f / fmaxf(sqrtf(nn), 1e-12f));
              const f32x4 kp = ks_ * ((a - 1.f) * kaw + 1.f); const f32x4 bb = kk * a;
              float bon = rs[0] * kp[0] * rkw[0] + rs[1] * kp[1] * rkw[1] + rs[2] * kp[2] * rkw[2] + rs[3] * kp[3] * rkw[3]; bon = row16_sum(bon);
              if ((lane & 15) == 0) C.bonus()[(size_t)tok * 4 + (lane >> 4)] = bon;
              bf16_t* ar = C.act() + (size_t)tok * DM + c4;
              u32x2 w; w.x = pk2(rs[0], rs[1]); w.y = pk2(rs[2], rs[3]); *(u32x2*)(ar) = w;
              w.x = pk2(kp[0], kp[1]); w.y = pk2(kp[2], kp[3]); *(u32x2*)(ar + 256) = w;
              w.x = pk2(vs[0], vs[1]); w.y = pk2(vs[2], vs[3]); *(u32x2*)(ar + 512) = w;
              w.x = pk2(bb[0], bb[1]); w.y = pk2(bb[2], bb[3]); *(u32x2*)(ar + 768) = w;
              w.x = pk2(kk[0], kk[1]); w.y = pk2(kk[2], kk[3]); *(u32x2*)(C.ops(0) + (size_t)tok * 256 + c4) = w; } }
        __syncthreads();
    }
}

DI void phase_qk_final(const Ctx& C, int l) {
    const int gw = C.bid * 8 + C.wave, GW = C.G * 8, lane = C.lane;
    const float* qg = C.in[13] + l * 96; const float* kg = C.in[14] + l * 96;
    const float QS = 0.10206207261596577f * 1.4426950408889634f;
    for (int tok = gw; tok < T; tok += GW) {
        const int s = tok % SB; const bool lat = s >= CTXL; const int t = s - CTXL;
        const bf16_t* pr = C.pbuf() + (size_t)tok * NPC; bf16_t* qr = C.qkv() + (size_t)tok * QKVC; bf16_t* kr = C.kf() + (size_t)tok * 768;
        float sq = 0.f, sk = 0.f;
        { const unsigned* p32 = (const unsigned*)pr;
          for (int i = lane; i < 192; i += 64) { const unsigned w = p32[i]; sq += lo_f(w) * lo_f(w) + hi_f(w) * hi_f(w); }
          for (int i = lane; i < 128; i += 64) { const unsigned w = p32[192 + i]; sk += lo_f(w) * lo_f(w) + hi_f(w) * hi_f(w); } }
        sq = wave_sum(sq); sk = wave_sum(sk);
        const float rq = rsqrtf(sq * (1.f / 384.f) + 1e-6f), rk = rsqrtf(sk * (1.f / 256.f) + 1e-6f);
        float cs = 1.f, sn = 0.f;
        if (lat && lane < 16) { const int f = lane & 7; const float inv = exp2f(-(float)f * (13.287712379549449f / 8.f)); const float pos = (lane < 8) ? (float)(t >> 6) : (float)(t & 63); sincosf(pos * inv, &sn, &cs); }
        unsigned krw = 0u; if (lane < 16) krw = ((unsigned)pr[C_KR + lane]) | ((unsigned)pr[C_KR + 16 + lane] << 16);
        const float kr1 = lo_f(krw), kr2 = hi_f(krw);
        for (int h = 0; h < 8; ++h) {
            float n0 = 0.f, n1 = 0.f, r1 = 0.f, r2 = 0.f;
            if (lane < 32) { const unsigned w = *(const unsigned*)(qr + h * 96 + 2 * lane); n0 = lo_f(w) * rq; n1 = hi_f(w) * rq; }
            if (lane < 16) { r1 = bf2f(qr[h * 96 + 64 + lane]) * rq; r2 = bf2f(qr[h * 96 + 80 + lane]) * rq; }
            float ss = wave_sum(n0 * n0 + n1 * n1 + r1 * r1 + r2 * r2);
            float rs = rsqrtf(ss * (1.f / 96.f) + 1e-6f) * QS;
            if (lane < 32) { *(unsigned*)(qr + h * 96 + 2 * lane) = pk2(n0 * rs * qg[2 * lane], n1 * rs * qg[2 * lane + 1]); }
            if (lane < 16) { const float a = r1 * rs * qg[64 + lane], bq = r2 * rs * qg[80 + lane];
                qr[h * 96 + 64 + lane] = f2bf(a * cs - bq * sn); qr[h * 96 + 80 + lane] = f2bf(a * sn + bq * cs); }
            float m0 = 0.f, m1 = 0.f;
            if (lane < 32) { const unsigned w = *(const unsigned*)(qr + 768 + h * 128 + 2 * lane); m0 = lo_f(w) * rk; m1 = hi_f(w) * rk; }
            float s2 = wave_sum(m0 * m0 + m1 * m1 + ((lane < 16) ? (kr1 * kr1 + kr2 * kr2) : 0.f));
            const float rs2 = rsqrtf(s2 * (1.f / 96.f) + 1e-6f);
            if (lane < 32) { *(unsigned*)(kr + h * 96 + 2 * lane) = pk2(m0 * rs2 * kg[2 * lane], m1 * rs2 * kg[2 * lane + 1]); }
            if (lane < 16) { const float a = kr1 * rs2 * kg[64 + lane], bq = kr2 * rs2 * kg[80 + lane];
                kr[h * 96 + 64 + lane] = f2bf(a * cs - bq * sn); kr[h * 96 + 80 + lane] = f2bf(a * sn + bq * cs); }
        }
    }
}

namespace att {
constexpr int KVBLK = 64; constexpr int SHM_V = 64 * 128 * 2, SHM_K = 64 * 256;
constexpr float THR2 = 11.541560327f;
#define KSWZ(row, colB) ((row) * 256 + ((colB) ^ (((row) & 7) << 4)))
#define SBAR() __builtin_amdgcn_sched_barrier(0)
DI int crow(int r, int hi) { return (r & 3) + 8 * (r >> 2) + 4 * hi; }
DI void partialSM(f32x16& p0, f32x16& p1, float& m_reg, float& mn, float& alpha) {
    float pmax = p0[0];
#pragma unroll
    for (int r = 1; r < 16; ++r) pmax = fmaxf(pmax, p0[r]);
#pragma unroll
    for (int r = 0; r < 16; ++r) pmax = fmaxf(pmax, p1[r]);
    { auto rr = __builtin_amdgcn_permlane32_swap(__float_as_uint(pmax), __float_as_uint(pmax), false, false);
      pmax = fmaxf(__uint_as_float(rr[0]), __uint_as_float(rr[1])); }
    if (__builtin_expect(__all(pmax - m_reg <= THR2), 1)) { mn = m_reg; alpha = 1.f; }
    else { mn = fmaxf(m_reg, pmax); alpha = __builtin_amdgcn_exp2f(m_reg - mn); m_reg = mn; }
#pragma unroll
    for (int r = 0; r < 16; ++r) p0[r] = p0[r] - mn;
#pragma unroll
    for (int r = 0; r < 16; ++r) p1[r] = p1[r] - mn;
#pragma unroll
    for (int r = 0; r < 16; ++r) p0[r] = __builtin_amdgcn_exp2f(p0[r]);
}
DI void finishSM(f32x16& p0, f32x16& p1, float alpha, float& l_reg, bf16x8& pa0, bf16x8& pa1, bf16x8& pa2, bf16x8& pa3) {
#pragma unroll
    for (int r = 0; r < 16; ++r) p1[r] = __builtin_amdgcn_exp2f(p1[r]);
    float ps = 0;
#pragma unroll
    for (int r = 0; r < 16; ++r) ps += p0[r];
#pragma unroll
    for (int r = 0; r < 16; ++r) ps += p1[r];
    { auto rr = __builtin_amdgcn_permlane32_swap(__float_as_uint(ps), __float_as_uint(ps), false, false);
      ps = __uint_as_float(rr[0]) + __uint_as_float(rr[1]); }
    l_reg = l_reg * alpha + ps;
#define PK4(P, BASE, OUT) do { unsigned a0 = pk2(P[BASE + 0], P[BASE + 1]), a1 = pk2(P[BASE + 2], P[BASE + 3]);   \
    unsigned b0 = pk2(P[BASE + 4], P[BASE + 5]), b1 = pk2(P[BASE + 6], P[BASE + 7]);                              \
    auto r0 = __builtin_amdgcn_permlane32_swap(a0, b0, false, false); auto r1 = __builtin_amdgcn_permlane32_swap(a1, b1, false, false); \
    u32x4 w = {r0[0], r1[0], r0[1], r1[1]}; OUT = __builtin_bit_cast(bf16x8, w); } while (0)
    PK4(p0, 0, pa0); PK4(p0, 8, pa1); PK4(p1, 0, pa2); PK4(p1, 8, pa3);
#undef PK4
}
DI void qkt(f32x16& p0, f32x16& p1, const LAS char* Ks, const bf16x8* qr, int r32, int hi) {
#pragma unroll
    for (int r = 0; r < 16; ++r) { p0[r] = 0.f; p1[r] = 0.f; }
#pragma unroll
    for (int d0 = 0; d0 < 6; ++d0) { const int cb = (d0 * 16 + hi * 8) * 2;
        const bf16x8 b0 = *(const LAS bf16x8*)(Ks + KSWZ(r32, cb));
        const bf16x8 b1 = *(const LAS bf16x8*)(Ks + KSWZ(32 + r32, cb));
        p0 = __builtin_amdgcn_mfma_f32_32x32x16_bf16(b0, qr[d0], p0, 0, 0, 0);
        p1 = __builtin_amdgcn_mfma_f32_32x32x16_bf16(b1, qr[d0], p1, 0, 0, 0); }
}
DI int v_st(int k, int c) { const int kk = (k & ~0xC) | ((k & 4) << 1) | ((k & 8) >> 1); return ((kk >> 3) * 4 + (c >> 5)) * 512 + ((kk & 7) * 32 + (c & 31)) * 2; }
DI int v_rd_base(int lane) { return ((lane & 3) << 3) | (((lane >> 2) & 3) << 6) | (((lane >> 4) & 1) << 5) | (((lane >> 5) & 1) << 8); }
constexpr int v_rd_off(int d0, int ks, int half) { return d0 * 512 + ks * 4096 + half * 2048; }
template <int OFF> DI s16x4 tr_read(int vb) { s16x4 r; asm volatile("ds_read_b64_tr_b16 %0, %1 offset:%2" : "=&v"(r) : "v"(vb), "i"(OFF) : "memory"); return r; }
template <int D0> DI void pv_one(f32x16& od, int vb, bf16x8 pa0, bf16x8 pa1, bf16x8 pa2, bf16x8 pa3) {
    const s16x4 l0 = tr_read<v_rd_off(D0, 0, 0)>(vb), h0 = tr_read<v_rd_off(D0, 0, 1)>(vb), l1 = tr_read<v_rd_off(D0, 1, 0)>(vb), h1 = tr_read<v_rd_off(D0, 1, 1)>(vb);
    const s16x4 l2 = tr_read<v_rd_off(D0, 2, 0)>(vb), h2 = tr_read<v_rd_off(D0, 2, 1)>(vb), l3 = tr_read<v_rd_off(D0, 3, 0)>(vb), h3 = tr_read<v_rd_off(D0, 3, 1)>(vb);
    asm volatile("s_waitcnt lgkmcnt(0)" ::: "memory"); SBAR();
#define PKV(L, H) (bf16x8){L[0], L[1], L[2], L[3], H[0], H[1], H[2], H[3]}
    od = __builtin_amdgcn_mfma_f32_32x32x16_bf16(pa0, PKV(l0, h0), od, 0, 0, 0);
    od = __builtin_amdgcn_mfma_f32_32x32x16_bf16(pa1, PKV(l1, h1), od, 0, 0, 0);
    od = __builtin_amdgcn_mfma_f32_32x32x16_bf16(pa2, PKV(l2, h2), od, 0, 0, 0);
    od = __builtin_amdgcn_mfma_f32_32x32x16_bf16(pa3, PKV(l3, h3), od, 0, 0, 0);
#undef PKV
}
constexpr int LDQ = QKVC, LDK = 768, LDV = QKVC, LDO = NPC;
DI void attn_body(const bf16_t* __restrict__ Qb, const bf16_t* __restrict__ Kh, const bf16_t* __restrict__ Vh, bf16_t* __restrict__ Ob, int seq, LAS char* lds, const int tid) {
    const int wid = tid >> 6, lane = tid & 63, r32 = lane & 31, hi = lane >> 5;
    LAS char* V_lds = lds; LAS char* K_lds = lds + 2 * SHM_V;
    LAS float* wsl = (LAS float*)(lds + 2 * SHM_V + 2 * SHM_K) + wid * 64; LAS float* li_l = wsl; LAS float* al_l = wsl + 32;
    float m_reg = -1e30f, l_reg = 0; f32x16 o[2]; bf16x8 qr[6];
#pragma unroll
    for (int d = 0; d < 2; ++d)
#pragma unroll
        for (int r = 0; r < 16; ++r) o[d][r] = 0.f;
    const bf16_t* Qw = Qb + (size_t)(wid * 32 + r32) * LDQ + hi * 8;
#pragma unroll
    for (int d0 = 0; d0 < 6; ++d0) qr[d0] = *(const bf16x8*)(Qw + d0 * 16);
    const int kc1 = tid, kc2 = 512 + (tid & 255);
    const int kr1 = kc1 / 12, kq1 = kc1 % 12, kr2 = kc2 / 12, kq2 = kc2 % 12;
    const int vr = tid >> 3, vq = (tid & 7) * 8, vst = v_st(vr, vq);
    const int vb0 = (int)(uintptr_t)V_lds + v_rd_base(lane);
    struct { bf16x8 k1, k2, v; } sr_[2];
#define SLOAD(i, k0) do { sr_[i].k1 = *(const bf16x8*)(Kh + (size_t)((k0) + kr1) * LDK + kq1 * 8); sr_[i].k2 = *(const bf16x8*)(Kh + (size_t)((k0) + kr2) * LDK + kq2 * 8); \
    sr_[i].v = *(const bf16x8*)(Vh + (size_t)((k0) + vr) * LDV + vq); } while (0)
#define SWRITE(b, i) do { *(LAS bf16x8*)(V_lds + (b) * SHM_V + vst) = sr_[i].v; \
    *(LAS bf16x8*)(K_lds + (b) * SHM_K + KSWZ(kr1, kq1 * 16)) = sr_[i].k1; *(LAS bf16x8*)(K_lds + (b) * SHM_K + KSWZ(kr2, kq2 * 16)) = sr_[i].k2; } while (0)
#define SWAIT() asm volatile("s_waitcnt vmcnt(3)" ::: "memory")
#define RESC(a) do { if (__any((a) < 1.f)) { if (hi == 0) al_l[r32] = (a); asm volatile("s_waitcnt lgkmcnt(0)" ::: "memory"); \
    _Pragma("unroll") for (int d = 0; d < 2; ++d) _Pragma("unroll") for (int r = 0; r < 16; ++r) o[d][r] *= al_l[crow(r, hi)]; } } while (0)
    f32x16 pA0, pA1, pB0, pB1; float mnA, mnB, alA, alB; bf16x8 pa0, pa1, pa2, pa3; const int NT = seq / KVBLK;
    constexpr int SE = 0, SO = 1;
    SLOAD(SE, 0); asm volatile("s_waitcnt vmcnt(0)" ::: "memory"); SWRITE(0, SE); __syncthreads();
    qkt(pA0, pA1, K_lds, qr, r32, hi); partialSM(pA0, pA1, m_reg, mnA, alA);
    SLOAD(SO, KVBLK); if (2 < NT) SLOAD(SE, 2 * KVBLK);
    SWAIT(); SWRITE(1, SO); __syncthreads();
    for (int j = 1; j + 1 < NT; j += 2) {
        SBAR(); qkt(pB0, pB1, K_lds + SHM_K, qr, r32, hi);
        finishSM(pA0, pA1, alA, l_reg, pa0, pa1, pa2, pa3); SBAR();
        SLOAD(SO, (j + 2) * KVBLK); SBAR();
        pv_one<0>(o[0], vb0, pa0, pa1, pa2, pa3); pv_one<1>(o[1], vb0, pa0, pa1, pa2, pa3); partialSM(pB0, pB1, m_reg, mnB, alB);
        __syncthreads(); SWAIT(); SWRITE(0, SE);
        RESC(alB); __syncthreads();
        SBAR(); qkt(pA0, pA1, K_lds, qr, r32, hi);
        finishSM(pB0, pB1, alB, l_reg, pa0, pa1, pa2, pa3); SBAR();
        if (j + 3 < NT) SLOAD(SE, (j + 3) * KVBLK); else SLOAD(SE, 0); SBAR();
        pv_one<0>(o[0], vb0 + SHM_V, pa0, pa1, pa2, pa3); pv_one<1>(o[1], vb0 + SHM_V, pa0, pa1, pa2, pa3); partialSM(pA0, pA1, m_reg, mnA, alA);
        __syncthreads(); SWAIT(); SWRITE(1, SO);
        RESC(alA); __syncthreads();
    }
    SBAR(); qkt(pB0, pB1, K_lds + SHM_K, qr, r32, hi);
    finishSM(pA0, pA1, alA, l_reg, pa0, pa1, pa2, pa3); SBAR();
    pv_one<0>(o[0], vb0, pa0, pa1, pa2, pa3); pv_one<1>(o[1], vb0, pa0, pa1, pa2, pa3); partialSM(pB0, pB1, m_reg, mnB, alB);
    __syncthreads(); RESC(alB);
    finishSM(pB0, pB1, alB, l_reg, pa0, pa1, pa2, pa3); SBAR();
    pv_one<0>(o[0], vb0 + SHM_V, pa0, pa1, pa2, pa3); pv_one<1>(o[1], vb0 + SHM_V, pa0, pa1, pa2, pa3);
    if (hi == 0) li_l[r32] = l_reg; asm volatile("s_waitcnt lgkmcnt(0)" ::: "memory");
    float rli[16];
#pragma unroll
    for (int r = 0; r < 16; ++r) rli[r] = __builtin_amdgcn_rcpf(li_l[crow(r, hi)]);
    bf16_t* Ow = Ob + (size_t)(wid * 32) * LDO;
#pragma unroll
    for (int r = 0; r < 16; ++r) { const int orow = crow(r, hi);
#pragma unroll
        for (int d0 = 0; d0 < 2; ++d0) Ow[(size_t)orow * LDO + d0 * 32 + r32] = f2bf(o[d0][r] * rli[r]); }
    asm volatile("s_waitcnt vmcnt(0)" ::: "memory");
    __syncthreads();
#undef SLOAD
#undef SWRITE
#undef SWAIT
#undef RESC
}
}

DI int scan_tok(int base, int dir, int n) { return base + (dir == 0 ? n : (n < CTXL ? (CTXL - 1 - n) : (SB + CTXL - 1 - n))); }
DI void cvt8(const bf16x8 v, float (&f)[8]) {
    const u32x4 w = __builtin_bit_cast(u32x4, v);
    f[0] = lo_f(w.x); f[1] = hi_f(w.x); f[2] = lo_f(w.y); f[3] = hi_f(w.y); f[4] = lo_f(w.z); f[5] = hi_f(w.z); f[6] = lo_f(w.w); f[7] = hi_f(w.w);
}
DI void rwkv_scan_item(const Ctx& C, int b, int h, int dir) {
    constexpr int TC = 32, ARR = TC * 64;
    LAS float* buf = (LAS float*)C.lds;
    LAS float* yL = (LAS float*)(C.lds + 2 * 6 * ARR * 4);
    const int tid = C.tid, i0 = tid >> 4, cgp = tid & 15;
    const int base = b * SB;
    const bf16_t* ACT = C.act(); const bf16_t* O0 = C.ops(0); const bf16_t* OW = C.ops(1 + dir);
    bf16_t* ydst = C.pbuf() + (dir ? C_YB : C_YF) + h * 64;
    float S0[4] = {0.f, 0.f, 0.f, 0.f}, S1[4] = {0.f, 0.f, 0.f, 0.f};
    const int sidx = tid & 255, sti = sidx >> 3, spart = sidx & 7, styp = tid >> 8;
    bf16x8 la, lb, lc, ld; la = lb = lc = ld = (bf16x8){0, 0, 0, 0, 0, 0, 0, 0};
#define RW_LOAD(c) do { const int tk = scan_tok(base, dir, (c) * TC + sti); const bf16_t* ar = ACT + (size_t)tk * DM + h * 64 + spart * 8; \
        la = *(const bf16x8*)(ar + (styp ? 256 : 0)); \
        lb = styp ? *(const bf16x8*)(OW + (size_t)tk * 256 + h * 64 + spart * 8) : *(const bf16x8*)(ar + 512); \
        if (styp == 0) { lc = *(const bf16x8*)(O0 + (size_t)tk * 256 + h * 64 + spart * 8); ld = *(const bf16x8*)(ar + 768); } } while (0)
#define RW_WRITE(nb) do { LAS float* B = buf + (nb) * 6 * ARR; float f[8]; const int o = sti * 64 + spart * 8; \
        cvt8(la, f); { LAS float* d = B + (styp ? 3 : 4) * ARR + o; *(LAS f32x4*)d = (f32x4){f[0], f[1], f[2], f[3]}; *(LAS f32x4*)(d + 4) = (f32x4){f[4], f[5], f[6], f[7]}; } \
        cvt8(lb, f); if (styp) { LAS float* d = B + 1 * ARR + o; *(LAS f32x4*)d = (f32x4){1.f - f[0], 1.f - f[1], 1.f - f[2], 1.f - f[3]}; *(LAS f32x4*)(d + 4) = (f32x4){1.f - f[4], 1.f - f[5], 1.f - f[6], 1.f - f[7]}; } \
        else { LAS float* d = B + 5 * ARR + o; *(LAS f32x4*)d = (f32x4){f[0], f[1], f[2], f[3]}; *(LAS f32x4*)(d + 4) = (f32x4){f[4], f[5], f[6], f[7]}; } \
        if (styp == 0) { cvt8(lc, f); { LAS float* d = B + 0 * ARR + o; *(LAS f32x4*)d = (f32x4){f[0], f[1], f[2], f[3]}; *(LAS f32x4*)(d + 4) = (f32x4){f[4], f[5], f[6], f[7]}; } \
            cvt8(ld, f); { LAS float* d = B + 2 * ARR + o; *(LAS f32x4*)d = (f32x4){f[0], f[1], f[2], f[3]}; *(LAS f32x4*)(d + 4) = (f32x4){f[4], f[5], f[6], f[7]}; } } } while (0)
    constexpr int NCH = SB / TC;
    RW_LOAD(0); RW_WRITE(0); __syncthreads();
    for (int c = 0; c < NCH; ++c) {
        const int cur = c & 1;
        if (c + 1 < NCH) RW_LOAD(c + 1);
        const LAS float* B = buf + cur * 6 * ARR;
#pragma unroll 4
        for (int t = 0; t < TC; ++t) {
            const f32x4 kk4 = *(const LAS f32x4*)(B + 0 * ARR + t * 64 + cgp * 4), w4 = *(const LAS f32x4*)(B + 1 * ARR + t * 64 + cgp * 4),
                        b4 = *(const LAS f32x4*)(B + 2 * ARR + t * 64 + cgp * 4), k4 = *(const LAS f32x4*)(B + 3 * ARR + t * 64 + cgp * 4),
                        r4 = *(const LAS f32x4*)(B + 4 * ARR + t * 64 + cgp * 4);
            const float v0 = B[5 * ARR + t * 64 + i0], v1 = B[5 * ARR + t * 64 + i0 + 32];
            float d0 = S0[0] * kk4[0] + S0[1] * kk4[1] + S0[2] * kk4[2] + S0[3] * kk4[3];
            float d1 = S1[0] * kk4[0] + S1[1] * kk4[1] + S1[2] * kk4[2] + S1[3] * kk4[3];
            d0 = row16_sum(d0); d1 = row16_sum(d1);
            float y0 = 0.f, y1 = 0.f;
#pragma unroll
            for (int j = 0; j < 4; ++j) {
                S0[j] = fmaf(S0[j], w4[j], fmaf(-d0, b4[j], v0 * k4[j]));
                S1[j] = fmaf(S1[j], w4[j], fmaf(-d1, b4[j], v1 * k4[j]));
                y0 = fmaf(S0[j], r4[j], y0); y1 = fmaf(S1[j], r4[j], y1); }
            y0 = row16_sum(y0); y1 = row16_sum(y1);
            if (cgp == 0) { yL[t * 64 + i0] = y0; yL[t * 64 + i0 + 32] = y1; }
        }
        __syncthreads();
        { const int ti = tid >> 4, c4 = (tid & 15) * 4; const f32x4 y = *(const LAS f32x4*)(yL + ti * 64 + c4);
          const int tk = scan_tok(base, dir, c * TC + ti); u32x2 w; w.x = pk2(y[0], y[1]); w.y = pk2(y[2], y[3]);
          *(u32x2*)(ydst + (size_t)tk * NPC + c4) = w; }
        if (c + 1 < NCH) RW_WRITE(cur ^ 1);
        __syncthreads();
    }
#undef RW_LOAD
#undef RW_WRITE
}

DI f32x4 mma16(const LAS bf16_t* A, int lda, const LAS bf16_t* Bm, int ldb, int ksteps, int lane, f32x4 acc) {
    for (int ks = 0; ks < ksteps; ++ks) {
        const bf16x8 a = *(const LAS bf16x8*)(A + (lane & 15) * lda + ks * 32 + 8 * (lane >> 4));
        const bf16x8 b = *(const LAS bf16x8*)(Bm + (lane & 15) * ldb + ks * 32 + 8 * (lane >> 4));
        acc = __builtin_amdgcn_mfma_f32_16x16x32_bf16(a, b, acc, 0, 0, 0); }
    return acc;
}
DI void retention_item(const Ctx& C, int l, int b, int h, int dir) {
    constexpr int LQ = 72, LT = 136;
    LAS bf16_t* Qs = (LAS bf16_t*)C.lds;
    LAS bf16_t* Ks = Qs + 128 * LQ;
    LAS bf16_t* Kzt = Ks + 128 * LQ;
    LAS bf16_t* Vt = Kzt + 64 * LT;
    LAS bf16_t* At = Vt + 64 * LT;
    LAS bf16_t* rT = At + 128 * LT;
    const int tid = C.tid, lane = C.lane, wave = C.wave; const int base = b * SB;
    const float x = C.in[15][(l * 2 + dir) * 4 + h];
    const float lg2 = -log1pf(__expf(-x)) * 1.4426950408889634f;
    const float gchunk = exp2f(lg2 * 128.f);
    bf16_t* Pp = C.pbuf(); bf16_t* odst = Pp + (dir ? C_OB : C_OF) + h * 64;
    f32x4 rst[2] = {{0.f, 0.f, 0.f, 0.f}, {0.f, 0.f, 0.f, 0.f}};
    for (int i = tid; i < 64 * LQ; i += NTHR) rT[i] = 0;
    const int si = tid >> 2, sp = tid & 3;
    bf16x8 gq[2], gk[2], gv[2];
#define RT_LOAD(c) do { const int tk = scan_tok(base, dir, (c) * 128 + si); const bf16_t* pr = Pp + (size_t)tk * NPC + h * 64 + sp * 16; \
        gq[0] = *(const bf16x8*)(pr + C_RQ); gq[1] = *(const bf16x8*)(pr + C_RQ + 8); gk[0] = *(const bf16x8*)(pr + C_RK); gk[1] = *(const bf16x8*)(pr + C_RK + 8); \
        gv[0] = *(const bf16x8*)(pr + C_RV); gv[1] = *(const bf16x8*)(pr + C_RV + 8); } while (0)
    RT_LOAD(0);
    __syncthreads();
    for (int c = 0; c < 34; ++c) {
        { *(LAS bf16x8*)(Qs + si * LQ + sp * 16) = gq[0]; *(LAS bf16x8*)(Qs + si * LQ + sp * 16 + 8) = gq[1];
          *(LAS bf16x8*)(Ks + si * LQ + sp * 16) = gk[0]; *(LAS bf16x8*)(Ks + si * LQ + sp * 16 + 8) = gk[1];
          const float zeta = exp2f(lg2 * (float)(127 - si));
#pragma unroll
          for (int hh = 0; hh < 2; ++hh) { float f[8]; cvt8(gk[hh], f);
#pragma unroll
              for (int j = 0; j < 8; ++j) Kzt[(sp * 16 + hh * 8 + j) * LT + si] = f2bf(f[j] * zeta);
#pragma unroll
              for (int j = 0; j < 8; ++j) Vt[(sp * 16 + hh * 8 + j) * LT + si] = (bf16_t)gv[hh][j]; } }
        __syncthreads();
        if (c + 1 < 34) RT_LOAD(c + 1);
        { const LAS bf16_t* Aq = Qs + (wave * 16) * LQ;
#pragma unroll
          for (int nt = 0; nt < 8; ++nt) { f32x4 acc = {0.f, 0.f, 0.f, 0.f}; acc = mma16(Aq, LQ, Ks + (nt * 16) * LQ, LQ, 2, lane, acc);
              const int j = nt * 16 + (lane & 15);
#pragma unroll
              for (int r = 0; r < 4; ++r) { const int i = wave * 16 + 4 * (lane >> 4) + r; const float dm = (i >= j) ? exp2f(lg2 * (float)(i - j)) : 0.f;
                  At[i * LT + j] = f2bf(acc[r] * dm); } } }
        asm volatile("s_waitcnt lgkmcnt(0)" ::: "memory");
        __builtin_amdgcn_wave_barrier();
        { const LAS bf16_t* Aa = At + (wave * 16) * LT; const LAS bf16_t* Aq = Qs + (wave * 16) * LQ;
#pragma unroll
          for (int nt = 0; nt < 4; ++nt) { f32x4 a1 = {0.f, 0.f, 0.f, 0.f}, a2 = {0.f, 0.f, 0.f, 0.f};
              a1 = mma16(Aa, LT, Vt + (nt * 16) * LT, LT, 4, lane, a1);
              a2 = mma16(Aq, LQ, rT + (nt * 16) * LQ, LQ, 2, lane, a2);
              const int dv = nt * 16 + (lane & 15);
#pragma unroll
              for (int r = 0; r < 4; ++r) { const int i = wave * 16 + 4 * (lane >> 4) + r; const float xi = exp2f(lg2 * (float)(i + 1));
                  const int tk = scan_tok(base, dir, c * 128 + i);
                  odst[(size_t)tk * NPC + dv] = f2bf(a1[r] + a2[r] * xi); } } }
        __syncthreads();
        { const int mt = wave >> 1;
#pragma unroll
          for (int i2 = 0; i2 < 2; ++i2) { const int nt = 2 * (wave & 1) + i2; f32x4 acc = {0.f, 0.f, 0.f, 0.f};
              acc = mma16(Kzt + (mt * 16) * LT, LT, Vt + (nt * 16) * LT, LT, 4, lane, acc);
              rst[i2] = rst[i2] * gchunk + acc;
              const int dv = nt * 16 + (lane & 15), dk0 = mt * 16 + 4 * (lane >> 4);
              u32x2 w; w.x = pk2(rst[i2][0], rst[i2][1]); w.y = pk2(rst[i2][2], rst[i2][3]);
              *(LAS u32x2*)(rT + dv * LQ + dk0) = w; } }
        __syncthreads();
    }
#undef RT_LOAD
}

DI void phase_mixers(const Ctx& C0, int l) {
    LAS int* slot = (LAS int*)(C0.lds + LDS_BYTES - 16);
    const int n_att = (l == 0) ? 1024 + 64 : 1024;
    const int total = 128 + n_att;
    for (;;) {
        __syncthreads();
        if (C0.tid == 0) *slot = atomicAdd(C0.cnt() + l, 1);
        __syncthreads();
        const int it = *slot;
        if (it >= total) break;
        Ctx C2 = C0; asm volatile("" : "+v"(C2.tid)); C2.lane = C2.tid & 63; C2.wave = __builtin_amdgcn_readfirstlane(C2.tid >> 6); const Ctx& C = C2;
        if (it < 64) rwkv_scan_item(C, it >> 3, (it >> 1) & 3, it & 1);
        else if (it < 128) { const int r = it - 64; retention_item(C, l, r >> 3, (r >> 1) & 3, r & 1); }
        else {
            int a = it - 128; int b, h, q0, seq;
            if (a < 1024) { b = a >> 7; h = (a >> 4) & 7; q0 = CTXL + (a & 15) * 256; seq = SB; }
            else { a -= 1024; b = a >> 3; h = a & 7; q0 = 0; seq = CTXL; }
            const size_t tb = (size_t)b * SB;
            att::attn_body(C.qkv() + (tb + q0) * QKVC + h * 96, C.kf() + tb * 768 + h * 96, C.qkv() + tb * QKVC + 768 + h * 128 + 64,
                           C.pbuf() + (tb + q0) * NPC + h * 64, seq, (LAS char*)C.lds, C.tid);
        }
    }
}

DI void phase_finish(const Ctx& C, int l) {
    const int gw = C.bid * 8 + C.wave, GW = C.G * 8, lane = C.lane, c4 = lane * 4, head = lane >> 4;
    const f32x4 gnw = *(const f32x4*)(C.in[16] + l * 256 + c4), lnw = *(const f32x4*)(C.in[26] + l * 256 + c4);
    for (int tok = gw; tok < T; tok += GW) {
        if (l == 1 && (tok % SB) < CTXL) continue;
        const bf16_t* pr = C.pbuf() + (size_t)tok * NPC; bf16_t* ar = C.act() + (size_t)tok * DM;
        const u32x4 attc = *(const u32x4*)(pr + lane * 8);
        const u32x2 of = *(const u32x2*)(pr + C_OF + c4), ob = *(const u32x2*)(pr + C_OB + c4), gg = *(const u32x2*)(pr + C_RG + c4);
        const u32x2 yf = *(const u32x2*)(pr + C_YF + c4), yb = *(const u32x2*)(pr + C_YB + c4);
        const u32x2 vv = *(const u32x2*)(ar + 512 + c4), gt = *(const u32x2*)(C.ops(3) + (size_t)tok * 256 + c4);
        const float bon = C.bonus()[(size_t)tok * 4 + head];
        f32x4 o = {lo_f(of.x) + lo_f(ob.x), hi_f(of.x) + hi_f(ob.x), lo_f(of.y) + lo_f(ob.y), hi_f(of.y) + hi_f(ob.y)};
        float mu = row16_sum(o[0] + o[1] + o[2] + o[3]) * (1.f / 64.f);
        f32x4 d = o - mu; float var = row16_sum(d[0] * d[0] + d[1] * d[1] + d[2] * d[2] + d[3] * d[3]) * (1.f / 64.f);
        float eps1 = 1e-5f, eps2 = 64e-5f; asm volatile("" : "+v"(eps1), "+v"(eps2));
        float rs = rsqrtf(var + eps1);
        const f32x4 g = {lo_f(gg.x), hi_f(gg.x), lo_f(gg.y), hi_f(gg.y)};
        f32x4 r1; r1[0] = d[0] * rs * gnw[0] * siluf_(g[0]); r1[1] = d[1] * rs * gnw[1] * siluf_(g[1]); r1[2] = d[2] * rs * gnw[2] * siluf_(g[2]); r1[3] = d[3] * rs * gnw[3] * siluf_(g[3]);
        f32x4 y = {lo_f(yf.x) + lo_f(yb.x), hi_f(yf.x) + hi_f(yb.x), lo_f(yf.y) + lo_f(yb.y), hi_f(yf.y) + hi_f(yb.y)};
        mu = row16_sum(y[0] + y[1] + y[2] + y[3]) * (1.f / 64.f);
        d = y - mu; var = row16_sum(d[0] * d[0] + d[1] * d[1] + d[2] * d[2] + d[3] * d[3]) * (1.f / 64.f);
        rs = rsqrtf(var + eps2);
        const f32x4 v = {lo_f(vv.x), hi_f(vv.x), lo_f(vv.y), hi_f(vv.y)}, gate = {lo_f(gt.x), hi_f(gt.x), lo_f(gt.y), hi_f(gt.y)};
        const f32x4 r2 = (d * rs * lnw + v * bon) * gate;
        *(u32x4*)(ar + lane * 8) = attc;
        u32x2 w; w.x = pk2(r1[0], r1[1]); w.y = pk2(r1[2], r1[3]); *(u32x2*)(ar + 512 + c4) = w;
        w.x = pk2(r2[0], r2[1]); w.y = pk2(r2[2], r2[3]); *(u32x2*)(ar + 768 + c4) = w;
    }
}

DI void phase_h_router(const Ctx& C, int l, const float* lat, const float* ctxp) {
    LAS float* rw = (LAS float*)C.lds;
    { const float* src = C.in[28] + (size_t)l * 16384; for (int i = C.tid; i < 4096; i += NTHR) *(LAS f32x4*)(rw + i * 4) = *(const f32x4*)(src + i * 4); }
    __syncthreads();
    const int gw = C.bid * 8 + C.wave, GW = C.G * 8, lane = C.lane;
    const float* nw = C.in[7] + l * 1024;
    for (int tok = gw; tok < T; tok += GW) {
        const int b = tok / SB, s = tok - b * SB; if (l == 1 && s < CTXL) continue;
        const float* xr = tok_row(lat, ctxp, tok); const float* modrow = C.modv(l) + (size_t)((s < CTXL) ? 8 : b) * 6144;
        f32x4 v[4];
#pragma unroll
        for (int j = 0; j < 4; ++j) v[j] = *(const f32x4*)(xr + j * 256 + lane * 4);
        float ss = 0.f;
#pragma unroll
        for (int j = 0; j < 4; ++j) ss += v[j][0] * v[j][0] + v[j][1] * v[j][1] + v[j][2] * v[j][2] + v[j][3] * v[j][3];
        ss = wave_sum(ss); const float rstd = rsqrtf(ss * (1.f / 1024.f) + 1e-6f);
        float lg[16];
#pragma unroll
        for (int e = 0; e < 16; ++e) lg[e] = 0.f;
        bf16_t* dst = C.act() + (size_t)tok * DM;
#pragma unroll
        for (int j = 0; j < 4; ++j) { const int c = j * 256 + lane * 4;
            const f32x4 w = *(const f32x4*)(nw + c), sc = *(const f32x4*)(modrow + 4096 + c), sh = *(const f32x4*)(modrow + 3072 + c);
            const f32x4 hv = v[j] * rstd * w * (sc + 1.f) + sh;
            u32x2 pkd; pkd.x = pk2(hv[0], hv[1]); pkd.y = pk2(hv[2], hv[3]); *(u32x2*)(dst + c) = pkd;
#pragma unroll
            for (int q = 0; q < 4; ++q) { const LAS float* rr = rw + (c + q) * 16;
                const f32x4 r0 = *(const LAS f32x4*)rr, r1 = *(const LAS f32x4*)(rr + 4), r2 = *(const LAS f32x4*)(rr + 8), r3 = *(const LAS f32x4*)(rr + 12);
                lg[0] += hv[q] * r0[0]; lg[1] += hv[q] * r0[1]; lg[2] += hv[q] * r0[2]; lg[3] += hv[q] * r0[3];
                lg[4] += hv[q] * r1[0]; lg[5] += hv[q] * r1[1]; lg[6] += hv[q] * r1[2]; lg[7] += hv[q] * r1[3];
                lg[8] += hv[q] * r2[0]; lg[9] += hv[q] * r2[1]; lg[10] += hv[q] * r2[2]; lg[11] += hv[q] * r2[3];
                lg[12] += hv[q] * r3[0]; lg[13] += hv[q] * r3[1]; lg[14] += hv[q] * r3[2]; lg[15] += hv[q] * r3[3]; } }
#pragma unroll
        for (int e = 0; e < 16; ++e) lg[e] = wave_sum(lg[e]);
        float mx = lg[0];
#pragma unroll
        for (int e = 1; e < 16; ++e) mx = fmaxf(mx, lg[e]);
        float den = 0.f, mine = 0.f;
#pragma unroll
        for (int e = 0; e < 16; ++e) { const float ex = __expf(lg[e] - mx); den += ex; if (lane == e) mine = ex; }
        if (lane < 16) { const float a = mine / den;
            if (s < CTXL) ((float*)(C.ws + OFF_AFFC))[(size_t)(b * 16 + lane) * CTXL + s] = a;
            else ((float*)(C.ws + OFF_AFFL))[(size_t)(b * 16 + lane) * SEQ + (s - CTXL)] = a; }
    }
}

DI void select_item(const Ctx& C, const float* aff, int n, int cap, int rowbase, int tokbase, int* inv  ) {
    LAS unsigned* keys = (LAS unsigned*)C.lds;
    LAS int* cnt = (LAS int*)(C.lds + 16384);
    LAS int* wsum = cnt + 64;
    const int tid = C.tid; const int m = (n + NTHR - 1) / NTHR;
    for (int i = tid; i < n; i += NTHR) keys[i] = __float_as_uint(aff[i]);
    if (tid < 40) cnt[tid] = 0;
    __syncthreads();
    unsigned prefix = 0u;
    for (int bit = 31; bit >= 0; --bit) {
        const unsigned cand = prefix | (1u << bit); int c = 0;
        for (int i = tid; i < n; i += NTHR) c += (keys[i] >= cand) ? 1 : 0;
        c = (int)wave_sum((float)c);
        if (C.lane == 0 && c) atomicAdd((int*)&cnt[bit], c);
        __syncthreads();
        if (cnt[bit] >= cap) prefix = cand;
    }
    const unsigned thr = prefix;
    int gtc = 0, eqc = 0;
    for (int q = 0; q < m; ++q) { const int i = tid * m + q; if (i < n) { const unsigned k = keys[i]; gtc += (k > thr); eqc += (k == thr); } }
    int g = gtc, e = eqc;
    for (int o = 1; o < 64; o <<= 1) { const int g2 = __shfl_up(g, o), e2 = __shfl_up(e, o); if (C.lane >= o) { g += g2; e += e2; } }
    if (C.lane == 63) { wsum[C.wave] = g; wsum[8 + C.wave] = e; }
    __syncthreads();
    int gb = 0, eb = 0, gtot = 0;
    for (int w = 0; w < 8; ++w) { if (w < C.wave) { gb += wsum[w]; eb += wsum[8 + w]; } gtot += wsum[w]; }
    int gpre = gb + g - gtc, epre = eb + e - eqc;
    const int need_eq = cap - gtot;
    int* idx = (int*)(C.ws + OFF_IDX); float* gate = (float*)(C.ws + OFF_GATE);
    for (int q = 0; q < m; ++q) { const int i = tid * m + q; if (i < n) { const unsigned k = keys[i];
        const bool sel = (k > thr) || (k == thr && epre < need_eq);
        const int sl = gpre + (epre < need_eq ? epre : need_eq);
        if (sel) { idx[rowbase + sl] = tokbase + i; gate[rowbase + sl] = __uint_as_float(k); }
        inv[(size_t)i * 16] = sel ? (rowbase + sl) : -1;
        gpre += (k > thr); epre += (k == thr); } }
    asm volatile("s_waitcnt vmcnt(0)" ::: "memory");
    __syncthreads();
    bf16_t* xe = (bf16_t*)(C.ws + OFF_ARENA + AR_XE);
    for (int sl = C.wave; sl < cap; sl += 8) { const int tk = idx[rowbase + sl];
        const u32x4* src = (const u32x4*)(C.act() + (size_t)tk * DM); u32x4* dst = (u32x4*)(xe + (size_t)(rowbase + sl) * DM);
        dst[C.lane] = src[C.lane]; dst[64 + C.lane] = src[64 + C.lane]; }
    __syncthreads();
}
DI void phase_select(const Ctx& C, int l) {
    const int nitems = (l == 0) ? 256 : 128;
    for (int it = C.bid; it < nitems; it += C.G) {
        if (it < 128) { const int b = it >> 4, e = it & 15;
            select_item(C, (const float*)(C.ws + OFF_AFFL) + (size_t)(b * 16 + e) * SEQ, SEQ, CAPL, e * 4096 + b * 512, b * SB + CTXL, (int*)(C.ws + OFF_INVL) + (size_t)b * SEQ * 16 + e); }
        else { const int a = it - 128, b = a >> 4, e = a & 15;
            select_item(C, (const float*)(C.ws + OFF_AFFC) + (size_t)(b * 16 + e) * CTXL, CTXL, CAPC, XE_LROWS + e * 256 + b * 32, b * SB, (int*)(C.ws + OFF_INVC) + (size_t)b * CTXL * 16 + e); }
    }
    { Ctx C2 = C; asm volatile("" : "+v"(C2.tid)); C2.lane = C2.tid & 63; C2.wave = __builtin_amdgcn_readfirstlane(C2.tid >> 6); phase_wconv_experts(C2, l); }
}

DI void phase_combine(const Ctx& C, int l, float* lat, float* ctxp) {
    const int gw = C.bid * 8 + C.wave, GW = C.G * 8, lane = C.lane;
    const bf16_t* ye = (const bf16_t*)(C.ws + OFF_ARENA + AR_XE);
    for (int tok = gw; tok < T; tok += GW) {
        const int b = tok / SB, s = tok - b * SB; if (l == 1 && s < CTXL) continue;
        float* xr = (s < CTXL) ? ctxp + (size_t)(b * CTXL + s) * DM : lat + (size_t)(b * SEQ + s - CTXL) * DM;
        const float* modrow = C.modv(l) + (size_t)((s < CTXL) ? 8 : b) * 6144;
        const int* inv = (s < CTXL) ? (const int*)(C.ws + OFF_INVC) + (size_t)(b * CTXL + s) * 16 : (const int*)(C.ws + OFF_INVL) + (size_t)(b * SEQ + s - CTXL) * 16;
        f32x4 acc[4];
#pragma unroll
        for (int j = 0; j < 4; ++j) acc[j] = (f32x4){0.f, 0.f, 0.f, 0.f};
        for (int e = 0; e < 16; ++e) { const int r = inv[e]; if (r >= 0) { const bf16_t* yr = ye + (size_t)r * DM + lane * 4;
#pragma unroll
            for (int j = 0; j < 4; ++j) { const u32x2 w = *(const u32x2*)(yr + j * 256); acc[j][0] += lo_f(w.x); acc[j][1] += hi_f(w.x); acc[j][2] += lo_f(w.y); acc[j][3] += hi_f(w.y); } } }
        f32x4 v[4];
#pragma unroll
        for (int j = 0; j < 4; ++j) { const int c = j * 256 + lane * 4; const f32x4 xo = *(const f32x4*)(xr + c), ga = *(const f32x4*)(modrow + 5120 + c);
            v[j] = xo + ga * acc[j]; *(f32x4*)(xr + c) = v[j]; }
        if (l == 0) norm_mod_store(v, C.in[6] + 1024, C.modv(1) + (size_t)((s < CTXL) ? 8 : b) * 6144, 0, 1024, C.act() + (size_t)tok * DM, lane);
    }
}


#ifdef DIAG
DI void diag_scan(const Ctx& C, int code, const void* ptr, size_t bytes, bool isbf) {
    const u32x4* p = (const u32x4*)ptr; const size_t n = bytes / 16; bool bad = false;
    for (size_t i = (size_t)C.bid * NTHR + C.tid; i < n; i += (size_t)C.G * NTHR) { const u32x4 v = p[i];
#pragma unroll
        for (int q = 0; q < 4; ++q) { const unsigned w = v[q];
            if (isbf) { const unsigned a = w & 0x7fffu, b = (w >> 16) & 0x7fffu; bad |= (a >= 0x5000u) || (b >= 0x5000u); }
            else bad |= ((w & 0x7fffffffu) >= 0x50000000u); } }
    if (__any(bad) && C.lane == 0) atomicAdd((int*)(C.ws + OFF_CNT) + 64 + code, 1);
}
DI void diag_maxexp(const Ctx& C, int code, const void* ptr, size_t bytes) {
    const u32x4* p = (const u32x4*)ptr; const size_t n = bytes / 16; unsigned mx = 0; int nb = 0;
    for (size_t i = (size_t)C.bid * NTHR + C.tid; i < n; i += (size_t)C.G * NTHR) { const u32x4 v = p[i]; unsigned m = 0;
#pragma unroll
        for (int q = 0; q < 4; ++q) { const unsigned w = v[q]; const unsigned a = (w >> 7) & 0xffu, b = (w >> 23) & 0xffu; m = m > a ? m : a; m = m > b ? m : b; }
        mx = mx > m ? mx : m; nb += (m >= 160u); }
    atomicMax((int*)(C.ws + OFF_CNT) + 64 + code, (int)mx); if (nb) atomicAdd((int*)(C.ws + OFF_CNT) + 64 + code + 1, nb);
}
DI void diag_out(const Ctx& C) {
    const int* cnts = (const int*)(C.ws + OFF_CNT) + 64; int first = -1;
    for (int i = 0; i < 40; ++i) { const int v = __hip_atomic_load(cnts + i, __ATOMIC_RELAXED, __HIP_MEMORY_SCOPE_AGENT); if (v != 0 && first < 0) first = i; }
#ifdef DIAG_VAL
    const float K = 1000.f * (1.f + (float)__hip_atomic_load(cnts + DIAG_VAL, __ATOMIC_RELAXED, __HIP_MEMORY_SCOPE_AGENT));
#elif defined(DIAG_SEL)
    int mask = 0; for (int i = 0; i < 4; ++i) if (__hip_atomic_load(cnts + DIAG_SEL + i, __ATOMIC_RELAXED, __HIP_MEMORY_SCOPE_AGENT) != 0) mask |= 1 << i;
    const float K = 1000.f * (float)(1 + mask);
#else
    const float K = (first < 0) ? 1000.f : 1000.f * exp2f((float)(first + 1));
#endif
    const size_t n = (size_t)NBATCH * SEQ * DM / 4;
    for (size_t i = (size_t)C.bid * NTHR + C.tid; i < n; i += (size_t)C.G * NTHR) { const f32x4 v = ((const f32x4*)C.in[0])[i]; ((f32x4*)C.out)[i] = v * K; }
}
#define DSCAN(code, ptr, bytes, isbf) diag_scan(C, code, ptr, bytes, isbf)
#else
#define DSCAN(code, ptr, bytes, isbf) do {} while (0)
#endif

#ifdef PHASE_TEST
#define MKCTX() extern __shared__ __attribute__((aligned(16))) unsigned char smem[]; Ctx C; C.in = prm.in; C.out = prm.out; C.ws = prm.ws; C.G = gridDim.x; C.bid = blockIdx.x; C.tid = threadIdx.x; \
    C.wave = __builtin_amdgcn_readfirstlane(threadIdx.x >> 6); C.lane = threadIdx.x & 63; C.lds = (LAS unsigned char*)smem;
__global__ void __launch_bounds__(NTHR, 2) t_mod(Params prm) { MKCTX(); phase_mod(C); }
__global__ void __launch_bounds__(NTHR, 2) t_wconv(Params prm) { MKCTX(); phase_wconv_small(C); phase_wconv_experts(C, 1); }
__global__ void __launch_bounds__(NTHR, 2) t_u(Params prm) { MKCTX(); phase_u(C, 0, C.in[0], C.in[2]); }
__global__ void __launch_bounds__(NTHR, 2) t_gemm_bf(Params prm) { MKCTX(); pg8::Gemm g{C.act(), C.wsm(0, WSM_WIN), DM, DM, DM}; pg8::Sched S; S.init(T / 256, NPC / 256, C.G, C.bid, 0); pg8::EpiBf16 E{C.pbuf(), NPC}; pg8::gemm_phase(C.lds, g, S, E, C.tid); }
__global__ void __launch_bounds__(NTHR, 2) t_gemm_res(Params prm) { MKCTX(); pg8::Gemm g{C.act(), C.wsm(0, WSM_WOUT), DM, DM, DM}; pg8::Sched S; S.init(128, 4, C.G, C.bid, 1); pg8::EpiResid E{C.in[0], C.in[2], C.out, C.xc(), C.modv(0)}; pg8::gemm_phase(C.lds, g, S, E, C.tid); }
__global__ void __launch_bounds__(NTHR, 2) t_gemm_sw(Params prm) { MKCTX(); pg8::Gemm g{C.act(), C.wsm(0, WSM_WOUT), DM, DM, DM}; pg8::Sched S; S.init(272, 8, C.G, C.bid, 2); pg8::EpiSwiglu E{C.pbuf(), DM}; pg8::gemm_phase(C.lds, g, S, E, C.tid); }
__global__ void __launch_bounds__(NTHR, 2) t_gemm_gate(Params prm) { MKCTX(); pg8::Gemm g{C.act(), C.wsm(0, WSM_WOUT), DM, DM, DM}; pg8::Sched S; S.init(272, 4, C.G, C.bid, 2); pg8::EpiGate E{C.pbuf(), DM, (const float*)(C.ws + OFF_GATE)}; pg8::gemm_phase(C.lds, g, S, E, C.tid); }
__global__ void __launch_bounds__(NTHR, 2) t_rwkv_prep(Params prm) { MKCTX(); phase_rwkv_prep(C, 0); }
__global__ void __launch_bounds__(NTHR, 2) t_ret_prep(Params prm) { MKCTX(); phase_ret_prep(C); }
__global__ void __launch_bounds__(NTHR, 2) t_qk(Params prm) { MKCTX(); phase_qk_final(C, 0); }
__global__ void __launch_bounds__(NTHR, 2) t_attn(Params prm) { MKCTX(); att::attn_body(C.qkv(), C.kf(), C.qkv(), C.pbuf(), SB, (LAS char*)C.lds, C.tid); }
__global__ void __launch_bounds__(NTHR, 2) t_rwkv(Params prm) { MKCTX(); rwkv_scan_item(C, 0, 1, C.bid & 1); }
__global__ void __launch_bounds__(NTHR, 2) t_ret(Params prm) { MKCTX(); retention_item(C, 0, 0, 1, C.bid & 1); }
__global__ void __launch_bounds__(NTHR, 2) t_finish(Params prm) { MKCTX(); phase_finish(C, 0); }
__global__ void __launch_bounds__(NTHR, 2) t_router(Params prm) { MKCTX(); phase_h_router(C, 0, C.out, C.xc()); }
__global__ void __launch_bounds__(NTHR, 2) t_select(Params prm) { MKCTX(); phase_select(C, 0); }
__global__ void __launch_bounds__(NTHR, 2) t_combine(Params prm) { MKCTX(); phase_combine(C, 0, C.out, C.xc()); }
#endif

__global__ void __launch_bounds__(NTHR, 2) hybrid_fwd(Params prm) {
    extern __shared__ __attribute__((aligned(16))) unsigned char smem[];
    cg::grid_group grid = cg::this_grid();
    Ctx C; C.in = prm.in; C.out = prm.out; C.ws = prm.ws; C.G = gridDim.x; C.bid = blockIdx.x; C.tid = threadIdx.x;
    C.wave = __builtin_amdgcn_readfirstlane(threadIdx.x >> 6); C.lane = threadIdx.x & 63; C.lds = (LAS unsigned char*)smem;
#define GRID_SYNC() do { asm volatile("s_waitcnt vmcnt(0) lgkmcnt(0)" ::: "memory"); __syncthreads(); grid.sync(); asm volatile("s_waitcnt vmcnt(0)" ::: "memory"); __syncthreads(); PH(); } while (0)
#define PH() do { asm volatile("" : "+v"(C.tid)); C.lane = C.tid & 63; C.wave = __builtin_amdgcn_readfirstlane(C.tid >> 6); } while (0)
    PH();
    phase_mod(C);
    PH();
    phase_wconv_small(C);
    GRID_SYNC();
    DSCAN(0, C.ws + OFF_MOD, 2 * 9 * 6144 * 4, false); DSCAN(1, C.ws + OFF_WSM, 2 * WSM_STRIDE, true);
#pragma unroll 1
    for (int l = 0; l < 2; ++l) {
#define xl_in ((l == 0) ? C.in[0] : C.out)
#define xc_in ((l == 0) ? C.in[2] : C.xc())
        if (l == 0) { phase_u(C, 0, xl_in, xc_in); GRID_SYNC(); }
        DSCAN(2 + l * 16 + 0, C.act(), (size_t)T * DM * 2, true);
        { pg8::Gemm g{C.act(), C.wsm(l, WSM_WIN), DM, DM, DM}; pg8::Sched S; S.init(T / 256, NPC / 256, C.G, C.bid, 0);
          pg8::EpiBf16 E{C.pbuf(), NPC}; pg8::gemm_phase(C.lds, g, S, E, C.tid); }
        GRID_SYNC();
        DSCAN(2 + l * 16 + 1, C.pbuf(), (size_t)T * NPC * 2, true);
        { pg8::Gemm g{C.pbuf(), C.wsm(l, WSM_WQKV), NPC, 640, 640}; pg8::Sched S; S.init(T / 256, QKVC / 256, C.G, C.bid, 0);
          pg8::EpiBf16 E{C.qkv(), QKVC}; pg8::gemm_phase(C.lds, g, S, E, C.tid); }
        PH();
        phase_rwkv_prep(C, l);
        GRID_SYNC();
        DSCAN(2 + l * 16 + 2, C.qkv(), (size_t)T * QKVC * 2, true); DSCAN(2 + l * 16 + 3, C.ops(0), 4 * OPS_STRIDE, true); if (l == 0) { DSCAN(40, C.ops(0), OPS_STRIDE, true); DSCAN(41, C.ops(1), OPS_STRIDE, true); DSCAN(42, C.ops(2), OPS_STRIDE, true); DSCAN(43, C.ops(3), OPS_STRIDE, true); } DSCAN(2 + l * 16 + 4, C.act(), (size_t)T * DM * 2, true);
        phase_ret_prep(C);
        PH();
        phase_qk_final(C, l);
        GRID_SYNC();
        DSCAN(2 + l * 16 + 5, C.qkv(), (size_t)T * QKVC * 2, true); DSCAN(2 + l * 16 + 6, C.kf(), (size_t)T * 768 * 2, true); DSCAN(2 + l * 16 + 7, C.pbuf(), (size_t)T * NPC * 2, true);
        phase_mixers(C, l);
        GRID_SYNC();
        if (l == 0) DSCAN(2 + l * 16 + 8, C.pbuf(), (size_t)T * NPC * 2, true);
        phase_finish(C, l);
        GRID_SYNC();
        if (l == 0) DSCAN(2 + l * 16 + 9, C.act(), (size_t)T * DM * 2, true);
        { pg8::Gemm g{C.act(), C.wsm(l, WSM_WOUT), DM, DM, DM}; pg8::Sched S;
          if (l == 0) S.init(T / 256, 4, C.G, C.bid, 0); else S.init(128, 4, C.G, C.bid, 1);
          pg8::EpiResid E{xl_in, xc_in, C.out, C.xc(), C.modv(l)}; pg8::gemm_phase(C.lds, g, S, E, C.tid); }
        GRID_SYNC();
        DSCAN(2 + l * 16 + 10, C.out, (size_t)NBATCH * SEQ * DM * 4, false);
        phase_h_router(C, l, C.out, C.xc());
        GRID_SYNC();
        DSCAN(2 + l * 16 + 11, C.ws + OFF_AFFL, 2 * MiB, false);
        phase_select(C, l);
        GRID_SYNC();
        DSCAN(2 + l * 16 + 12, C.ws + OFF_ARENA + AR_WGU, 96 * MiB, true); DSCAN(2 + l * 16 + 13, C.ws + OFF_ARENA + AR_XE, (size_t)(l == 0 ? XE_ROWS : XE_LROWS) * DM * 2, true);
        { pg8::Gemm g{(const bf16_t*)(C.ws + OFF_ARENA + AR_XE), (const bf16_t*)(C.ws + OFF_ARENA + AR_WGU), DM, DM, DM}; pg8::Sched S;
          S.init(l == 0 ? 272 : 256, 8, C.G, C.bid, 2);
          pg8::EpiSwiglu E{(bf16_t*)(C.ws + OFF_ARENA + AR_HID), DM}; pg8::gemm_phase(C.lds, g, S, E, C.tid); }
        GRID_SYNC();
        DSCAN(2 + l * 16 + 14, C.ws + OFF_ARENA + AR_HID, (size_t)(l == 0 ? XE_ROWS : XE_LROWS) * DM * 2, true);
        { pg8::Gemm g{(const bf16_t*)(C.ws + OFF_ARENA + AR_HID), (const bf16_t*)(C.ws + OFF_ARENA + AR_WD), DM, DM, DM}; pg8::Sched S;
          S.init(l == 0 ? 272 : 256, 4, C.G, C.bid, 2);
          pg8::EpiGate E{(bf16_t*)(C.ws + OFF_ARENA + AR_XE), DM, (const float*)(C.ws + OFF_GATE)}; pg8::gemm_phase(C.lds, g, S, E, C.tid); }
        GRID_SYNC();
        phase_combine(C, l, C.out, C.xc());
        GRID_SYNC();
        DSCAN(2 + l * 16 + 15, C.out, (size_t)NBATCH * SEQ * DM * 4, false);
    }
#ifdef DIAG
    GRID_SYNC();
    diag_out(C);
#endif
}

extern "C" void kernel_launch(void* const* d_in, const int* in_sizes, int n_in, void* d_out, int out_size, void* d_ws, size_t ws_size, hipStream_t stream) {
    static int grid = 0;
    if (grid == 0) {
        int dev = 0, cus = 0, per_cu = 0;
        (void)hipGetDevice(&dev); (void)hipDeviceGetAttribute(&cus, hipDeviceAttributeMultiprocessorCount, dev);
        if (hipFuncSetAttribute((const void*)hybrid_fwd, hipFuncAttributeMaxDynamicSharedMemorySize, LDS_BYTES) != hipSuccess) { fprintf(stderr, "kernel_launch: hipFuncSetAttribute failed\n"); grid = -1; return; }
        if (hipOccupancyMaxActiveBlocksPerMultiprocessor(&per_cu, (const void*)hybrid_fwd, NTHR, LDS_BYTES) != hipSuccess || per_cu < 1) { fprintf(stderr, "kernel_launch: occupancy query gives %d\n", per_cu); grid = -1; return; }
        if (n_in != 32 || ws_size < WS_END) { fprintf(stderr, "kernel_launch: n_in %d ws %zu (need %zu)\n", n_in, ws_size, (size_t)WS_END); grid = -1; return; }
        grid = cus;
    }
    if (grid < 0) return;
    (void)hipMemsetAsync((char*)d_ws + OFF_BAR, 0, 65536, stream);
    Params p{}; for (int i = 0; i < 32; ++i) p.in[i] = (const float*)d_in[i];
    p.out = (float*)d_out; p.ws = (unsigned char*)d_ws; p.G = grid; p.pad = 0;
    void* args[] = {&p};
    hipError_t e = hipLaunchCooperativeKernel((const void*)hybrid_fwd, dim3(grid), dim3(NTHR), args, LDS_BYTES, stream);
    if (e != hipSuccess) fprintf(stderr, "cooperative launch failed: %s (grid %d)\n", hipGetErrorString(e), grid);
}
```

```cpp
#include <hip/hip_runtime.h>
#include <hip/hip_cooperative_groups.h>
#include <cstdio>
#include <cstdint>
namespace cg = cooperative_groups;

typedef unsigned short bf16_t;
typedef short bf16x8 __attribute__((ext_vector_type(8)));
typedef short s16x4 __attribute__((ext_vector_type(4)));
typedef float f32x4 __attribute__((ext_vector_type(4)));
typedef float f32x2 __attribute__((ext_vector_type(2)));
typedef float f32x16 __attribute__((ext_vector_type(16)));
typedef unsigned u32x4 __attribute__((ext_vector_type(4)));
typedef unsigned u32x2 __attribute__((ext_vector_type(2)));
#define LAS __attribute__((address_space(3)))
#define DI __device__ __forceinline__

constexpr int DM = 1024, NBATCH = 8, SEQ = 4096, CTXL = 256, SB = 4352, T = 34816;
constexpr int NPC = 2816;
constexpr int INC = 2784;
constexpr int QKVC = 1792;
constexpr int C_KR = 640, C_RQ = 672, C_RK = 928, C_RV = 1184, C_RG = 1440, C_RW = 1696;
constexpr int C_OF = 1696, C_OB = 1952, C_YF = 2208, C_YB = 2464;
constexpr int NE = 16, CAPL = 512, CAPC = 32;
constexpr int XE_LROWS = 65536, XE_ROWS = 65536 + 4096;
constexpr int NTHR = 512;
constexpr int LDS_BYTES = 160 * 1024;

constexpr size_t MiB = 1048576;
constexpr size_t OFF_BAR = 0, OFF_CNT = 32768, OFF_MOD = 1 * MiB, OFF_BONUS = 2 * MiB, OFF_AFFL = 3 * MiB, OFF_AFFC = 5 * MiB,
                 OFF_IDX = 6 * MiB, OFF_GATE = 6 * MiB + 512 * 1024, OFF_INVL = 7 * MiB, OFF_INVC = 9 * MiB, OFF_WSM = 10 * MiB,
                 OFF_XC = 31 * MiB, OFF_ACT = 39 * MiB, OFF_ARENA = 107 * MiB;
constexpr size_t WSM_STRIDE = 11010048, WSM_WIN = 0, WSM_WQKV = 5767168, WSM_WOUT = 8060928, WSM_W2F = 10158080, WSM_W2B = 10190848,
                 WSM_A2 = 10223616, WSM_G2 = 10256384;
constexpr size_t AR_P = 0, AR_QKV = 187 * MiB, AR_KF = 306 * MiB, AR_OPS = 357 * MiB, OPS_STRIDE = 17 * MiB;
constexpr size_t AR_WGU = 0, AR_WD = 64 * MiB, AR_XE = 96 * MiB, AR_HID = 232 * MiB;
constexpr size_t OFF_ROPE = OFF_ARENA + 425 * MiB;
constexpr size_t ROPE_AT = 4352 * 32 * 8;
constexpr size_t OFF_WGU2 = OFF_ROPE + 2 * MiB;
constexpr size_t WS_END = OFF_WGU2 + 64 * MiB;

struct Params { const float* in[32]; float* out; unsigned char* ws; int G; int pad; };

DI float bf2f(unsigned v) { return __uint_as_float(v << 16); }
DI bf16_t f2bf(float f) { return __builtin_bit_cast(bf16_t, (__bf16)f); }
typedef __bf16 bf16x2n __attribute__((ext_vector_type(2)));
DI unsigned pk2(float lo, float hi) { const f32x2 v = {lo, hi}; return __builtin_bit_cast(unsigned, __builtin_convertvector(v, bf16x2n)); }
DI float lo_f(unsigned w) { return __uint_as_float(w << 16); }
DI float hi_f(unsigned w) { return __uint_as_float(w & 0xffff0000u); }
DI float wave_sum(float v) { for (int o = 32; o >= 1; o >>= 1) v += __shfl_xor(v, o); return v; }
DI float dppf(float x, const int ctrl_sel) { return x; }
template <int CTRL> DI float dpp_mov(float x) { return __builtin_bit_cast(float, __builtin_amdgcn_update_dpp(0, __builtin_bit_cast(int, x), CTRL, 0xf, 0xf, true)); }
DI float row16_sum(float x) { x += dpp_mov<0xB1>(x); x += dpp_mov<0x4E>(x); x += dpp_mov<0x141>(x); x += dpp_mov<0x140>(x); return x; }
DI void row16_sum2(float& x, float& y) {
    asm("s_nop 1\n\t"
        "v_add_f32_dpp %0, %0, %0 quad_perm:[1,0,3,2] row_mask:0xf bank_mask:0xf bound_ctrl:1\n\t"
        "v_add_f32_dpp %1, %1, %1 quad_perm:[1,0,3,2] row_mask:0xf bank_mask:0xf bound_ctrl:1\n\t"
        "s_nop 0\n\t"
        "v_add_f32_dpp %0, %0, %0 quad_perm:[2,3,0,1] row_mask:0xf bank_mask:0xf bound_ctrl:1\n\t"
        "v_add_f32_dpp %1, %1, %1 quad_perm:[2,3,0,1] row_mask:0xf bank_mask:0xf bound_ctrl:1\n\t"
        "s_nop 0\n\t"
        "v_add_f32_dpp %0, %0, %0 row_half_mirror row_mask:0xf bank_mask:0xf bound_ctrl:1\n\t"
        "v_add_f32_dpp %1, %1, %1 row_half_mirror row_mask:0xf bank_mask:0xf bound_ctrl:1\n\t"
        "s_nop 0\n\t"
        "v_add_f32_dpp %0, %0, %0 row_mirror row_mask:0xf bank_mask:0xf bound_ctrl:1\n\t"
        "v_add_f32_dpp %1, %1, %1 row_mirror row_mask:0xf bank_mask:0xf bound_ctrl:1\n\t"
        "s_nop 0"
        : "+v"(x), "+v"(y));
}
DI float sigmoidf_(float x) { return __builtin_amdgcn_rcpf(1.f + __expf(-x)); }
DI float siluf_(float x) { return x * __builtin_amdgcn_rcpf(1.f + __expf(-x)); }
DI int tok_b(int tok) { return tok / SB; }

namespace pg8 {
constexpr int BM = 256, BK = 64, HALF = 128, HTB = HALF * BK * 2, STAGE_BYTES = 8 * HTB, NXCD = 8, WGM = 8;
DI int lds_byte(int r, int c) { const int st = (r >> 4) * 2 + (c >> 5), rr = r & 15, cc = c & 31, ob = rr * 64 + cc * 2; return st * 1024 + (ob ^ (((ob >> 9) & 1) << 5)); }
DI void stage_rc(int b, int& R, int& C) { const int st = b / 1024, sb = b % 1024, swz = sb ^ (((sb >> 9) & 1) << 5); R = (st >> 1) * 16 + swz / 64; C = (st & 1) * 32 + (swz % 64) / 2; }
DI int perm32(int rho) { const int n = rho >> 4, i = rho & 15; return 8 * (i >> 2) + 4 * n + (i & 3); }

struct Unit { int pm, pn, arow, brow; };
struct Gemm { const bf16_t* A; const bf16_t* Bt; int lda, ldb, K; const int* gidx; };

struct Sched {
    int nM, nN, nwg, G, c, mode;
    DI void init(int nM_, int nN_, int G_, int c_, int mode_) { nM = nM_; nN = nN_; nwg = nM * nN; G = G_; c = c_; mode = mode_; }
    DI bool next(int i, Unit& u) const {
        const long L = (long)i * G + c; if (L >= nwg) return false;
        int wgid = (int)L; { const int q = nwg / NXCD, r = nwg % NXCD, xcd = wgid % NXCD, off = wgid / NXCD; wgid = (xcd < r ? xcd * (q + 1) : r * (q + 1) + (xcd - r) * q) + off; }
        const int nig = WGM * nN, gid = wgid / nig, fm = gid * WGM, gsz = (nM - fm) < WGM ? (nM - fm) : WGM;
        int pm = fm + ((wgid % nig) % gsz); const int pn = (wgid % nig) / gsz;
        u.pn = pn;
        if (mode == 0) { u.pm = pm; u.arow = pm * 256; u.brow = pn * 256; }
        else if (mode == 1) { pm = pm + pm / 16 + 1; u.pm = pm; u.arow = pm * 256; u.brow = pn * 256; }
        else { const int e = pm < 256 ? (pm >> 4) : (pm - 256); u.pm = pm; u.arow = pm * 256; u.brow = e * (nN * 256) + pn * 256; }
        return true;
    }
};

struct EpiBf16 {
    static constexpr bool PERM = true;
    bf16_t* O; int ldc;
    DI void operator()(const f32x4 (&acc)[2][2][4][2], const Unit& u, int wr, int wc, int fr, int fq) const {
        const int row0 = u.pm * BM + wr * 64 + fr, col0 = u.pn * BM + wc * 32 + 8 * fq;
#pragma unroll
        for (int ai = 0; ai < 2; ++ai)
#pragma unroll
            for (int m = 0; m < 4; ++m) { bf16_t* rowp = O + (size_t)(row0 + ai * HALF + m * 16) * ldc + col0;
#pragma unroll
                for (int bj = 0; bj < 2; ++bj) { const f32x4 v0 = acc[ai][bj][m][0], v1 = acc[ai][bj][m][1];
                    u32x4 w; w.x = pk2(v0[0], v0[1]); w.y = pk2(v0[2], v0[3]); w.z = pk2(v1[0], v1[1]); w.w = pk2(v1[2], v1[3]);
                    *(u32x4*)(rowp + bj * HALF) = w; } }
    }
};
struct EpiGate {
    static constexpr bool PERM = true;
    bf16_t* O; int ldc; const float* gate;
    DI void operator()(const f32x4 (&acc)[2][2][4][2], const Unit& u, int wr, int wc, int fr, int fq) const {
        const int row0 = u.pm * BM + wr * 64 + fr, col0 = u.pn * BM + wc * 32 + 8 * fq;
#pragma unroll
        for (int ai = 0; ai < 2; ++ai)
#pragma unroll
            for (int m = 0; m < 4; ++m) { const int row = row0 + ai * HALF + m * 16; const float g = gate[row]; bf16_t* rowp = O + (size_t)row * ldc + col0;
#pragma unroll
                for (int bj = 0; bj < 2; ++bj) { const f32x4 v0 = acc[ai][bj][m][0] * g, v1 = acc[ai][bj][m][1] * g;
                    u32x4 w; w.x = pk2(v0[0], v0[1]); w.y = pk2(v0[2], v0[3]); w.z = pk2(v1[0], v1[1]); w.w = pk2(v1[2], v1[3]);
                    *(u32x4*)(rowp + bj * HALF) = w; } }
    }
};
struct EpiSwiglu {
    static constexpr bool PERM = true;
    bf16_t* O; int ldc;
    DI void operator()(const f32x4 (&acc)[2][2][4][2], const Unit& u, int wr, int wc, int fr, int fq) const {
        const int row0 = u.pm * BM + wr * 64 + fr, col0 = u.pn * 128 + wc * 16 + 4 * fq;
#pragma unroll
        for (int ai = 0; ai < 2; ++ai)
#pragma unroll
            for (int m = 0; m < 4; ++m) { bf16_t* rowp = O + (size_t)(row0 + ai * HALF + m * 16) * ldc + col0;
#pragma unroll
                for (int bj = 0; bj < 2; ++bj) { const f32x4 g = acc[ai][bj][m][0], up = acc[ai][bj][m][1];
                    u32x2 w; w.x = pk2(siluf_(g[0]) * up[0], siluf_(g[1]) * up[1]); w.y = pk2(siluf_(g[2]) * up[2], siluf_(g[3]) * up[3]);
                    *(u32x2*)(rowp + bj * 64) = w; } }
    }
};
struct EpiResid {
    static constexpr bool PERM = false;
    const float* xold_lat; const float* xold_ctx; float* xnew_lat; float* xnew_ctx; const float* modl;
    DI void operator()(const f32x4 (&acc)[2][2][4][2], const Unit& u, int wr, int wc, int fr, int fq) const {
        const int b = u.pm / 17, w = u.pm % 17;
        const float* xo = (w == 0) ? xold_ctx + (size_t)(b * 256) * DM : xold_lat + (size_t)(b * 4096 + (w - 1) * 256) * DM;
        float* xn = (w == 0) ? xnew_ctx + (size_t)(b * 256) * DM : xnew_lat + (size_t)(b * 4096 + (w - 1) * 256) * DM;
        const float* ga = modl + (size_t)((w == 0) ? 8 : b) * 6144 + 2048;
        const int r0 = wr * 64 + fr, col0 = u.pn * BM + wc * 32 + 4 * fq;
        f32x4 gv[2][2];
#pragma unroll
        for (int bj = 0; bj < 2; ++bj)
#pragma unroll
            for (int n = 0; n < 2; ++n) gv[bj][n] = *(const f32x4*)(ga + col0 + bj * HALF + n * 16);
#pragma unroll
        for (int ai = 0; ai < 2; ++ai)
#pragma unroll
            for (int m = 0; m < 4; ++m) { const size_t ro = (size_t)(r0 + ai * HALF + m * 16) * DM + col0;
#pragma unroll
                for (int bj = 0; bj < 2; ++bj)
#pragma unroll
                    for (int n = 0; n < 2; ++n) { const f32x4 o = *(const f32x4*)(xo + ro + bj * HALF + n * 16); *(f32x4*)(xn + ro + bj * HALF + n * 16) = o + gv[bj][n] * acc[ai][bj][m][n]; }
                asm volatile("" ::: "memory"); }
    }
};

template <class Epi, bool ALIGN_EPI = true, bool SP2 = true, bool GATHER = false>
DI void gemm_phase(LAS unsigned char* lds, const Gemm g, const Sched& S, const Epi& E, const int tid) {
    const int wid = __builtin_amdgcn_readfirstlane(tid >> 6), lane = tid & 63, wr = wid >> 2, wc = wid & 3, fr = lane & 15, fq = lane >> 4;
    const int K = g.K, nt = K / BK;
    unsigned voffA[2], voffB[2];
#pragma unroll
    for (int i = 0; i < 2; ++i) { int R, C; stage_rc(tid * 16 + i * 8192, R, C); const int Rb = Epi::PERM ? ((R & ~31) + perm32(R & 31)) : R;
        voffA[i] = (unsigned)(R * g.lda + C) * 2u; voffB[i] = (unsigned)(Rb * g.ldb + C) * 2u; }
    const size_t kstep = (size_t)(BK * 2);
    const size_t hstepA = GATHER ? (size_t)0 : (size_t)HALF * g.lda * 2, hstepB = (size_t)HALF * g.ldb * 2;
    unsigned vG[2][2], vN[2][2]; int gR[2], gC[2];
    LAS int* lidx = (LAS int*)(lds + STAGE_BYTES);
#pragma unroll
    for (int i = 0; i < 2; ++i) { int R, C; stage_rc(tid * 16 + i * 8192, R, C); gR[i] = R; gC[i] = C * 2; }
#define PG8_GOFF(V, ui_) do { _Pragma("unroll") for (int h_ = 0; h_ < 2; ++h_) _Pragma("unroll") for (int i_ = 0; i_ < 2; ++i_) \
        V[h_][i_] = (unsigned)lidx[(ui_) * 256 + h_ * 128 + gR[i_]] * (unsigned)(g.lda * 2) + (unsigned)gC[i_]; } while (0)
    const unsigned ldsw = (unsigned)wid * 1024u;
    const int aoff = lds_byte(wr * 64 + fr, fq * 8), boff = lds_byte(wc * 32 + fr, fq * 8);
#define PG8_SA(b, h) (((b) * 2 + (h)) * HTB)
#define PG8_SB(b, h) ((4 + (b) * 2 + (h)) * HTB)
#define PG8_STAGE(bufoff, gbase, voff) do { _Pragma("unroll") for (int _i = 0; _i < 2; ++_i) \
        __builtin_amdgcn_global_load_lds((const unsigned*)((const char*)(gbase) + (voff)[_i]), (LAS unsigned*)(lds + (bufoff) + ldsw + _i * 8192), 16, 0, 0); } while (0)
#define PG8_LDA(dst, b, h) do { _Pragma("unroll") for (int m = 0; m < 4; ++m) _Pragma("unroll") for (int k = 0; k < 2; ++k) dst[m][k] = *(const LAS bf16x8*)(lds + PG8_SA(b, h) + aoff + m * 2048 + k * 1024); } while (0)
#define PG8_LDB(dst, b, h) do { _Pragma("unroll") for (int n = 0; n < 2; ++n) _Pragma("unroll") for (int k = 0; k < 2; ++k) dst[n][k] = *(const LAS bf16x8*)(lds + PG8_SB(b, h) + boff + n * 2048 + k * 1024); } while (0)
#define PG8_MMA(ai, bj, At, Bt) do { __builtin_amdgcn_s_setprio(1); _Pragma("unroll") for (int m = 0; m < 4; ++m) _Pragma("unroll") for (int n = 0; n < 2; ++n) _Pragma("unroll") for (int k = 0; k < 2; ++k) \
        acc[ai][bj][m][n] = __builtin_amdgcn_mfma_f32_16x16x32_bf16(Bt[n][k], At[m][k], acc[ai][bj][m][n], 0, 0, 0); __builtin_amdgcn_s_setprio(0); } while (0)
#define PG8_WAIT_V(n) asm volatile("s_waitcnt vmcnt(" #n ")" ::: "memory")
#define PG8_WAIT_L(n) asm volatile("s_waitcnt lgkmcnt(" #n ")" ::: "memory")
#define PG8_BAR __builtin_amdgcn_s_barrier()
#define PG8_SCHED __builtin_amdgcn_sched_barrier(0)
    Unit cur, nxt; int ui = 0;
    if (!S.next(0, cur)) return;
    if constexpr (GATHER) { Unit u_; for (int q_ = 0; S.next(q_, u_); ++q_) if (tid < 256) lidx[q_ * 256 + tid] = g.gidx[u_.arow + tid];
        __syncthreads(); PG8_GOFF(vG, 0); }
    f32x4 acc[2][2][4][2];
#pragma unroll
    for (int a = 0; a < 2; ++a)
#pragma unroll
        for (int b = 0; b < 2; ++b)
#pragma unroll
            for (int m = 0; m < 4; ++m)
#pragma unroll
                for (int n = 0; n < 2; ++n) acc[a][b][m][n] = (f32x4){0.f, 0.f, 0.f, 0.f};
    bf16x8 At[4][2], B0[2][2], B1[2][2];
    const char* cA = GATHER ? (const char*)g.A : (const char*)g.A + (size_t)cur.arow * g.lda * 2; const char* cB = (const char*)g.Bt + (size_t)cur.brow * g.ldb * 2;
#define PG8_VA(h, nextu) (GATHER ? ((nextu) ? vN[h] : vG[h]) : voffA)
    if constexpr (SP2) {
        PG8_STAGE(PG8_SB(0, 0), cB, voffB); PG8_STAGE(PG8_SB(0, 1), cB + hstepB, voffB); PG8_STAGE(PG8_SA(0, 0), cA, PG8_VA(0, false)); PG8_STAGE(PG8_SA(0, 1), cA + hstepA, PG8_VA(1, false));
        if (wr == 1) PG8_BAR;
        PG8_WAIT_V(2); PG8_BAR;
        PG8_STAGE(PG8_SB(1, 0), cB + kstep, voffB); PG8_STAGE(PG8_SA(1, 0), cA + kstep, PG8_VA(0, false)); PG8_STAGE(PG8_SB(1, 1), cB + hstepB + kstep, voffB);
        PG8_WAIT_V(6); PG8_BAR;
    } else {
    PG8_STAGE(PG8_SB(0, 0), cB, voffB); PG8_STAGE(PG8_SA(0, 0), cA, voffA); PG8_STAGE(PG8_SB(0, 1), cB + hstepB, voffB); PG8_STAGE(PG8_SA(0, 1), cA + hstepA, voffA);
    if (wr == 1) PG8_BAR;
    PG8_WAIT_V(4); PG8_BAR;
    PG8_STAGE(PG8_SB(1, 0), cB + kstep, voffB); PG8_STAGE(PG8_SA(1, 0), cA + kstep, voffA); PG8_STAGE(PG8_SB(1, 1), cB + hstepB + kstep, voffB);
    PG8_WAIT_V(6); PG8_BAR;
    }
    for (;;) {
        const bool has_next = S.next(ui + 1, nxt);
        const char* nA = GATHER ? cA : (has_next ? (const char*)g.A + (size_t)nxt.arow * g.lda * 2 : cA); const char* nB = has_next ? (const char*)g.Bt + (size_t)nxt.brow * g.ldb * 2 : cB;
        if constexpr (GATHER) { if (has_next) PG8_GOFF(vN, ui + 1); else {
#pragma unroll
            for (int h_ = 0; h_ < 2; ++h_) { vN[h_][0] = vG[h_][0]; vN[h_][1] = vG[h_][1]; } } }
        for (int t = 0; t < nt; t += 2) {
            const bool last = (t == nt - 2);
            const char* a1 = cA + (size_t)(t + 1) * kstep;
            const char* a2 = last ? nA : cA + (size_t)(t + 2) * kstep; const char* b2 = last ? nB : cB + (size_t)(t + 2) * kstep;
            const char* a3 = a2 + kstep; const char* b3 = b2 + kstep;
            if constexpr (SP2) {
            PG8_LDB(B0, 0, 0); PG8_LDB(B1, 0, 1); PG8_SCHED; PG8_LDA(At, 0, 0); PG8_STAGE(PG8_SA(1, 1), a1 + hstepA, PG8_VA(1, false));
            PG8_WAIT_V(8); PG8_WAIT_L(0); PG8_BAR; PG8_MMA(0, 0, At, B0); PG8_MMA(0, 1, At, B1); PG8_BAR; PG8_SCHED;
            PG8_LDA(At, 0, 1); PG8_STAGE(PG8_SB(0, 0), b2, voffB); PG8_STAGE(PG8_SB(0, 1), b2 + hstepB, voffB); PG8_STAGE(PG8_SA(0, 0), a2, PG8_VA(0, last));
            PG8_WAIT_V(8); PG8_WAIT_L(0); PG8_BAR; PG8_MMA(1, 0, At, B0); PG8_MMA(1, 1, At, B1); PG8_BAR; PG8_SCHED;
            PG8_LDB(B0, 1, 0); PG8_LDB(B1, 1, 1); PG8_SCHED; PG8_LDA(At, 1, 0); PG8_STAGE(PG8_SA(0, 1), a2 + hstepA, PG8_VA(1, last));
            PG8_WAIT_V(8); PG8_WAIT_L(0); PG8_BAR; PG8_MMA(0, 0, At, B0); PG8_MMA(0, 1, At, B1); PG8_BAR; PG8_SCHED;
            PG8_LDA(At, 1, 1); PG8_STAGE(PG8_SB(1, 0), b3, voffB); PG8_STAGE(PG8_SB(1, 1), b3 + hstepB, voffB); PG8_STAGE(PG8_SA(1, 0), a3, PG8_VA(0, last));
            PG8_WAIT_V(8); PG8_WAIT_L(0); PG8_BAR; PG8_MMA(1, 0, At, B0); PG8_MMA(1, 1, At, B1); PG8_BAR; PG8_SCHED;
            } else {
            PG8_LDB(B0, 0, 0); PG8_SCHED; PG8_LDA(At, 0, 0); PG8_STAGE(PG8_SA(1, 1), a1 + hstepA, voffA);
            PG8_WAIT_L(8); PG8_BAR; PG8_WAIT_L(0); PG8_MMA(0, 0, At, B0); PG8_BAR; PG8_SCHED;
            PG8_LDB(B1, 0, 1); PG8_STAGE(PG8_SB(0, 0), b2, voffB);
            PG8_BAR; PG8_WAIT_L(0); PG8_MMA(0, 1, At, B1); PG8_BAR;
            PG8_LDA(At, 0, 1); PG8_STAGE(PG8_SA(0, 0), a2, voffA);
            PG8_BAR; PG8_WAIT_L(0); PG8_MMA(1, 0, At, B0); PG8_BAR; PG8_SCHED;
            PG8_STAGE(PG8_SB(0, 1), b2 + hstepB, voffB);
            PG8_WAIT_V(6); PG8_BAR; PG8_MMA(1, 1, At, B1); PG8_BAR;
            PG8_LDB(B0, 1, 0); PG8_SCHED; PG8_LDA(At, 1, 0); PG8_STAGE(PG8_SA(0, 1), a2 + hstepA, voffA);
            PG8_WAIT_L(8); PG8_BAR; PG8_WAIT_L(0); PG8_MMA(0, 0, At, B0); PG8_BAR; PG8_SCHED;
            PG8_LDB(B1, 1, 1); PG8_STAGE(PG8_SB(1, 0), b3, voffB);
            PG8_BAR; PG8_WAIT_L(0); PG8_MMA(0, 1, At, B1); PG8_BAR;
            PG8_LDA(At, 1, 1); PG8_STAGE(PG8_SA(1, 0), a3, voffA);
            PG8_BAR; PG8_WAIT_L(0); PG8_MMA(1, 0, At, B0); PG8_BAR; PG8_SCHED;
            PG8_STAGE(PG8_SB(1, 1), b3 + hstepB, voffB);
            PG8_WAIT_V(6); PG8_BAR; PG8_MMA(1, 1, At, B1); PG8_BAR;
            }
        }
        if constexpr (ALIGN_EPI) { if (wr == 0) PG8_BAR; }
        E(acc, cur, wr, wc, fr, fq);
        if (!has_next) break;
#pragma unroll
        for (int a = 0; a < 2; ++a)
#pragma unroll
            for (int b = 0; b < 2; ++b)
#pragma unroll
                for (int m = 0; m < 4; ++m)
#pragma unroll
                    for (int n = 0; n < 2; ++n) acc[a][b][m][n] = (f32x4){0.f, 0.f, 0.f, 0.f};
        cur = nxt; cA = nA; cB = nB; ++ui;
        if constexpr (GATHER) {
#pragma unroll
            for (int h_ = 0; h_ < 2; ++h_) { vG[h_][0] = vN[h_][0]; vG[h_][1] = vN[h_][1]; } }
        if constexpr (ALIGN_EPI) { if (wr == 1) PG8_BAR; }
    }
    PG8_WAIT_V(0);
    if constexpr (!ALIGN_EPI) { if (wr == 0) PG8_BAR; }
    PG8_BAR;
#undef PG8_SA
#undef PG8_VA
#undef PG8_GOFF
#undef PG8_SB
#undef PG8_STAGE
#undef PG8_LDA
#undef PG8_LDB
#undef PG8_MMA
#undef PG8_WAIT_V
#undef PG8_WAIT_L
#undef PG8_BAR
#undef PG8_SCHED
}
}


#define XB_TMO      128
#define XB_XCNT(j)  (256  + 64 * (j))
#define XB_XSUB(j)  (1280 + 64 * (j))
#define XB_XGEN(j)  (2304 + 64 * (j))
#define XB_TOP      3328
#define XB_TOPGEN   3392
#define XCD_BAR_WORDS 3456
#define XB_SPIN_CAP (1u << 22)
DI unsigned xb_ld(unsigned* p)              { return __hip_atomic_load(p, __ATOMIC_RELAXED, __HIP_MEMORY_SCOPE_AGENT); }
DI unsigned xb_add(unsigned* p, unsigned v) { return __hip_atomic_fetch_add(p, v, __ATOMIC_RELAXED, __HIP_MEMORY_SCOPE_AGENT); }
DI unsigned xb_xcc_id() { return (unsigned)__builtin_amdgcn_s_getreg((3 << 11) | 20) & 0xFu; }
#define XB_SPIN(cond, bar) do { unsigned _sp = 0; while (cond) { __builtin_amdgcn_s_sleep(1); \
    if ((++_sp & 255u) == 0u) { if (xb_ld(&(bar)[XB_TMO])) break; if (_sp > XB_SPIN_CAP) { atomicAdd(&(bar)[XB_TMO], 1u); break; } } } } while (0)
struct XcdBarrier { unsigned* bar; unsigned x; volatile LAS unsigned* st; };
DI XcdBarrier xcd_barrier_post(unsigned* bar, volatile LAS unsigned* st) {
    XcdBarrier b; b.bar = bar; b.x = xb_xcc_id(); b.st = st;
    if (threadIdx.x == 0) (void)xb_add(&bar[XB_XCNT(b.x)], 1u);
    return b;
}
DI void xcd_barrier_complete(unsigned* bar, unsigned x, unsigned& nloc, unsigned& nx) {
    const unsigned G = gridDim.x * gridDim.y * gridDim.z;
    unsigned sum, cnt, mine, sp = 0u;
    for (;;) {
        sum = 0u; cnt = 0u; mine = 0u;
#pragma unroll
        for (unsigned j = 0; j < 16; ++j) { const unsigned c = xb_ld(&bar[XB_XCNT(j)]); sum += c; cnt += (c > 0u) ? 1u : 0u; mine = (j == x) ? c : mine; }
        if (sum == G) break;
        __builtin_amdgcn_s_sleep(1);
        if ((++sp & 255u) == 0u) { if (xb_ld(&bar[XB_TMO])) break; if (sp > XB_SPIN_CAP) { atomicAdd(&bar[XB_TMO], 1u); break; } }
    }
    nloc = mine > 0u ? mine : 1u; nx = cnt > 0u ? cnt : 1u;
}
DI void xcd_barrier(const XcdBarrier& b) {
    asm volatile("s_waitcnt vmcnt(0)" ::: "memory");
    __syncthreads();
    if (threadIdx.x == 0) {
        unsigned* bar = b.bar;
        __builtin_amdgcn_s_waitcnt(0);
        unsigned nloc = b.st[0], nx = b.st[1];
        if (nloc == 0u) { xcd_barrier_complete(bar, b.x, nloc, nx); b.st[0] = nloc; b.st[1] = nx; }
        const unsigned old = xb_add(&bar[XB_XSUB(b.x)], 1u);
        const unsigned gen = old / nloc;
        if (old + 1u == (gen + 1u) * nloc) {
            __builtin_amdgcn_fence(__ATOMIC_RELEASE, "agent");
            asm volatile("s_waitcnt vmcnt(0)" ::: "memory");
            const unsigned og = xb_add(&bar[XB_TOP], 1u);
            const unsigned tg = og / nx;
            if (og + 1u == (tg + 1u) * nx) xb_add(&bar[XB_TOPGEN], 1u);
            else XB_SPIN(xb_ld(&bar[XB_TOPGEN]) == tg, bar);
            __builtin_amdgcn_fence(__ATOMIC_ACQUIRE, "agent");
            xb_add(&bar[XB_XGEN(b.x)], 1u);
            asm volatile("s_waitcnt vmcnt(0)" ::: "memory");
        } else {
            XB_SPIN(xb_ld(&bar[XB_XGEN(b.x)]) == gen, bar);
            __builtin_amdgcn_fence(__ATOMIC_ACQUIRE, "agent");
            asm volatile("s_waitcnt vmcnt(0)" ::: "memory");
        }
    }
    __syncthreads();
}

struct Ctx {
    const float* const* in; float* out; unsigned char* ws; int G, bid, tid, wave, lane; LAS unsigned char* lds;
    DI float* modv(int l) const { return (float*)(ws + OFF_MOD) + (size_t)l * 9 * 6144; }
    DI bf16_t* wsm(int l, size_t off) const { return (bf16_t*)(ws + OFF_WSM + (size_t)l * WSM_STRIDE + off); }
    DI bf16_t* act() const { return (bf16_t*)(ws + OFF_ACT); }
    DI bf16_t* pbuf() const { return (bf16_t*)(ws + OFF_ARENA + AR_P); }
    DI bf16_t* qkv() const { return (bf16_t*)(ws + OFF_ARENA + AR_QKV); }
    DI bf16_t* kf() const { return (bf16_t*)(ws + OFF_ARENA + AR_KF); }
    DI bf16_t* ops(int i) const { return (bf16_t*)(ws + OFF_ARENA + AR_OPS + (size_t)i * OPS_STRIDE); }
    DI float* xc() const { return (float*)(ws + OFF_XC); }
    DI float* bonus() const { return (float*)(ws + OFF_BONUS); }
    DI int* cnt() const { return (int*)(ws + OFF_CNT); }
};

DI void phase_mod(const Ctx& C) {
    LAS float* sl = (LAS float*)C.lds;
    LAS float* red = (LAS float*)(C.lds + 40960);
    const float* cv = C.in[1]; const float* ccx = C.in[3];
    for (int i = C.tid; i < 9 * 1024; i += NTHR) { const int s = i >> 10, k = i & 1023; const float v = (s < 8) ? cv[s * 1024 + k] : ccx[k]; sl[i] = siluf_(v); }
    __syncthreads();
    for (int item = C.bid; item < 192; item += C.G) {
        const int l = item / 96, col = (item % 96) * 64 + C.lane;
        const float* W = C.in[4] + (size_t)l * 1024 * 6144 + col;
        float acc[9];
#pragma unroll
        for (int j = 0; j < 9; ++j) acc[j] = 0.f;
        const int k0 = C.wave * 128;
        for (int kb = 0; kb < 128; kb += 16) { float wv[16];
#pragma unroll
            for (int k = 0; k < 16; ++k) wv[k] = W[(size_t)(k0 + kb + k) * 6144];
#pragma unroll
            for (int k = 0; k < 16; ++k)
#pragma unroll
                for (int j = 0; j < 9; ++j) acc[j] += sl[j * 1024 + k0 + kb + k] * wv[k]; }
#pragma unroll
        for (int j = 0; j < 9; ++j) red[(C.wave * 9 + j) * 64 + C.lane] = acc[j];
        __syncthreads();
        for (int o = C.tid; o < 9 * 64; o += NTHR) { const int j = o >> 6, ln = o & 63; float s = 0.f;
            for (int w = 0; w < 8; ++w) s += red[(w * 9 + j) * 64 + ln];
            const int cc = (item % 96) * 64 + ln;
            C.modv(l)[(size_t)j * 6144 + cc] = s + C.in[5][(size_t)l * 6144 + cc]; }
        __syncthreads();
    }
}

DI void phase_rope_tables(const Ctx& C) {
    f32x2* RT = (f32x2*)(C.ws + OFF_ROPE); f32x2* AT = (f32x2*)(C.ws + OFF_ROPE + ROPE_AT);
    const int n1 = SB * 32, n2 = SEQ * 16;
    for (int i = C.bid * NTHR + C.tid; i < n1 + n2; i += C.G * NTHR) {
        float sn, cs;
        if (i < n1) { const int pos = i >> 5, k = i & 31; const float inv = exp2f(-(float)k * (13.287712379549449f / 31.f)); sincosf((float)pos * inv, &sn, &cs); RT[i] = (f32x2){cs, sn}; }
        else { const int j = i - n1, t = j >> 4, p = j & 15, f = p & 7; const float inv = exp2f(-(float)f * (13.287712379549449f / 8.f)); const float pos = (p < 8) ? (float)(t >> 6) : (float)(t & 63);
            sincosf(pos * inv, &sn, &cs); AT[j] = (f32x2){cs, sn}; }
    }
}

struct TJob { const float* src; int ldsrc, Ks, Ns; const float* kscale; bf16_t* dst; int lddst, row0, col0, nkt, nnt, rowmap; };
DI void tconv_tile(const TJob& J, int kt, int nt, LAS float* lds, const int tid) {
    const int k0 = kt * 64, n0 = nt * 64;
    { const int kk = tid >> 3, nn = (tid & 7) * 8; const int k = k0 + kk; float v[8];
#pragma unroll
      for (int j = 0; j < 8; ++j) v[j] = 0.f;
      if (J.src && k < J.Ks) { const float* sp = J.src + (size_t)k * J.ldsrc + n0 + nn;
          if (n0 + nn + 7 < J.Ns) { const f32x4 a = *(const f32x4*)sp, b = *(const f32x4*)(sp + 4); v[0] = a[0]; v[1] = a[1]; v[2] = a[2]; v[3] = a[3]; v[4] = b[0]; v[5] = b[1]; v[6] = b[2]; v[7] = b[3]; }
          else {
#pragma unroll
              for (int j = 0; j < 8; ++j) if (n0 + nn + j < J.Ns) v[j] = sp[j]; }
          const float sc = J.kscale ? J.kscale[k] : 1.f;
#pragma unroll
          for (int j = 0; j < 8; ++j) v[j] *= sc; }
#pragma unroll
      for (int j = 0; j < 8; ++j) lds[kk * 65 + nn + j] = v[j]; }
    __syncthreads();
    { const int n = tid >> 3, kq = (tid & 7) * 8; float v[8];
#pragma unroll
      for (int j = 0; j < 8; ++j) v[j] = lds[(kq + j) * 65 + n];
      const int nl = n0 + n; int dr;
      if (J.rowmap == 0) dr = nl; else dr = 8 * (nl >> 2) + (nl & 3) + (J.rowmap == 2 ? 4 : 0);
      u32x4 w; w.x = pk2(v[0], v[1]); w.y = pk2(v[2], v[3]); w.z = pk2(v[4], v[5]); w.w = pk2(v[6], v[7]);
      *(u32x4*)(J.dst + (size_t)(J.row0 + dr) * J.lddst + J.col0 + k0 + kq) = w; }
    __syncthreads();
}
DI TJob small_job(const Ctx& C, int l, int j) {
    TJob J; J.kscale = nullptr; J.rowmap = 0; J.row0 = 0; J.col0 = 0;
    switch (j) {
    case 0: J.src = C.in[8] + (size_t)l * 1024 * INC; J.ldsrc = INC; J.Ks = 1024; J.Ns = INC; J.dst = C.wsm(l, WSM_WIN); J.lddst = 1024; J.nkt = 16; J.nnt = 44; break;
    case 1: J.src = C.in[10] + (size_t)l * 384 * 768; J.ldsrc = 768; J.Ks = 384; J.Ns = 768; J.kscale = C.in[9] + l * 384; J.dst = C.wsm(l, WSM_WQKV); J.lddst = 640; J.nkt = 6; J.nnt = 12; break;
    case 2: J.src = C.in[12] + (size_t)l * 256 * 1024; J.ldsrc = 1024; J.Ks = 256; J.Ns = 1024; J.kscale = C.in[11] + l * 256; J.dst = C.wsm(l, WSM_WQKV); J.lddst = 640; J.row0 = 768; J.col0 = 384; J.nkt = 4; J.nnt = 16; break;
    case 3: J.src = nullptr; J.ldsrc = 0; J.Ks = 0; J.Ns = 0; J.dst = C.wsm(l, WSM_WQKV); J.lddst = 640; J.row0 = 0; J.col0 = 384; J.nkt = 4; J.nnt = 12; break;
    case 4: J.src = nullptr; J.ldsrc = 0; J.Ks = 0; J.Ns = 0; J.dst = C.wsm(l, WSM_WQKV); J.lddst = 640; J.row0 = 768; J.col0 = 0; J.nkt = 6; J.nnt = 16; break;
    case 5: J.src = C.in[27] + (size_t)l * 1024 * 1024; J.ldsrc = 1024; J.Ks = 1024; J.Ns = 1024; J.dst = C.wsm(l, WSM_WOUT); J.lddst = 1024; J.nkt = 16; J.nnt = 16; break;
    case 6: J.src = C.in[19] + (size_t)(l * 2 + 0) * 64 * 256; J.ldsrc = 256; J.Ks = 64; J.Ns = 256; J.dst = C.wsm(l, WSM_W2F); J.lddst = 64; J.nkt = 1; J.nnt = 4; break;
    case 7: J.src = C.in[19] + (size_t)(l * 2 + 1) * 64 * 256; J.ldsrc = 256; J.Ks = 64; J.Ns = 256; J.dst = C.wsm(l, WSM_W2B); J.lddst = 64; J.nkt = 1; J.nnt = 4; break;
    case 8: J.src = C.in[21] + (size_t)l * 64 * 256; J.ldsrc = 256; J.Ks = 64; J.Ns = 256; J.dst = C.wsm(l, WSM_A2); J.lddst = 64; J.nkt = 1; J.nnt = 4; break;
    default: J.src = C.in[22] + (size_t)l * 128 * 256; J.ldsrc = 256; J.Ks = 128; J.Ns = 256; J.dst = C.wsm(l, WSM_G2); J.lddst = 128; J.nkt = 2; J.nnt = 4; break;
    }
    return J;
}
DI void phase_wconv_small(const Ctx& C) {
    LAS float* lds = (LAS float*)C.lds;
    int base = 0;
    for (int l = 0; l < 2; ++l)
        for (int j = 0; j < 10; ++j) {
            const TJob J = small_job(C, l, j); const int ntile = J.nkt * J.nnt;
            int first = (C.bid - base % C.G + C.G) % C.G;
            for (int t = first; t < ntile; t += C.G) tconv_tile(J, t / J.nnt, t % J.nnt, lds, C.tid);
            base += ntile;
        }
}
constexpr int SM_TILES = 1260, P0_NMOD = 192, P0_NB = 2 * SM_TILES / 8;
struct TDst { bf16_t* dp; int ld; };
DI TDst tconv_ld(const Ctx& C, int t, const int tid, f32x4& a, f32x4& b, float& sc) {
    int l = 0; if (t >= SM_TILES) { l = 1; t -= SM_TILES; }
    int j;
    if (t < 704) j = 0; else if (t < 776) { j = 1; t -= 704; } else if (t < 840) { j = 2; t -= 776; } else if (t < 888) { j = 3; t -= 840; } else if (t < 984) { j = 4; t -= 888; }
    else if (t < 1240) { j = 5; t -= 984; } else if (t < 1244) { j = 6; t -= 1240; } else if (t < 1248) { j = 7; t -= 1244; } else if (t < 1252) { j = 8; t -= 1248; } else { j = 9; t -= 1252; }
    const TJob J = small_job(C, l, j);
    const int kt = t / J.nnt, nt = t - kt * J.nnt; const int k0 = kt * 64, n0 = nt * 64; const int kk = tid >> 3, nn = (tid & 7) * 8;
    a = (f32x4){0.f, 0.f, 0.f, 0.f}; b = a; sc = 1.f;
    if (J.src) { if (n0 + nn < J.Ns) { const float* sp = J.src + (size_t)(k0 + kk) * J.ldsrc + n0 + nn; a = *(const f32x4*)sp; b = *(const f32x4*)(sp + 4); }
                 if (J.kscale) sc = J.kscale[k0 + kk]; }
    TDst r; r.dp = J.dst + (size_t)(J.row0 + n0) * J.lddst + J.col0 + k0; r.ld = J.lddst; return r;
}
DI void tconv_range8(const Ctx& C, int t0) {
    LAS float* lds = (LAS float*)(C.lds + 65536);
    const int tid = C.tid, kk = tid >> 3, nn = (tid & 7) * 8, n = tid >> 3, kq = (tid & 7) * 8;
    f32x4 A0[4], B0[4], A1[4], B1[4]; float s0[4], s1[4]; TDst d0[4], d1[4];
#define TQ_PROC(A, B, S, D) do { \
        _Pragma("unroll") for (int q_ = 0; q_ < 4; ++q_) { LAS float* d_ = lds + q_ * 4160 + kk * 65 + nn; const f32x4 a_ = A[q_] * S[q_], b_ = B[q_] * S[q_]; \
            d_[0] = a_[0]; d_[1] = a_[1]; d_[2] = a_[2]; d_[3] = a_[3]; d_[4] = b_[0]; d_[5] = b_[1]; d_[6] = b_[2]; d_[7] = b_[3]; } \
        __syncthreads(); \
        _Pragma("unroll") for (int q_ = 0; q_ < 4; ++q_) { const LAS float* s_ = lds + q_ * 4160 + kq * 65 + n; \
            u32x4 w_; w_.x = pk2(s_[0], s_[65]); w_.y = pk2(s_[130], s_[195]); w_.z = pk2(s_[260], s_[325]); w_.w = pk2(s_[390], s_[455]); \
            *(u32x4*)(D[q_].dp + (size_t)n * D[q_].ld + kq) = w_; } \
        __syncthreads(); } while (0)
#pragma unroll
    for (int q = 0; q < 4; ++q) d0[q] = tconv_ld(C, t0 + q, tid, A0[q], B0[q], s0[q]);
#pragma unroll
    for (int q = 0; q < 4; ++q) d1[q] = tconv_ld(C, t0 + 4 + q, tid, A1[q], B1[q], s1[q]);
    TQ_PROC(A0, B0, s0, d0);
    TQ_PROC(A1, B1, s1, d1);
#undef TQ_PROC
}
DI void mod_item(const Ctx& C, int item, bool need_sl) {
    LAS float* sl = (LAS float*)C.lds;
    LAS float* red = (LAS float*)(C.lds + 40960);
    const int l = item / 96, col = (item % 96) * 64 + C.lane;
    const int k0 = C.wave * 128;
    const float* W = C.in[4] + (size_t)l * 1024 * 6144 + (size_t)k0 * 6144 + col;
    float wv[128];
#pragma unroll
    for (int k = 0; k < 128; ++k) wv[k] = W[(size_t)k * 6144];
    if (need_sl) { const float* cv = C.in[1]; const float* ccx = C.in[3];
        float tv[18];
#pragma unroll
        for (int q = 0; q < 18; ++q) { const int i = C.tid + q * NTHR; const int s = i >> 10, k = i & 1023; tv[q] = (s < 8) ? cv[s * 1024 + k] : ccx[k]; }
#pragma unroll
        for (int q = 0; q < 18; ++q) sl[C.tid + q * NTHR] = siluf_(tv[q]);
        __syncthreads(); }
    float acc[9];
#pragma unroll
    for (int j = 0; j < 9; ++j) acc[j] = 0.f;
#pragma unroll
    for (int k = 0; k < 128; ++k)
#pragma unroll
        for (int j = 0; j < 9; ++j) acc[j] += sl[j * 1024 + k0 + k] * wv[k];
#pragma unroll
    for (int j = 0; j < 9; ++j) red[(C.wave * 9 + j) * 64 + C.lane] = acc[j];
    __syncthreads();
    for (int o = C.tid; o < 9 * 64; o += NTHR) { const int j = o >> 6, ln = o & 63; float s = 0.f;
        for (int w = 0; w < 8; ++w) s += red[(w * 9 + j) * 64 + ln];
        const int cc = (item % 96) * 64 + ln;
        C.modv(l)[(size_t)j * 6144 + cc] = s + C.in[5][(size_t)l * 6144 + cc]; }
    __syncthreads();
}
DI void phase_p0(const Ctx& C0) {
    LAS int* slot = (LAS int*)(C0.lds + LDS_BYTES - 16);
    bool have_sl = false;
    for (;;) {
        __syncthreads(); if (C0.tid == 0) *slot = atomicAdd(C0.cnt() + 16, 1); __syncthreads();
        const int it = *slot;
#ifdef DIAG_TS
        if (it >= P0_NMOD + P0_NB && C0.tid == 0) atomicMax(((unsigned long long*)(C0.ws + OFF_CNT + 4096)) + 52, (unsigned long long)__builtin_amdgcn_s_memrealtime());
#endif
        if (it >= P0_NMOD + P0_NB) break;
        Ctx C2 = C0; asm volatile("" : "+v"(C2.tid)); C2.lane = C2.tid & 63; C2.wave = __builtin_amdgcn_readfirstlane(C2.tid >> 6); const Ctx& C = C2;
        if (it < P0_NMOD) {
            mod_item(C, it, !have_sl); have_sl = true;
#ifdef DIAG_TS
            if (C.tid == 0) atomicMax(((unsigned long long*)(C.ws + OFF_CNT + 4096)) + 53, (unsigned long long)__builtin_amdgcn_s_memrealtime());
#endif
        } else tconv_range8(C, (it - P0_NMOD) * 8);
    }
}
constexpr int WX_NGU = 2048, WX_NALL = 3072;
DI void wconv_range(const Ctx& C, int l, int t0, int cnt) {
    LAS float* lds = (LAS float*)C.lds;
    const int tid = C.tid, kk = tid >> 3, nn = (tid & 7) * 8, n = tid >> 3, kq = (tid & 7) * 8;
    f32x4 RA[8], RB[8];
#define WX_DEC(t) const int mat_ = (t) >> 6, kt_ = ((t) >> 2) & 15, ng_ = (t) & 3; const int kind_ = (mat_ < 32) ? (mat_ & 1) : 2, e_ = (mat_ < 32) ? (mat_ >> 1) : mat_ - 32
#define WX_LD(R, t) do { WX_DEC(t); \
        const float* p_ = C.in[29 + kind_] + (size_t)(l * 16 + e_) * 1048576 + (size_t)(kt_ * 64 + kk) * 1024 + ng_ * 256 + nn; \
        _Pragma("unroll") for (int j_ = 0; j_ < 4; ++j_) { R[2 * j_] = *(const f32x4*)(p_ + j_ * 64); R[2 * j_ + 1] = *(const f32x4*)(p_ + j_ * 64 + 4); } } while (0)
#define WX_PROC(R, t) do { WX_DEC(t); \
        _Pragma("unroll") for (int j_ = 0; j_ < 4; ++j_) { LAS float* d_ = lds + j_ * 4160 + kk * 65 + nn; \
            d_[0] = R[2 * j_][0]; d_[1] = R[2 * j_][1]; d_[2] = R[2 * j_][2]; d_[3] = R[2 * j_][3]; d_[4] = R[2 * j_ + 1][0]; d_[5] = R[2 * j_ + 1][1]; d_[6] = R[2 * j_ + 1][2]; d_[7] = R[2 * j_ + 1][3]; } \
        __syncthreads(); \
        bf16_t* dst_ = (kind_ < 2) ? (bf16_t*)(C.ws + OFF_WGU2) + (size_t)(e_ * 2048) * 1024 : (bf16_t*)(C.ws + OFF_ARENA + AR_WD) + (size_t)(e_ * 1024) * 1024; \
        _Pragma("unroll") for (int j_ = 0; j_ < 4; ++j_) { const LAS float* s_ = lds + j_ * 4160 + kq * 65 + n; const int nl_ = ng_ * 256 + j_ * 64 + n; \
            const int dr_ = (kind_ == 2) ? nl_ : 8 * (nl_ >> 2) + (nl_ & 3) + (kind_ == 1 ? 4 : 0); \
            u32x4 w_; w_.x = pk2(s_[0], s_[65]); w_.y = pk2(s_[130], s_[195]); w_.z = pk2(s_[260], s_[325]); w_.w = pk2(s_[390], s_[455]); \
            *(u32x4*)(dst_ + (size_t)dr_ * 1024 + kt_ * 64 + kq) = w_; } \
        __syncthreads(); } while (0)
    __syncthreads();
    WX_LD(RA, t0);
    for (int i = 0; i < cnt; i += 2) {
        if (i + 1 < cnt) WX_LD(RB, t0 + i + 1);
        WX_PROC(RA, t0 + i);
        if (i + 2 < cnt) WX_LD(RA, t0 + i + 2);
        if (i + 1 < cnt) WX_PROC(RB, t0 + i + 1);
    }
#undef WX_DEC
#undef WX_LD
#undef WX_PROC
}
DI void phase_wconv_experts(const Ctx& C, int l) {
    LAS int* slot = (LAS int*)(C.lds + LDS_BYTES - 16);
    int* ctr = C.cnt() + 8 + l;
    for (;;) {
        __syncthreads(); if (C.tid == 0) *slot = atomicAdd(ctr, 1); __syncthreads();
        const int bt = *slot; if (bt >= (WX_NALL - WX_NGU) / 4) break;
        wconv_range(C, l, WX_NGU + bt * 4, 4);
    }
}

DI const float* tok_row(const float* lat, const float* ctxp, int tok) { const int b = tok / SB, s = tok - b * SB; return (s < CTXL) ? ctxp + (size_t)(b * CTXL + s) * DM : lat + (size_t)(b * SEQ + s - CTXL) * DM; }

DI void norm_mod_store(const f32x4 (&v)[4], const float* nw, const float* modrow, int shoff, int scoff, bf16_t* dst, int lane) {
    float ss = 0.f;
#pragma unroll
    for (int j = 0; j < 4; ++j) ss += v[j][0] * v[j][0] + v[j][1] * v[j][1] + v[j][2] * v[j][2] + v[j][3] * v[j][3];
    ss = wave_sum(ss);
    const float rstd = rsqrtf(ss * (1.f / 1024.f) + 1e-6f);
#pragma unroll
    for (int j = 0; j < 4; ++j) { const int c = j * 256 + lane * 4;
        const f32x4 w = *(const f32x4*)(nw + c), sc = *(const f32x4*)(modrow + scoff + c), sh = *(const f32x4*)(modrow + shoff + c);
        const f32x4 o = v[j] * rstd * w * (sc + 1.f) + sh;
        u32x2 pkd; pkd.x = pk2(o[0], o[1]); pkd.y = pk2(o[2], o[3]); *(u32x2*)(dst + c) = pkd; }
}

DI void phase_u(const Ctx& C, int l, const float* lat, const float* ctxp) {
    const int gw = C.bid * 8 + C.wave, GW = C.G * 8;
    f32x4 v[4], v2[4];
#define PU_LOAD(V, V2, t_) do { const int t2_ = ((t_) + GW < T) ? (t_) + GW : (t_); const float* xr_ = tok_row(lat, ctxp, (t_)); const float* xr2_ = tok_row(lat, ctxp, t2_); \
        _Pragma("unroll") for (int j_ = 0; j_ < 4; ++j_) { V[j_] = *(const f32x4*)(xr_ + j_ * 256 + C.lane * 4); V2[j_] = *(const f32x4*)(xr2_ + j_ * 256 + C.lane * 4); } } while (0)
    if (gw < T) PU_LOAD(v, v2, gw);
    for (int tok = gw; tok < T; tok += 2 * GW) {
        const int tok2 = (tok + GW < T) ? tok + GW : tok; const int nt = tok + 2 * GW;
        f32x4 n[4], n2[4]; if (nt < T) PU_LOAD(n, n2, nt);
        { const int b = tok / SB, s = tok - b * SB; norm_mod_store(v, C.in[6] + l * 1024, C.modv(l) + (size_t)((s < CTXL) ? 8 : b) * 6144, 0, 1024, C.act() + (size_t)tok * DM, C.lane); }
        if (tok2 != tok) { const int b = tok2 / SB, s = tok2 - b * SB; norm_mod_store(v2, C.in[6] + l * 1024, C.modv(l) + (size_t)((s < CTXL) ? 8 : b) * 6144, 0, 1024, C.act() + (size_t)tok2 * DM, C.lane); }
        if (nt < T) {
#pragma unroll
            for (int j = 0; j < 4; ++j) { v[j] = n[j]; v2[j] = n2[j]; } }
    }
#undef PU_LOAD
}

DI void phase_ret_prep(const Ctx& C) {
    const int gw = C.bid * 8 + C.wave, GW = C.G * 8;
    const int hh = C.lane >> 4, i2 = (C.lane & 15) * 2;
    const f32x4* RT = (const f32x4*)(C.ws + OFF_ROPE);
    for (int tok = gw; tok < T; tok += GW) {
        const int s = tok % SB; bf16_t* pr = C.pbuf() + (size_t)tok * NPC;
        const f32x4 cssn = RT[(s * 32 + i2) >> 1]; const float c0 = cssn[0], s0 = cssn[1], c1 = cssn[2], s1 = cssn[3];
#pragma unroll
        for (int qk = 0; qk < 2; ++qk) { bf16_t* base = pr + (qk ? C_RK : C_RQ) + hh * 64 + i2; const float sc = qk ? 0.125f : 1.f;
            const unsigned a = *(const unsigned*)base, bq = *(const unsigned*)(base + 32);
            const float x10 = lo_f(a), x11 = hi_f(a), x20 = lo_f(bq), x21 = hi_f(bq);
            *(unsigned*)base = pk2((x10 * c0 - x20 * s0) * sc, (x11 * c1 - x21 * s1) * sc);
            *(unsigned*)(base + 32) = pk2((x10 * s0 + x20 * c0) * sc, (x11 * s1 + x21 * c1) * sc); }
    }
}

DI float shift_val(float pc, float pp, float pn, float mu) { return pc + (0.5f * (pp + pn) - pc) * mu; }
DI void phase_rwkv_prep(const Ctx& C, int l) {
    LAS bf16_t* X = (LAS bf16_t*)C.lds;
    LAS bf16_t* AL = (LAS bf16_t*)(C.lds + 64 * 328 * 2);
    const float* mu = C.in[17] + l * 1088;
    const bf16_t* P = C.pbuf();
    const int wave = C.wave;
    LAS float* Lmu = (LAS float*)(C.lds + 80 * 1024);
    LAS float* Lw0 = Lmu + 1088; LAS float* La0 = Lw0 + 512;
    for (int i = C.tid; i < 1088; i += NTHR) Lmu[i] = mu[i];
    for (int i = C.tid; i < 512; i += NTHR) Lw0[i] = C.in[18][(size_t)l * 512 + i];
    for (int i = C.tid; i < 256; i += NTHR) La0[i] = C.in[20][l * 256 + i];
    __syncthreads();
    bf16x8 wf0[2][2], wf1[2][2], wf2[2][2], wf3[2][4];
    { const int l0 = C.lane;
#pragma unroll
      for (int nt2 = 0; nt2 < 2; ++nt2) { const int row = wave * 32 + nt2 * 16 + (l0 & 15);
#pragma unroll
          for (int ks = 0; ks < 2; ++ks) { wf0[nt2][ks] = *(const bf16x8*)(C.wsm(l, WSM_W2F) + (size_t)row * 64 + ks * 32 + 8 * (l0 >> 4));
              wf1[nt2][ks] = *(const bf16x8*)(C.wsm(l, WSM_W2B) + (size_t)row * 64 + ks * 32 + 8 * (l0 >> 4));
              wf2[nt2][ks] = *(const bf16x8*)(C.wsm(l, WSM_A2) + (size_t)row * 64 + ks * 32 + 8 * (l0 >> 4)); }
#pragma unroll
          for (int ks = 0; ks < 4; ++ks) wf3[nt2][ks] = *(const bf16x8*)(C.wsm(l, WSM_G2) + (size_t)row * 128 + ks * 32 + 8 * (l0 >> 4)); } }
    for (int tile = C.bid; tile < 544; tile += C.G) {
        int tid_ = C.tid; asm volatile("" : "+v"(tid_)); const int lane = tid_ & 63;
        const int b = tile / 68, tt = tile % 68; const int s0 = tt * 64; const int tok0 = b * SB + s0;
        const int sfirst = (s0 < CTXL) ? 0 : CTXL, slast = (s0 < CTXL) ? CTXL - 1 : SB - 1;
#ifdef DIAG_TS
#define PSTAMP(k) do { if (l == 0 && tile == C.bid && C.bid == DIAG_BLK && C.tid == 0) ((unsigned long long*)(C.ws + OFF_CNT + 4096))[k] = __builtin_amdgcn_s_memrealtime(); } while (0)
#else
#define PSTAMP(k) do {} while (0)
#endif
        PSTAMP(42);
        { const int ti = tid_ >> 3, s = s0 + ti; const bf16_t* pc = P + (size_t)(tok0 + ti) * NPC + C_RW + 768;
          const bool hp = s > sfirst, hn = s < slast;
#pragma unroll
          for (int jj = 0; jj < 5; ++jj) { const int col = (tid_ & 7) * 8 + 64 * jj;
              const u32x4 vc = *(const u32x4*)(pc + col); u32x4 vp = {0u, 0u, 0u, 0u}, vn = {0u, 0u, 0u, 0u};
              if (hp) vp = *(const u32x4*)(pc - NPC + col); if (hn) vn = *(const u32x4*)(pc + NPC + col);
              unsigned o[4];
#pragma unroll
              for (int q = 0; q < 4; ++q) { float a = shift_val(lo_f(vc[q]), lo_f(vp[q]), lo_f(vn[q]), Lmu[768 + col + 2 * q]);
                  float bq = shift_val(hi_f(vc[q]), hi_f(vp[q]), hi_f(vn[q]), Lmu[768 + col + 2 * q + 1]);
                  if (col < 128) { a = 1.f - 2.f / (1.f + __expf(2.f * a)); bq = 1.f - 2.f / (1.f + __expf(2.f * bq)); } else if (col >= 192) { a = sigmoidf_(a); bq = sigmoidf_(bq); }
                  o[q] = pk2(a, bq); }
              *(LAS u32x4*)(X + ti * 328 + col) = (u32x4){o[0], o[1], o[2], o[3]}; } }
        __syncthreads();
        PSTAMP(43);
        {
#pragma unroll
          for (int mat = 0; mat < 4; ++mat) {
              const int xoff = (mat == 3) ? 192 : mat * 64; const int nks = (mat == 3) ? 4 : 2;
#pragma unroll 1
              for (int tg = 0; tg < 4; ++tg) { const int tk = tg * 16 + (lane & 15); const int tok = tok0 + tk;
                  bf16x8 xfr[4];
#pragma unroll
                  for (int ks = 0; ks < 4; ++ks) if (ks < nks) xfr[ks] = *(const LAS bf16x8*)(X + tk * 328 + xoff + ks * 32 + 8 * (lane >> 4));
#pragma unroll
                  for (int nt2 = 0; nt2 < 2; ++nt2) { f32x4 acc = {0.f, 0.f, 0.f, 0.f};
#pragma unroll
                      for (int ks = 0; ks < 4; ++ks) if (ks < nks) acc = __builtin_amdgcn_mfma_f32_16x16x32_bf16(mat == 0 ? wf0[nt2][ks & 1] : mat == 1 ? wf1[nt2][ks & 1] : mat == 2 ? wf2[nt2][ks & 1] : wf3[nt2][ks], xfr[ks], acc, 0, 0, 0);
                      const int n0 = wave * 32 + nt2 * 16 + 4 * (lane >> 4);
                      float o[4];
                      if (mat < 2) { const LAS float* w0 = Lw0 + mat * 256 + n0;
#pragma unroll
                          for (int q = 0; q < 4; ++q) o[q] = 1.f - __expf(-0.606531f * __builtin_amdgcn_rcpf(1.f + __expf(-(w0[q] + acc[q]))));
                          u32x2 w; w.x = pk2(o[0], o[1]); w.y = pk2(o[2], o[3]); *(u32x2*)(C.ops(1 + mat) + (size_t)tok * 256 + n0) = w; }
                      else if (mat == 2) { const LAS float* a0 = La0 + n0;
#pragma unroll
                          for (int q = 0; q < 4; ++q) o[q] = __builtin_amdgcn_rcpf(1.f + __expf(-(a0[q] + acc[q])));
                          u32x2 w; w.x = pk2(o[0], o[1]); w.y = pk2(o[2], o[3]); *(LAS u32x2*)(AL + tk * 264 + n0) = w; }
                      else { u32x2 w; w.x = pk2(acc[0], acc[1]); w.y = pk2(acc[2], acc[3]); *(u32x2*)(C.ops(3) + (size_t)tok * 256 + n0) = w; } } } } }
        __syncthreads();
        PSTAMP(44);
        { const int c4 = lane * 4;
          const f32x4 mur = *(const f32x4*)(mu + c4), muk = *(const f32x4*)(mu + 256 + c4), muv = *(const f32x4*)(mu + 512 + c4);
          const f32x4 kkw = *(const f32x4*)(C.in[23] + l * 256 + c4), kaw = *(const f32x4*)(C.in[24] + l * 256 + c4), rkw = *(const f32x4*)(C.in[25] + l * 256 + c4);
          u32x2 rowv[10][3];
#pragma unroll
          for (int rr = 0; rr < 10; ++rr) { const int sr = s0 + wave * 8 + rr - 1; const bool ok = (sr >= sfirst) && (sr <= slast);
              const bf16_t* pr_ = P + (size_t)(tok0 + wave * 8 + rr - 1) * NPC + C_RW + c4;
#pragma unroll
              for (int part = 0; part < 3; ++part) rowv[rr][part] = ok ? *(const u32x2*)(pr_ + part * 256) : (u32x2){0u, 0u}; }
#pragma unroll
          for (int q8 = 0; q8 < 8; ++q8) { const int ti = wave * 8 + q8, tok = tok0 + ti;
              f32x4 rs, ks_, vs;
#pragma unroll
              for (int part = 0; part < 3; ++part) { const u32x2 vc = rowv[q8 + 1][part], vp = rowv[q8][part], vn = rowv[q8 + 2][part];
                  const f32x4 m = part == 0 ? mur : part == 1 ? muk : muv; f32x4 o;
                  o[0] = shift_val(lo_f(vc.x), lo_f(vp.x), lo_f(vn.x), m[0]); o[1] = shift_val(hi_f(vc.x), hi_f(vp.x), hi_f(vn.x), m[1]);
                  o[2] = shift_val(lo_f(vc.y), lo_f(vp.y), lo_f(vn.y), m[2]); o[3] = shift_val(hi_f(vc.y), hi_f(vp.y), hi_f(vn.y), m[3]);
                  if (part == 0) rs = o; else if (part == 1) ks_ = o; else vs = o; }
              const u32x2 aw = *(const LAS u32x2*)(AL + ti * 264 + c4); const f32x4 a = {lo_f(aw.x), hi_f(aw.x), lo_f(aw.y), hi_f(aw.y)};
              f32x4 kk = ks_ * kkw; float nn = kk[0] * kk[0] + kk[1] * kk[1] + kk[2] * kk[2] + kk[3] * kk[3]; nn = row16_sum(nn);
              kk = kk * rsqrtf(fmaxf(nn, 1e-24f));
              const f32x4 kp = ks_ * ((a - 1.f) * kaw + 1.f); const f32x4 bb = kk * a;
              float bon = rs[0] * kp[0] * rkw[0] + rs[1] * kp[1] * rkw[1] + rs[2] * kp[2] * rkw[2] + rs[3] * kp[3] * rkw[3]; bon = row16_sum(bon);
              if ((lane & 15) == 0) C.bonus()[(size_t)tok * 4 + (lane >> 4)] = bon;
              bf16_t* ar = C.act() + (size_t)tok * DM + c4;
              u32x2 w; w.x = pk2(rs[0], rs[1]); w.y = pk2(rs[2], rs[3]); *(u32x2*)(ar) = w;
              w.x = pk2(kp[0], kp[1]); w.y = pk2(kp[2], kp[3]); *(u32x2*)(ar + 256) = w;
              w.x = pk2(vs[0], vs[1]); w.y = pk2(vs[2], vs[3]); *(u32x2*)(ar + 512) = w;
              w.x = pk2(bb[0], bb[1]); w.y = pk2(bb[2], bb[3]); *(u32x2*)(ar + 768) = w;
              w.x = pk2(kk[0], kk[1]); w.y = pk2(kk[2], kk[3]); *(u32x2*)(C.ops(0) + (size_t)tok * 256 + c4) = w; } }
        __syncthreads();
        PSTAMP(45);
    }
}

DI float row8_sum(float x) { x += dpp_mov<0xB1>(x); x += dpp_mov<0x4E>(x); x += dpp_mov<0x141>(x); return x; }
struct QKTok { u32x4 cq, ckv, qn, kn, at; unsigned qr1, qr2, kr1, kr2, rq1, rq2, rk1, rk2; f32x4 rt; };
DI void qk_load(const Ctx& C, int tok, int lane, QKTok& R) {
    const int h = lane >> 3, sub = lane & 7; const int s = tok % SB;
    const bf16_t* pr = C.pbuf() + (size_t)tok * NPC; const bf16_t* qr = C.qkv() + (size_t)tok * QKVC;
    R.cq = (lane < 48) ? *(const u32x4*)(pr + lane * 8) : (u32x4){0u, 0u, 0u, 0u};
    R.ckv = (lane < 32) ? *(const u32x4*)(pr + 384 + lane * 8) : (u32x4){0u, 0u, 0u, 0u};
    R.qn = *(const u32x4*)(qr + h * 96 + sub * 8); R.qr1 = *(const unsigned*)(qr + h * 96 + 64 + 2 * sub); R.qr2 = *(const unsigned*)(qr + h * 96 + 80 + 2 * sub);
    R.kn = *(const u32x4*)(qr + 768 + h * 128 + sub * 8); R.kr1 = *(const unsigned*)(pr + C_KR + 2 * sub); R.kr2 = *(const unsigned*)(pr + C_KR + 16 + 2 * sub);
    R.at = *(const u32x4*)(C.ws + OFF_ROPE + ROPE_AT + ((size_t)((s >= CTXL) ? s - CTXL : 0) * 16 + 2 * sub) * 8);
    const int hh = lane >> 4, i2 = (lane & 15) * 2;
    R.rq1 = *(const unsigned*)(pr + C_RQ + hh * 64 + i2); R.rq2 = *(const unsigned*)(pr + C_RQ + hh * 64 + 32 + i2);
    R.rk1 = *(const unsigned*)(pr + C_RK + hh * 64 + i2); R.rk2 = *(const unsigned*)(pr + C_RK + hh * 64 + 32 + i2);
    R.rt = ((const f32x4*)(C.ws + OFF_ROPE))[(s * 32 + i2) >> 1];
}
DI float ssq4(u32x4 w) { float a = 0.f;
#pragma unroll
    for (int q = 0; q < 4; ++q) a += lo_f(w[q]) * lo_f(w[q]) + hi_f(w[q]) * hi_f(w[q]); return a; }
DI void qk_compute_store(const Ctx& C, int l, int tok, int lane, const QKTok& R, const float (&qgn)[8], const float (&kgn)[8], const float (&qgr)[4], const float (&kgr)[4]) {
    const int h = lane >> 3, sub = lane & 7;
    bf16_t* pr = C.pbuf() + (size_t)tok * NPC; bf16_t* qr = C.qkv() + (size_t)tok * QKVC; bf16_t* kr = C.kf() + (size_t)tok * 768;
    const float QS = 0.10206207261596577f * 1.4426950408889634f;
    const float sq = wave_sum(ssq4(R.cq)), sk = wave_sum(ssq4(R.ckv));
    const float rq = rsqrtf(sq * (1.f / 384.f) + 1e-6f), rk = rsqrtf(sk * (1.f / 256.f) + 1e-6f);
    const bool lat_ = (tok % SB) >= CTXL;
    const float cs0 = lat_ ? __uint_as_float(R.at[0]) : 1.f, sn0 = lat_ ? __uint_as_float(R.at[1]) : 0.f, cs1 = lat_ ? __uint_as_float(R.at[2]) : 1.f, sn1 = lat_ ? __uint_as_float(R.at[3]) : 0.f;
    { float n[8];
#pragma unroll
      for (int q = 0; q < 4; ++q) { n[2 * q] = lo_f(R.qn[q]) * rq; n[2 * q + 1] = hi_f(R.qn[q]) * rq; }
      const float a0 = lo_f(R.qr1) * rq, a1 = hi_f(R.qr1) * rq, b0 = lo_f(R.qr2) * rq, b1 = hi_f(R.qr2) * rq;
      float ss = a0 * a0 + a1 * a1 + b0 * b0 + b1 * b1;
#pragma unroll
      for (int q = 0; q < 8; ++q) ss += n[q] * n[q];
      ss = row8_sum(ss); const float rs = rsqrtf(ss * (1.f / 96.f) + 1e-6f) * QS;
      u32x4 w;
#pragma unroll
      for (int q = 0; q < 4; ++q) w[q] = pk2(n[2 * q] * rs * qgn[2 * q], n[2 * q + 1] * rs * qgn[2 * q + 1]);
      *(u32x4*)(qr + h * 96 + sub * 8) = w;
      const float x0 = a0 * rs * qgr[0], x1 = a1 * rs * qgr[1], y0 = b0 * rs * qgr[2], y1 = b1 * rs * qgr[3];
      *(unsigned*)(qr + h * 96 + 64 + 2 * sub) = pk2(x0 * cs0 - y0 * sn0, x1 * cs1 - y1 * sn1);
      *(unsigned*)(qr + h * 96 + 80 + 2 * sub) = pk2(x0 * sn0 + y0 * cs0, x1 * sn1 + y1 * cs1); }
    { float n[8];
#pragma unroll
      for (int q = 0; q < 4; ++q) { n[2 * q] = lo_f(R.kn[q]) * rk; n[2 * q + 1] = hi_f(R.kn[q]) * rk; }
      const float a0 = lo_f(R.kr1), a1 = hi_f(R.kr1), b0 = lo_f(R.kr2), b1 = hi_f(R.kr2);
      float ss = a0 * a0 + a1 * a1 + b0 * b0 + b1 * b1;
#pragma unroll
      for (int q = 0; q < 8; ++q) ss += n[q] * n[q];
      ss = row8_sum(ss); const float rs = rsqrtf(ss * (1.f / 96.f) + 1e-6f);
      u32x4 w;
#pragma unroll
      for (int q = 0; q < 4; ++q) w[q] = pk2(n[2 * q] * rs * kgn[2 * q], n[2 * q + 1] * rs * kgn[2 * q + 1]);
      *(u32x4*)(kr + h * 96 + sub * 8) = w;
      const float x0 = a0 * rs * kgr[0], x1 = a1 * rs * kgr[1], y0 = b0 * rs * kgr[2], y1 = b1 * rs * kgr[3];
      *(unsigned*)(kr + h * 96 + 64 + 2 * sub) = pk2(x0 * cs0 - y0 * sn0, x1 * cs1 - y1 * sn1);
      *(unsigned*)(kr + h * 96 + 80 + 2 * sub) = pk2(x0 * sn0 + y0 * cs0, x1 * sn1 + y1 * cs1); }
    { const int hh = lane >> 4, i2 = (lane & 15) * 2; const float c0 = R.rt[0], s0 = R.rt[1], c1 = R.rt[2], s1 = R.rt[3];
      { const float x10 = lo_f(R.rq1), x11 = hi_f(R.rq1), x20 = lo_f(R.rq2), x21 = hi_f(R.rq2);
        *(unsigned*)(pr + C_RQ + hh * 64 + i2) = pk2(x10 * c0 - x20 * s0, x11 * c1 - x21 * s1);
        *(unsigned*)(pr + C_RQ + hh * 64 + 32 + i2) = pk2(x10 * s0 + x20 * c0, x11 * s1 + x21 * c1); }
      { const float x10 = lo_f(R.rk1), x11 = hi_f(R.rk1), x20 = lo_f(R.rk2), x21 = hi_f(R.rk2);
        *(unsigned*)(pr + C_RK + hh * 64 + i2) = pk2((x10 * c0 - x20 * s0) * 0.125f, (x11 * c1 - x21 * s1) * 0.125f);
        *(unsigned*)(pr + C_RK + hh * 64 + 32 + i2) = pk2((x10 * s0 + x20 * c0) * 0.125f, (x11 * s1 + x21 * c1) * 0.125f); } }
}
DI void phase_qk_final(const Ctx& C, int l) {
    const int gw = C.bid * 8 + C.wave, GW = C.G * 8, lane = C.lane, sub = lane & 7;
    float qgn[8], kgn[8], qgr[4], kgr[4];
    { const float* qg = C.in[13] + l * 96; const float* kg = C.in[14] + l * 96;
#pragma unroll
      for (int q = 0; q < 8; ++q) { qgn[q] = qg[sub * 8 + q]; kgn[q] = kg[sub * 8 + q]; }
      qgr[0] = qg[64 + 2 * sub]; qgr[1] = qg[65 + 2 * sub]; qgr[2] = qg[80 + 2 * sub]; qgr[3] = qg[81 + 2 * sub];
      kgr[0] = kg[64 + 2 * sub]; kgr[1] = kg[65 + 2 * sub]; kgr[2] = kg[80 + 2 * sub]; kgr[3] = kg[81 + 2 * sub]; }
    QKTok A, B;
    int tok = gw;
    if (tok < T) qk_load(C, tok, lane, A);
    for (; tok < T; tok += 2 * GW) {
        const int tok2 = tok + GW; const bool has2 = tok2 < T;
        if (has2) qk_load(C, tok2, lane, B);
        qk_compute_store(C, l, tok, lane, A, qgn, kgn, qgr, kgr);
        if (tok2 + GW < T) qk_load(C, tok2 + GW, lane, A);
        if (has2) qk_compute_store(C, l, tok2, lane, B, qgn, kgn, qgr, kgr);
    }
}

namespace att {
constexpr int KVBLK = 64; constexpr int SHM_V = 64 * 128 * 2, SHM_K = 64 * 256;
#define KSWZ(row, colB) ((row) * 256 + ((colB) ^ (((row) & 7) << 4)))
#define SBAR() __builtin_amdgcn_sched_barrier(0)
DI int crow(int r, int hi) { return (r & 3) + 8 * (r >> 2) + 4 * hi; }
DI void partialSM(f32x16& p0, f32x16& p1) {
#pragma unroll
    for (int r = 0; r < 16; ++r) p0[r] = __builtin_amdgcn_exp2f(p0[r]);
}
DI void finishSM(f32x16& p0, f32x16& p1, float& l_reg, bf16x8& pa0, bf16x8& pa1, bf16x8& pa2, bf16x8& pa3) {
#pragma unroll
    for (int r = 0; r < 16; ++r) p1[r] = __builtin_amdgcn_exp2f(p1[r]);
    float ps = 0;
#pragma unroll
    for (int r = 0; r < 16; ++r) ps += p0[r];
#pragma unroll
    for (int r = 0; r < 16; ++r) ps += p1[r];
    l_reg += ps;
#define PK4(P, BASE, OUT) do { unsigned a0 = pk2(P[BASE + 0], P[BASE + 1]), a1 = pk2(P[BASE + 2], P[BASE + 3]);   \
    unsigned b0 = pk2(P[BASE + 4], P[BASE + 5]), b1 = pk2(P[BASE + 6], P[BASE + 7]);                              \
    auto r0 = __builtin_amdgcn_permlane32_swap(a0, b0, false, false); auto r1 = __builtin_amdgcn_permlane32_swap(a1, b1, false, false); \
    u32x4 w = {r0[0], r1[0], r0[1], r1[1]}; OUT = __builtin_bit_cast(bf16x8, w); } while (0)
    PK4(p0, 0, pa0); PK4(p0, 8, pa1); PK4(p1, 0, pa2); PK4(p1, 8, pa3);
#undef PK4
}
DI void qkt(f32x16& p0, f32x16& p1, const LAS char* Ks, const bf16x8* qr, int r32, int hi, float negM) {
#pragma unroll
    for (int r = 0; r < 16; ++r) { p0[r] = negM; p1[r] = negM; }
#pragma unroll
    for (int d0 = 0; d0 < 6; ++d0) { const int cb = (d0 * 16 + hi * 8) * 2;
        const bf16x8 b0 = *(const LAS bf16x8*)(Ks + KSWZ(r32, cb));
        const bf16x8 b1 = *(const LAS bf16x8*)(Ks + KSWZ(32 + r32, cb));
        p0 = __builtin_amdgcn_mfma_f32_32x32x16_bf16(b0, qr[d0], p0, 0, 0, 0);
        p1 = __builtin_amdgcn_mfma_f32_32x32x16_bf16(b1, qr[d0], p1, 0, 0, 0); }
}
DI int v_st(int k, int c) { const int kk = (k & ~0xC) | ((k & 4) << 1) | ((k & 8) >> 1); return ((kk >> 3) * 4 + (c >> 5)) * 512 + ((kk & 7) * 32 + (c & 31)) * 2; }
DI int v_rd_base(int lane) { return ((lane & 3) << 3) | (((lane >> 2) & 3) << 6) | (((lane >> 4) & 1) << 5) | (((lane >> 5) & 1) << 8); }
constexpr int v_rd_off(int d0, int ks, int half) { return d0 * 512 + ks * 4096 + half * 2048; }
template <int OFF> DI s16x4 tr_read(int vb) { s16x4 r; asm volatile("ds_read_b64_tr_b16 %0, %1 offset:%2" : "=&v"(r) : "v"(vb), "i"(OFF) : "memory"); return r; }
template <int D0> DI void pv_one(f32x16& od, int vb, bf16x8 pa0, bf16x8 pa1, bf16x8 pa2, bf16x8 pa3) {
    const s16x4 l0 = tr_read<v_rd_off(D0, 0, 0)>(vb), h0 = tr_read<v_rd_off(D0, 0, 1)>(vb), l1 = tr_read<v_rd_off(D0, 1, 0)>(vb), h1 = tr_read<v_rd_off(D0, 1, 1)>(vb);
    const s16x4 l2 = tr_read<v_rd_off(D0, 2, 0)>(vb), h2 = tr_read<v_rd_off(D0, 2, 1)>(vb), l3 = tr_read<v_rd_off(D0, 3, 0)>(vb), h3 = tr_read<v_rd_off(D0, 3, 1)>(vb);
    asm volatile("s_waitcnt lgkmcnt(0)" ::: "memory"); SBAR();
#define PKV(L, H) (bf16x8){L[0], L[1], L[2], L[3], H[0], H[1], H[2], H[3]}
    od = __builtin_amdgcn_mfma_f32_32x32x16_bf16(pa0, PKV(l0, h0), od, 0, 0, 0);
    od = __builtin_amdgcn_mfma_f32_32x32x16_bf16(pa1, PKV(l1, h1), od, 0, 0, 0);
    od = __builtin_amdgcn_mfma_f32_32x32x16_bf16(pa2, PKV(l2, h2), od, 0, 0, 0);
    od = __builtin_amdgcn_mfma_f32_32x32x16_bf16(pa3, PKV(l3, h3), od, 0, 0, 0);
#undef PKV
}
constexpr int LDQ = QKVC, LDK = 768, LDV = QKVC, LDO = NPC;
DI void attn_body(const bf16_t* __restrict__ Qb, const bf16_t* __restrict__ Kh, const bf16_t* __restrict__ Vh, bf16_t* __restrict__ Ob, int seq, LAS char* lds, const int tid, const float negM) {
    const int wid = tid >> 6, lane = tid & 63, r32 = lane & 31, hi = lane >> 5;
    LAS char* V_lds = lds; LAS char* K_lds = lds + 2 * SHM_V;
    LAS float* wsl = (LAS float*)(lds + 2 * SHM_V + 2 * SHM_K) + wid * 64; LAS float* li_l = wsl;
    float l_reg = 0; f32x16 o[2]; bf16x8 qr[6];
#pragma unroll
    for (int d = 0; d < 2; ++d)
#pragma unroll
        for (int r = 0; r < 16; ++r) o[d][r] = 0.f;
    const bf16_t* Qw = Qb + (size_t)(wid * 32 + r32) * LDQ + hi * 8;
#pragma unroll
    for (int d0 = 0; d0 < 6; ++d0) qr[d0] = *(const bf16x8*)(Qw + d0 * 16);
    const int kc1 = tid, kc2 = 512 + (tid & 255);
    const int kr1 = kc1 / 12, kq1 = kc1 % 12, kr2 = kc2 / 12, kq2 = kc2 % 12;
    const int vr = tid >> 3, vq = (tid & 7) * 8, vst = v_st(vr, vq);
    const int vb0 = (int)(uintptr_t)V_lds + v_rd_base(lane);
    struct { bf16x8 k1, k2, v; } sr_[2];
#define SLOAD(i, k0) do { sr_[i].k1 = *(const bf16x8*)(Kh + (size_t)((k0) + kr1) * LDK + kq1 * 8); sr_[i].k2 = *(const bf16x8*)(Kh + (size_t)((k0) + kr2) * LDK + kq2 * 8); \
    sr_[i].v = *(const bf16x8*)(Vh + (size_t)((k0) + vr) * LDV + vq); } while (0)
#define SWRITE(b, i) do { *(LAS bf16x8*)(V_lds + (b) * SHM_V + vst) = sr_[i].v; \
    *(LAS bf16x8*)(K_lds + (b) * SHM_K + KSWZ(kr1, kq1 * 16)) = sr_[i].k1; *(LAS bf16x8*)(K_lds + (b) * SHM_K + KSWZ(kr2, kq2 * 16)) = sr_[i].k2; } while (0)
#define SWAIT() asm volatile("s_waitcnt vmcnt(3)" ::: "memory")
    f32x16 pA0, pA1, pB0, pB1; bf16x8 pa0, pa1, pa2, pa3; const int NT = seq / KVBLK;
    constexpr int SE = 0, SO = 1;
    SLOAD(SE, 0); asm volatile("s_waitcnt vmcnt(0)" ::: "memory"); SWRITE(0, SE); __syncthreads();
    qkt(pA0, pA1, K_lds, qr, r32, hi, negM); partialSM(pA0, pA1);
    SLOAD(SO, KVBLK); if (2 < NT) SLOAD(SE, 2 * KVBLK);
    SWAIT(); SWRITE(1, SO); __syncthreads();
    for (int j = 1; j + 1 < NT; j += 2) {
        SBAR(); qkt(pB0, pB1, K_lds + SHM_K, qr, r32, hi, negM);
        finishSM(pA0, pA1, l_reg, pa0, pa1, pa2, pa3); SBAR();
        SLOAD(SO, (j + 2) * KVBLK); SBAR();
        pv_one<0>(o[0], vb0, pa0, pa1, pa2, pa3); pv_one<1>(o[1], vb0, pa0, pa1, pa2, pa3); partialSM(pB0, pB1);
        __syncthreads(); SWAIT(); SWRITE(0, SE);
        __syncthreads();
        SBAR(); qkt(pA0, pA1, K_lds, qr, r32, hi, negM);
        finishSM(pB0, pB1, l_reg, pa0, pa1, pa2, pa3); SBAR();
        if (j + 3 < NT) SLOAD(SE, (j + 3) * KVBLK); else SLOAD(SE, 0); SBAR();
        pv_one<0>(o[0], vb0 + SHM_V, pa0, pa1, pa2, pa3); pv_one<1>(o[1], vb0 + SHM_V, pa0, pa1, pa2, pa3); partialSM(pA0, pA1);
        __syncthreads(); SWAIT(); SWRITE(1, SO);
        __syncthreads();
    }
    SBAR(); qkt(pB0, pB1, K_lds + SHM_K, qr, r32, hi, negM);
    finishSM(pA0, pA1, l_reg, pa0, pa1, pa2, pa3); SBAR();
    pv_one<0>(o[0], vb0, pa0, pa1, pa2, pa3); pv_one<1>(o[1], vb0, pa0, pa1, pa2, pa3); partialSM(pB0, pB1);
    __syncthreads();
    finishSM(pB0, pB1, l_reg, pa0, pa1, pa2, pa3); SBAR();
    pv_one<0>(o[0], vb0 + SHM_V, pa0, pa1, pa2, pa3); pv_one<1>(o[1], vb0 + SHM_V, pa0, pa1, pa2, pa3);
    { auto rr = __builtin_amdgcn_permlane32_swap(__float_as_uint(l_reg), __float_as_uint(l_reg), false, false); l_reg = __uint_as_float(rr[0]) + __uint_as_float(rr[1]); }
    if (hi == 0) li_l[r32] = l_reg; asm volatile("s_waitcnt lgkmcnt(0)" ::: "memory");
    float rli[16];
#pragma unroll
    for (int r = 0; r < 16; ++r) rli[r] = __builtin_amdgcn_rcpf(li_l[crow(r, hi)]);
    bf16_t* Ow = Ob + (size_t)(wid * 32) * LDO;
#pragma unroll
    for (int r = 0; r < 16; ++r) { const int orow = crow(r, hi);
#pragma unroll
        for (int d0 = 0; d0 < 2; ++d0) Ow[(size_t)orow * LDO + d0 * 32 + r32] = f2bf(o[d0][r] * rli[r]); }
    asm volatile("s_waitcnt vmcnt(0)" ::: "memory");
    __syncthreads();
#undef SLOAD
#undef SWRITE
#undef SWAIT
}
}

DI int scan_tok(int base, int dir, int n) { return base + (dir == 0 ? n : (n < CTXL ? (CTXL - 1 - n) : (SB + CTXL - 1 - n))); }
DI void cvt8(const bf16x8 v, float (&f)[8]) {
    const u32x4 w = __builtin_bit_cast(u32x4, v);
    f[0] = lo_f(w.x); f[1] = hi_f(w.x); f[2] = lo_f(w.y); f[3] = hi_f(w.y); f[4] = lo_f(w.z); f[5] = hi_f(w.z); f[6] = lo_f(w.w); f[7] = hi_f(w.w);
}
DI float row16_sum1(float x) {
    asm("s_nop 1\n\t"
        "v_add_f32_dpp %0, %0, %0 quad_perm:[1,0,3,2] row_mask:0xf bank_mask:0xf bound_ctrl:1\n\t"
        "s_nop 1\n\t"
        "v_add_f32_dpp %0, %0, %0 quad_perm:[2,3,0,1] row_mask:0xf bank_mask:0xf bound_ctrl:1\n\t"
        "s_nop 1\n\t"
        "v_add_f32_dpp %0, %0, %0 row_half_mirror row_mask:0xf bank_mask:0xf bound_ctrl:1\n\t"
        "s_nop 1\n\t"
        "v_add_f32_dpp %0, %0, %0 row_mirror row_mask:0xf bank_mask:0xf bound_ctrl:1\n\t"
        "s_nop 0"
        : "+v"(x));
    return x;
}
DI void row16_sum4(float& a, float& b, float& c, float& d) {
#define R4_(MODE) "v_add_f32_dpp %0, %0, %0 " MODE " row_mask:0xf bank_mask:0xf bound_ctrl:1\n\t" "v_add_f32_dpp %1, %1, %1 " MODE " row_mask:0xf bank_mask:0xf bound_ctrl:1\n\t" \
                  "v_add_f32_dpp %2, %2, %2 " MODE " row_mask:0xf bank_mask:0xf bound_ctrl:1\n\t" "v_add_f32_dpp %3, %3, %3 " MODE " row_mask:0xf bank_mask:0xf bound_ctrl:1\n\t"
    asm("s_nop 1\n\t" R4_("quad_perm:[1,0,3,2]") R4_("quad_perm:[2,3,0,1]") R4_("row_half_mirror") R4_("row_mirror") "s_nop 0" : "+v"(a), "+v"(b), "+v"(c), "+v"(d));
#undef R4_
}
DI void rwkv_scan_item(const Ctx& C, int b, int h, int dir, int half) {
    constexpr int TC = 32, ARR = TC * 64;
    LAS float* buf = (LAS float*)C.lds;
    LAS float* yL = (LAS float*)(C.lds + 2 * 6 * ARR * 4);
    const int tid = C.tid, i0 = tid >> 4, cgp = tid & 15;
    const int base = b * SB;
    const bf16_t* ACT = C.act(); const bf16_t* O0 = C.ops(0); const bf16_t* OW = C.ops(1 + dir);
    bf16_t* ydst = C.pbuf() + (dir ? C_YB : C_YF) + h * 64 + half * 32;
    f32x2 S01 = {0.f, 0.f}, S23 = {0.f, 0.f};
    const int sidx = tid & 255, sti = sidx >> 3, spart = sidx & 7, styp = tid >> 8;
    bf16x8 la, lb, lc, ld; la = lb = lc = ld = (bf16x8){0, 0, 0, 0, 0, 0, 0, 0};
#define RW_LOAD(c) do { const int tk = scan_tok(base, dir, (c) * TC + sti); const bf16_t* ar = ACT + (size_t)tk * DM + h * 64 + spart * 8; \
        la = *(const bf16x8*)(ar + (styp ? 256 : 0)); \
        lb = styp ? *(const bf16x8*)(OW + (size_t)tk * 256 + h * 64 + spart * 8) : *(const bf16x8*)(ar + 512); \
        if (styp == 0) { lc = *(const bf16x8*)(O0 + (size_t)tk * 256 + h * 64 + spart * 8); ld = *(const bf16x8*)(ar + 768); } } while (0)
#define RW_WRITE(nb) do { LAS float* B = buf + (nb) * 6 * ARR; float f[8]; const int o = sti * 64 + spart * 8; \
        cvt8(la, f); { LAS float* d = B + (styp ? 3 : 4) * ARR + o; *(LAS f32x4*)d = (f32x4){f[0], f[1], f[2], f[3]}; *(LAS f32x4*)(d + 4) = (f32x4){f[4], f[5], f[6], f[7]}; } \
        cvt8(lb, f); if (styp) { LAS float* d = B + 1 * ARR + o; *(LAS f32x4*)d = (f32x4){1.f - f[0], 1.f - f[1], 1.f - f[2], 1.f - f[3]}; *(LAS f32x4*)(d + 4) = (f32x4){1.f - f[4], 1.f - f[5], 1.f - f[6], 1.f - f[7]}; } \
        else { LAS float* d = B + 5 * ARR + o; *(LAS f32x4*)d = (f32x4){f[0], f[1], f[2], f[3]}; *(LAS f32x4*)(d + 4) = (f32x4){f[4], f[5], f[6], f[7]}; } \
        if (styp == 0) { cvt8(lc, f); { LAS float* d = B + 0 * ARR + o; *(LAS f32x4*)d = (f32x4){f[0], f[1], f[2], f[3]}; *(LAS f32x4*)(d + 4) = (f32x4){f[4], f[5], f[6], f[7]}; } \
            cvt8(ld, f); { LAS float* d = B + 2 * ARR + o; *(LAS f32x4*)d = (f32x4){f[0], f[1], f[2], f[3]}; *(LAS f32x4*)(d + 4) = (f32x4){f[4], f[5], f[6], f[7]}; } } } while (0)
    constexpr int NCH = SB / TC;
    RW_LOAD(0); RW_WRITE(0); __syncthreads();
    for (int c = 0; c < NCH; ++c) {
        const int cur = c & 1;
        if (c + 1 < NCH) RW_LOAD(c + 1);
        const LAS float* B = buf + cur * 6 * ARR;
        const LAS float* Bq = B + cgp * 4; const LAS float* Bv = B + 5 * ARR + half * 32 + i0;
        float yk = 0.f;
#define RW_FETCH(P, t) const f32x4 P##kk = *(const LAS f32x4*)(Bq + (t) * 64), P##w = *(const LAS f32x4*)(Bq + ARR + (t) * 64), P##b = *(const LAS f32x4*)(Bq + 2 * ARR + (t) * 64), \
            P##k = *(const LAS f32x4*)(Bq + 3 * ARR + (t) * 64), P##r = *(const LAS f32x4*)(Bq + 4 * ARR + (t) * 64); const float P##v = Bv[(t) * 64]
#define RW_STEP(P, YP) do { const f32x2 kk01 = {P##kk[0], P##kk[1]}, kk23 = {P##kk[2], P##kk[3]}, w01 = {P##w[0], P##w[1]}, w23 = {P##w[2], P##w[3]}, b01 = {P##b[0], P##b[1]}, b23 = {P##b[2], P##b[3]}, \
                k01 = {P##k[0], P##k[1]}, k23 = {P##k[2], P##k[3]}, r01 = {P##r[0], P##r[1]}, r23 = {P##r[2], P##r[3]}; \
            const f32x2 d2 = S01 * kk01 + S23 * kk23; const float d = row16_sum1(d2.x + d2.y); \
            S01 = S01 * w01 + (k01 * P##v - b01 * d); S23 = S23 * w23 + (k23 * P##v - b23 * d); \
            const f32x2 y2 = S01 * r01 + S23 * r23; YP = y2.x + y2.y; } while (0)
#pragma unroll 1
        for (int g = 0; g < TC / 16; ++g) {
#pragma unroll 1
            for (int tt = 0; tt < 16; tt += 4) { const int t = g * 16 + tt;
                float y0, y1, y2_, y3;
                RW_FETCH(a_, t); RW_FETCH(b_, t + 1);
                __builtin_amdgcn_sched_barrier(0);
                RW_STEP(a_, y0);
                RW_FETCH(c_, t + 2);
                __builtin_amdgcn_sched_barrier(0);
                RW_STEP(b_, y1);
                RW_FETCH(d_, t + 3);
                __builtin_amdgcn_sched_barrier(0);
                RW_STEP(c_, y2_);
                __builtin_amdgcn_sched_barrier(0);
                RW_STEP(d_, y3);
                row16_sum4(y0, y1, y2_, y3);
                const int q = cgp - tt; yk = (q == 0) ? y0 : (q == 1) ? y1 : (q == 2) ? y2_ : (q == 3) ? y3 : yk; }
            yL[(g * 16 + cgp) * 32 + i0] = yk;
        }
#undef RW_FETCH
#undef RW_STEP
        __syncthreads();
        { const int ti = tid >> 4, c2 = (tid & 15) * 2; const f32x2 y = *(const LAS f32x2*)(yL + ti * 32 + c2);
          const int tk = scan_tok(base, dir, c * TC + ti);
          *(unsigned*)(ydst + (size_t)tk * NPC + c2) = pk2(y[0], y[1]); }
        if (c + 1 < NCH) RW_WRITE(cur ^ 1);
        __syncthreads();
    }
#undef RW_LOAD
#undef RW_WRITE
}

namespace rk {
constexpr int RAW_BYTES = 64 * 6 * 64 * 2;
constexpr int SL_KK = 0, SL_R = 2304, SL_K = 4608, SL_B = 6912, SL_KT = 9216, SL_BT = 11776, SL_VT = 14336, SL_P16 = 16896, SL_ABF = 17152,
              SL_T = 18304, SL_AK = 18944, SL_GK = 19584, SL_GB = 20224, SLOT = 20992;
typedef short s16x4v __attribute__((ext_vector_type(4)));
DI s16x4v pack4(const f32x4 v) { u32x2 w; w.x = pk2(v[0], v[1]); w.y = pk2(v[2], v[3]); return __builtin_bit_cast(s16x4v, w); }
DI f32x4 mm16(const s16x4v a, const s16x4v b, const f32x4 c) { return __builtin_amdgcn_mfma_f32_16x16x16bf16_1k(a, b, c, 0, 0, 0); }
DI void prep(LAS unsigned char* lds, int q, int lane) {
    const LAS bf16_t* raw = (const LAS bf16_t*)lds + (size_t)(16 * q) * 384;
    LAS unsigned char* sl = lds + RAW_BYTES + q * SLOT;
    LAS bf16_t* KKs = (LAS bf16_t*)(sl + SL_KK); LAS bf16_t* Rs = (LAS bf16_t*)(sl + SL_R); LAS bf16_t* Ks = (LAS bf16_t*)(sl + SL_K); LAS bf16_t* Bs = (LAS bf16_t*)(sl + SL_B);
    LAS bf16_t* KT = (LAS bf16_t*)(sl + SL_KT); LAS bf16_t* BT = (LAS bf16_t*)(sl + SL_BT); LAS bf16_t* VT = (LAS bf16_t*)(sl + SL_VT);
    LAS float* P16 = (LAS float*)(sl + SL_P16); LAS float* Abf = (LAS float*)(sl + SL_ABF);
    LAS bf16_t* Tb = (LAS bf16_t*)(sl + SL_T); LAS bf16_t* AKb = (LAS bf16_t*)(sl + SL_AK); LAS bf16_t* GKb = (LAS bf16_t*)(sl + SL_GK); LAS bf16_t* GBb = (LAS bf16_t*)(sl + SL_GB);
    float P = 1.f;
#pragma unroll
    for (int t4 = 0; t4 < 4; ++t4) { unsigned kq[4], bq[4], vq[4];
#pragma unroll
        for (int tj = 0; tj < 4; ++tj) { const int t = t4 * 4 + tj; const LAS bf16_t* rt = raw + t * 384 + lane;
            const float wv = 1.f - bf2f(rt[5 * 64]); const float Pp = P; P *= wv; const float ip = __builtin_amdgcn_rcpf(P);
            const float kkv = bf2f(rt[4 * 64]) * Pp, rv = bf2f(rt[0]) * P, kv = bf2f(rt[64]) * ip, bv = bf2f(rt[3 * 64]) * ip;
            const bf16_t kb = f2bf(kv), bbv = f2bf(bv);
            KKs[t * 72 + lane] = f2bf(kkv); Rs[t * 72 + lane] = f2bf(rv); Ks[t * 72 + lane] = kb; Bs[t * 72 + lane] = bbv;
            kq[tj] = kb; bq[tj] = f2bf(-bv); vq[tj] = rt[2 * 64]; }
        u32x2 w; w.x = kq[0] | (kq[1] << 16); w.y = kq[2] | (kq[3] << 16); *(LAS u32x2*)(KT + lane * 20 + t4 * 4) = w;
        w.x = bq[0] | (bq[1] << 16); w.y = bq[2] | (bq[3] << 16); *(LAS u32x2*)(BT + lane * 20 + t4 * 4) = w;
        w.x = vq[0] | (vq[1] << 16); w.y = vq[2] | (vq[3] << 16); *(LAS u32x2*)(VT + lane * 20 + t4 * 4) = w; }
    P16[lane] = P;
    asm volatile("s_waitcnt lgkmcnt(0)" ::: "memory"); __builtin_amdgcn_wave_barrier();
    const int r_ = lane & 15, g = lane >> 4;
    f32x4 ab = {0.f, 0.f, 0.f, 0.f}, ak = ab, gk = ab, gb = ab;
#pragma unroll
    for (int ks = 0; ks < 2; ++ks) { const int o = r_ * 72 + ks * 32 + 8 * g;
        const bf16x8 akk = *(const LAS bf16x8*)(KKs + o), ar = *(const LAS bf16x8*)(Rs + o), bk = *(const LAS bf16x8*)(Ks + o), bbf = *(const LAS bf16x8*)(Bs + o);
        ab = __builtin_amdgcn_mfma_f32_16x16x32_bf16(akk, bbf, ab, 0, 0, 0); ak = __builtin_amdgcn_mfma_f32_16x16x32_bf16(akk, bk, ak, 0, 0, 0);
        gk = __builtin_amdgcn_mfma_f32_16x16x32_bf16(ar, bk, gk, 0, 0, 0); gb = __builtin_amdgcn_mfma_f32_16x16x32_bf16(ar, bbf, gb, 0, 0, 0); }
#pragma unroll
    for (int rg = 0; rg < 4; ++rg) { const int t = 4 * g + rg, s_ = r_;
        Abf[t * 17 + s_] = (s_ < t) ? ab[rg] : 0.f;
        AKb[t * 20 + s_] = f2bf((s_ < t) ? ak[rg] : 0.f); GKb[t * 20 + s_] = f2bf((s_ <= t) ? gk[rg] : 0.f); GBb[t * 20 + s_] = f2bf((s_ <= t) ? -gb[rg] : 0.f); }
    asm volatile("s_waitcnt lgkmcnt(0)" ::: "memory"); __builtin_amdgcn_wave_barrier();
    float Tc[16];
#pragma unroll
    for (int t = 0; t < 16; ++t) { float a = (t == r_) ? 1.f : 0.f;
#pragma unroll
        for (int s_ = 0; s_ < t; ++s_) a -= Abf[t * 17 + s_] * Tc[s_];
        Tc[t] = a; }
    if (g == 0) {
#pragma unroll
        for (int t = 0; t < 16; ++t) Tb[t * 20 + r_] = f2bf(Tc[t]); }
}
DI void crit(LAS unsigned char* lds, int q, int vt, int lane, f32x4 (&ST)[4], bf16_t* ydst, int base, int dir, int n0) {
    LAS unsigned char* sl = lds + RAW_BYTES + q * SLOT;
    const LAS bf16_t* KKs = (const LAS bf16_t*)(sl + SL_KK); const LAS bf16_t* Rs = (const LAS bf16_t*)(sl + SL_R);
    const LAS bf16_t* KT = (const LAS bf16_t*)(sl + SL_KT); const LAS bf16_t* BT = (const LAS bf16_t*)(sl + SL_BT); const LAS bf16_t* VT = (const LAS bf16_t*)(sl + SL_VT);
    const LAS float* P16 = (const LAS float*)(sl + SL_P16);
    const LAS bf16_t* Tb = (const LAS bf16_t*)(sl + SL_T); const LAS bf16_t* AKb = (const LAS bf16_t*)(sl + SL_AK); const LAS bf16_t* GKb = (const LAS bf16_t*)(sl + SL_GK); const LAS bf16_t* GBb = (const LAS bf16_t*)(sl + SL_GB);
    const int r_ = lane & 15, g = lane >> 4; const f32x4 zero = {0.f, 0.f, 0.f, 0.f};
    const s16x4v vf = *(const LAS s16x4v*)(VT + (16 * vt + r_) * 20 + 4 * g);
    s16x4v ps[4];
#pragma unroll
    for (int kt = 0; kt < 4; ++kt) ps[kt] = pack4(ST[kt]);
    f32x4 x1 = mm16(*(const LAS s16x4v*)(AKb + r_ * 20 + 4 * g), vf, zero);
#pragma unroll
    for (int kt = 0; kt < 4; ++kt) x1 = mm16(*(const LAS s16x4v*)(KKs + r_ * 72 + 16 * kt + 4 * g), ps[kt], x1);
    const f32x4 u = mm16(*(const LAS s16x4v*)(Tb + r_ * 20 + 4 * g), pack4(x1), zero);
    const s16x4v pu = pack4(u);
    f32x4 y = mm16(*(const LAS s16x4v*)(GKb + r_ * 20 + 4 * g), vf, zero);
#pragma unroll
    for (int kt = 0; kt < 4; ++kt) y = mm16(*(const LAS s16x4v*)(Rs + r_ * 72 + 16 * kt + 4 * g), ps[kt], y);
    y = mm16(*(const LAS s16x4v*)(GBb + r_ * 20 + 4 * g), pu, y);
#pragma unroll
    for (int kt = 0; kt < 4; ++kt) { f32x4 a = mm16(*(const LAS s16x4v*)(KT + (16 * kt + r_) * 20 + 4 * g), vf, ST[kt]);
        a = mm16(*(const LAS s16x4v*)(BT + (16 * kt + r_) * 20 + 4 * g), pu, a);
        ST[kt] = a * *(const LAS f32x4*)(P16 + 16 * kt + 4 * g); }
#pragma unroll
    for (int rg = 0; rg < 4; ++rg) { const int tk = scan_tok(base, dir, n0 + 4 * g + rg); ydst[(size_t)tk * NPC + 16 * vt + r_] = f2bf(y[rg]); }
}
}
DI void rwkv_chunk_item(const Ctx& C, int b, int h, int dir) {
    LAS unsigned char* lds = C.lds; const int tid = C.tid, lane = C.lane, wave = C.wave;
    const int base = b * SB; const int tl = tid >> 3, part = tid & 7;
    const bf16_t* ACT = C.act() + h * 64 + part * 8; const bf16_t* O0 = C.ops(0) + h * 64 + part * 8; const bf16_t* OW = C.ops(1 + dir) + h * 64 + part * 8;
    bf16_t* ydst = C.pbuf() + (dir ? C_YB : C_YF) + h * 64;
    f32x4 ST[4];
#pragma unroll
    for (int kt = 0; kt < 4; ++kt) ST[kt] = (f32x4){0.f, 0.f, 0.f, 0.f};
    u32x4 RA[6], RB[6];
#define RK_LD(R, bt) do { const int tk = scan_tok(base, dir, (bt) * 64 + tl); const bf16_t* ar = ACT + (size_t)tk * DM; \
        R[0] = *(const u32x4*)(ar); R[1] = *(const u32x4*)(ar + 256); R[2] = *(const u32x4*)(ar + 512); R[3] = *(const u32x4*)(ar + 768); \
        R[4] = *(const u32x4*)(O0 + (size_t)tk * 256); R[5] = *(const u32x4*)(OW + (size_t)tk * 256); } while (0)
#define RK_WR(R) do { LAS unsigned char* d_ = lds + (tl * 6) * 128 + part * 16; _Pragma("unroll") for (int a_ = 0; a_ < 6; ++a_) *(LAS u32x4*)(d_ + a_ * 128) = R[a_]; } while (0)
    RK_LD(RA, 0); RK_WR(RA); __syncthreads();
    RK_LD(RA, 1); RK_LD(RB, 2);
    for (int i = 0; i < 68; i += 2) {
        if (wave < 4) rk::prep(lds, wave, lane);
        __syncthreads();
        RK_WR(RA); if (i + 3 < 68) RK_LD(RA, i + 3);
        if (wave < 4) {
#pragma unroll 1
            for (int q = 0; q < 4; ++q) rk::crit(lds, q, wave, lane, ST, ydst, base, dir, i * 64 + q * 16); }
        __syncthreads();
        if (wave < 4) rk::prep(lds, wave, lane);
        __syncthreads();
        if (i + 2 < 68) RK_WR(RB); if (i + 4 < 68) RK_LD(RB, i + 4);
        if (wave < 4) {
#pragma unroll 1
            for (int q = 0; q < 4; ++q) rk::crit(lds, q, wave, lane, ST, ydst, base, dir, (i + 1) * 64 + q * 16); }
        __syncthreads();
    }
#undef RK_LD
#undef RK_WR
}

DI f32x4 mma16(const LAS bf16_t* A, int lda, const LAS bf16_t* Bm, int ldb, int ksteps, int lane, f32x4 acc) {
    for (int ks = 0; ks < ksteps; ++ks) {
        const bf16x8 a = *(const LAS bf16x8*)(A + (lane & 15) * lda + ks * 32 + 8 * (lane >> 4));
        const bf16x8 b = *(const LAS bf16x8*)(Bm + (lane & 15) * ldb + ks * 32 + 8 * (lane >> 4));
        acc = __builtin_amdgcn_mfma_f32_16x16x32_bf16(a, b, acc, 0, 0, 0); }
    return acc;
}
DI void retention_item(const Ctx& C, int l, int b, int h, int dir) {
    constexpr int LQ = 72, LT = 136;
    LAS bf16_t* Qs = (LAS bf16_t*)C.lds;
    LAS bf16_t* Ks = Qs + 128 * LQ;
    LAS bf16_t* Kzt = Ks + 128 * LQ;
    LAS bf16_t* Vt = Kzt + 64 * LT;
    LAS bf16_t* At = Vt + 64 * LT;
    LAS bf16_t* rT = At + 128 * LT;
    const int tid = C.tid, lane = C.lane, wave = C.wave; const int base = b * SB;
    const float x = C.in[15][(l * 2 + dir) * 4 + h];
    const float lg2 = -log1pf(__expf(-x)) * 1.4426950408889634f;
    const float gchunk = exp2f(lg2 * 128.f);
    const float zeta_c = exp2f(lg2 * (float)(127 - (tid >> 2)));
    float dmc[8][4], xic[4];
#pragma unroll
    for (int nt = 0; nt < 8; ++nt)
#pragma unroll
        for (int r = 0; r < 4; ++r) { const int i = wave * 16 + 4 * (lane >> 4) + r, j = nt * 16 + (lane & 15); dmc[nt][r] = (i >= j) ? exp2f(lg2 * (float)(i - j)) : 0.f; }
#pragma unroll
    for (int r = 0; r < 4; ++r) xic[r] = exp2f(lg2 * (float)(wave * 16 + 4 * (lane >> 4) + r + 1));
    bf16_t* Pp = C.pbuf(); bf16_t* odst = Pp + (dir ? C_OB : C_OF) + h * 64;
    f32x4 rst[2] = {{0.f, 0.f, 0.f, 0.f}, {0.f, 0.f, 0.f, 0.f}};
    for (int i = tid; i < 64 * LQ; i += NTHR) rT[i] = 0;
    const int si = tid >> 2, sp = tid & 3;
    bf16x8 gq[2], gk[2], gv[2];
#define RT_LOAD(c) do { const int tk = scan_tok(base, dir, (c) * 128 + si); const bf16_t* pr = Pp + (size_t)tk * NPC + h * 64 + sp * 16; \
        gq[0] = *(const bf16x8*)(pr + C_RQ); gq[1] = *(const bf16x8*)(pr + C_RQ + 8); gk[0] = *(const bf16x8*)(pr + C_RK); gk[1] = *(const bf16x8*)(pr + C_RK + 8); \
        gv[0] = *(const bf16x8*)(pr + C_RV); gv[1] = *(const bf16x8*)(pr + C_RV + 8); } while (0)
    RT_LOAD(0);
    __syncthreads();
    for (int c = 0; c < 34; ++c) {
        { *(LAS bf16x8*)(Qs + si * LQ + sp * 16) = gq[0]; *(LAS bf16x8*)(Qs + si * LQ + sp * 16 + 8) = gq[1];
          *(LAS bf16x8*)(Ks + si * LQ + sp * 16) = gk[0]; *(LAS bf16x8*)(Ks + si * LQ + sp * 16 + 8) = gk[1];
          const float zeta = zeta_c;
#pragma unroll
          for (int hh = 0; hh < 2; ++hh) { float f[8]; cvt8(gk[hh], f);
#pragma unroll
              for (int j = 0; j < 8; ++j) Kzt[(sp * 16 + hh * 8 + j) * LT + si] = f2bf(f[j] * zeta);
#pragma unroll
              for (int j = 0; j < 8; ++j) Vt[(sp * 16 + hh * 8 + j) * LT + si] = (bf16_t)gv[hh][j]; } }
        __syncthreads();
        if (c + 1 < 34) RT_LOAD(c + 1);
        { const LAS bf16_t* Aq = Qs + (wave * 16) * LQ;
#pragma unroll
          for (int nt = 0; nt < 8; ++nt) { f32x4 acc = {0.f, 0.f, 0.f, 0.f}; acc = mma16(Aq, LQ, Ks + (nt * 16) * LQ, LQ, 2, lane, acc);
              const int j = nt * 16 + (lane & 15);
#pragma unroll
              for (int r = 0; r < 4; ++r) { const int i = wave * 16 + 4 * (lane >> 4) + r; const float dm = dmc[nt][r];
                  At[i * LT + j] = f2bf(acc[r] * dm); } } }
        asm volatile("s_waitcnt lgkmcnt(0)" ::: "memory");
        __builtin_amdgcn_wave_barrier();
        { const LAS bf16_t* Aa = At + (wave * 16) * LT; const LAS bf16_t* Aq = Qs + (wave * 16) * LQ;
#pragma unroll
          for (int nt = 0; nt < 4; ++nt) { f32x4 a1 = {0.f, 0.f, 0.f, 0.f}, a2 = {0.f, 0.f, 0.f, 0.f};
              a1 = mma16(Aa, LT, Vt + (nt * 16) * LT, LT, 4, lane, a1);
              a2 = mma16(Aq, LQ, rT + (nt * 16) * LQ, LQ, 2, lane, a2);
              const int dv = nt * 16 + (lane & 15);
#pragma unroll
              for (int r = 0; r < 4; ++r) { const int i = wave * 16 + 4 * (lane >> 4) + r; const float xi = xic[r];
                  const int tk = scan_tok(base, dir, c * 128 + i);
                  odst[(size_t)tk * NPC + dv] = f2bf(a1[r] + a2[r] * xi); } } }
        __syncthreads();
        { const int mt = wave >> 1;
#pragma unroll
          for (int i2 = 0; i2 < 2; ++i2) { const int nt = 2 * (wave & 1) + i2; f32x4 acc = {0.f, 0.f, 0.f, 0.f};
              acc = mma16(Kzt + (mt * 16) * LT, LT, Vt + (nt * 16) * LT, LT, 4, lane, acc);
              rst[i2] = rst[i2] * gchunk + acc;
              const int dv = nt * 16 + (lane & 15), dk0 = mt * 16 + 4 * (lane >> 4);
              u32x2 w; w.x = pk2(rst[i2][0], rst[i2][1]); w.y = pk2(rst[i2][2], rst[i2][3]);
              *(LAS u32x2*)(rT + dv * LQ + dk0) = w; } }
        __syncthreads();
    }
#undef RT_LOAD
}

DI void phase_mixers(const Ctx& C0, int l) {
    LAS int* slot = (LAS int*)(C0.lds + LDS_BYTES - 16);
    const int n_att = (l == 0) ? 1024 + 64 : 1024;
    const int total = 128 + n_att + WX_NGU / 8;
#ifdef DIAG_ITEMS
    int nit = 0;
#endif
    float gqm = 0.f, gkm = 0.f;
    for (int i = 0; i < 96; ++i) { gqm = fmaxf(gqm, fabsf(C0.in[13][l * 96 + i])); gkm = fmaxf(gkm, fabsf(C0.in[14][l * 96 + i])); }
    const float negM = -(96.f * 0.10206207261596577f * 1.4426950408889634f) * gqm * gkm;
    bool first = true;
    for (;;) {
        __syncthreads();
        if (C0.tid == 0) *slot = (first && C0.bid < 128) ? C0.bid : 128 + atomicAdd(C0.cnt() + l, 1);
        first = false;
        __syncthreads();
        const int it = *slot;
#ifdef DIAG_ITEMS
        if (l == 0 && C0.bid == DIAG_BLK && C0.tid == 0 && nit < 6) ((unsigned long long*)(C0.ws + OFF_CNT + 4096))[32 + nit] = __builtin_amdgcn_s_memrealtime();
        ++nit;
#endif
        if (it >= total) break;
        Ctx C2 = C0; asm volatile("" : "+v"(C2.tid)); C2.lane = C2.tid & 63; C2.wave = __builtin_amdgcn_readfirstlane(C2.tid >> 6); const Ctx& C = C2;
        if (it < 64) rwkv_chunk_item(C, it >> 3, (it >> 1) & 3, it & 1);
        else if (it < 128) { const int r = it - 64; retention_item(C, l, r >> 3, (r >> 1) & 3, r & 1); }
        else if (it >= 128 + n_att) wconv_range(C, l, (it - 128 - n_att) * 8, 8);
        else {
            int a = it - 128; int b, h, q0, seq;
            if (a < 1024) { b = a >> 7; h = (a >> 4) & 7; q0 = CTXL + (a & 15) * 256; seq = SB; }
            else { a -= 1024; b = a >> 3; h = a & 7; q0 = 0; seq = CTXL; }
            const size_t tb = (size_t)b * SB;
            att::attn_body(C.qkv() + (tb + q0) * QKVC + h * 96, C.kf() + tb * 768 + h * 96, C.qkv() + tb * QKVC + 768 + h * 128 + 64,
                           C.pbuf() + (tb + q0) * NPC + h * 64, seq, (LAS char*)C.lds, C.tid, negM);
        }
    }
}

struct FinTok { u32x2 of, ob, gg, yf, yb, vv, gt; float bon; };
DI void fin_load(const Ctx& C, int tok, int lane, FinTok& R) {
    const int c4 = lane * 4; const bf16_t* pr = C.pbuf() + (size_t)tok * NPC; const bf16_t* ar = C.act() + (size_t)tok * DM;
    R.of = *(const u32x2*)(pr + C_OF + c4); R.ob = *(const u32x2*)(pr + C_OB + c4); R.gg = *(const u32x2*)(pr + C_RG + c4);
    R.yf = *(const u32x2*)(pr + C_YF + c4); R.yb = *(const u32x2*)(pr + C_YB + c4);
    R.vv = *(const u32x2*)(ar + 512 + c4); R.gt = *(const u32x2*)(C.ops(3) + (size_t)tok * 256 + c4);
    R.bon = C.bonus()[(size_t)tok * 4 + (lane >> 4)];
}
DI void fin_store(const Ctx& C, int tok, int lane, const FinTok& R, const f32x4 gnw, const f32x4 lnw) {
    const int c4 = lane * 4;
    const u32x2 of = R.of, ob = R.ob, gg = R.gg, yf = R.yf, yb = R.yb, vv = R.vv, gt = R.gt; const float bon = R.bon;
    f32x4 o = {lo_f(of.x) + lo_f(ob.x), hi_f(of.x) + hi_f(ob.x), lo_f(of.y) + lo_f(ob.y), hi_f(of.y) + hi_f(ob.y)};
    float mu = row16_sum(o[0] + o[1] + o[2] + o[3]) * (1.f / 64.f);
    f32x4 d = o - mu; float var = row16_sum(d[0] * d[0] + d[1] * d[1] + d[2] * d[2] + d[3] * d[3]) * (1.f / 64.f);
    float eps1 = 1e-5f, eps2 = 64e-5f; asm volatile("" : "+v"(eps1), "+v"(eps2));
    float rs = rsqrtf(var + eps1);
    const f32x4 g = {lo_f(gg.x), hi_f(gg.x), lo_f(gg.y), hi_f(gg.y)};
    f32x4 r1; r1[0] = d[0] * rs * gnw[0] * siluf_(g[0]); r1[1] = d[1] * rs * gnw[1] * siluf_(g[1]); r1[2] = d[2] * rs * gnw[2] * siluf_(g[2]); r1[3] = d[3] * rs * gnw[3] * siluf_(g[3]);
    f32x4 y = {lo_f(yf.x) + lo_f(yb.x), hi_f(yf.x) + hi_f(yb.x), lo_f(yf.y) + lo_f(yb.y), hi_f(yf.y) + hi_f(yb.y)};
    mu = row16_sum(y[0] + y[1] + y[2] + y[3]) * (1.f / 64.f);
    d = y - mu; var = row16_sum(d[0] * d[0] + d[1] * d[1] + d[2] * d[2] + d[3] * d[3]) * (1.f / 64.f);
    rs = rsqrtf(var + eps2);
    const f32x4 v = {lo_f(vv.x), hi_f(vv.x), lo_f(vv.y), hi_f(vv.y)}, gate = {lo_f(gt.x), hi_f(gt.x), lo_f(gt.y), hi_f(gt.y)};
    const f32x4 r2 = (d * rs * lnw + v * bon) * gate;
    bf16_t* pw = C.pbuf() + (size_t)tok * NPC;
    u32x2 w; w.x = pk2(r1[0], r1[1]); w.y = pk2(r1[2], r1[3]); *(u32x2*)(pw + 512 + c4) = w;
    w.x = pk2(r2[0], r2[1]); w.y = pk2(r2[2], r2[3]); *(u32x2*)(pw + 768 + c4) = w;
}
DI void phase_finish(const Ctx& C, int l) {
    const int gw = C.bid * 8 + C.wave, GW = C.G * 8, lane = C.lane, c4 = lane * 4;
    const f32x4 gnw = *(const f32x4*)(C.in[16] + l * 256 + c4), lnw = *(const f32x4*)(C.in[26] + l * 256 + c4);
    const int NT_ = (l == 1) ? NBATCH * SEQ : T;
#define FN_TOK(i_) (((l == 1) ? ((i_) / SEQ) * SB + CTXL + ((i_) % SEQ) : (i_)))
    FinTok A, B, NA, NB;
    if (gw < NT_) { fin_load(C, FN_TOK(gw), lane, A); const int i2 = gw + GW; fin_load(C, FN_TOK(i2 < NT_ ? i2 : gw), lane, B); }
    for (int i = gw; i < NT_; i += 2 * GW) {
        const int i2 = i + GW; const bool has2 = i2 < NT_; const int j = i + 2 * GW; const bool hasn = j < NT_;
        if (hasn) { fin_load(C, FN_TOK(j), lane, NA); const int j2 = j + GW; fin_load(C, FN_TOK(j2 < NT_ ? j2 : j), lane, NB); }
        fin_store(C, FN_TOK(i), lane, A, gnw, lnw);
        if (has2) fin_store(C, FN_TOK(i2), lane, B, gnw, lnw);
        if (hasn) { A = NA; B = NB; }
    }
#undef FN_TOK
}

DI float wave_sum2(float v) { v = row16_sum(v); v += __shfl_xor(v, 16); v += __shfl_xor(v, 32); return v; }
DI float row16_max(float x) { x = fmaxf(x, dpp_mov<0xB1>(x)); x = fmaxf(x, dpp_mov<0x4E>(x)); x = fmaxf(x, dpp_mov<0x141>(x)); x = fmaxf(x, dpp_mov<0x140>(x)); return x; }
DI void router_token(const Ctx& C, int l, int tok, int lane, const float (&v)[16], const LAS float* rw, const float* nw) {
    const int b = tok / SB, s = tok - b * SB; const float* modrow = C.modv(l) + (size_t)((s < CTXL) ? 8 : b) * 6144;
    float ss = 0.f;
#pragma unroll
    for (int m = 0; m < 16; ++m) ss += v[m] * v[m];
    ss = wave_sum2(ss); const float rstd = rsqrtf(ss * (1.f / 1024.f) + 1e-6f);
    float lg[16];
#pragma unroll
    for (int e = 0; e < 16; ++e) lg[e] = 0.f;
    bf16_t* dst = C.act() + (size_t)tok * DM;
#pragma unroll
    for (int m = 0; m < 16; ++m) { const int c = m * 64 + lane;
        const float hv = v[m] * rstd * nw[c] * (modrow[4096 + c] + 1.f) + modrow[3072 + c];
        dst[c] = f2bf(hv);
        const LAS float* rr = rw + c * 20;
        const f32x4 r0 = *(const LAS f32x4*)rr, r1 = *(const LAS f32x4*)(rr + 4), r2 = *(const LAS f32x4*)(rr + 8), r3 = *(const LAS f32x4*)(rr + 12);
        lg[0] += hv * r0[0]; lg[1] += hv * r0[1]; lg[2] += hv * r0[2]; lg[3] += hv * r0[3];
        lg[4] += hv * r1[0]; lg[5] += hv * r1[1]; lg[6] += hv * r1[2]; lg[7] += hv * r1[3];
        lg[8] += hv * r2[0]; lg[9] += hv * r2[1]; lg[10] += hv * r2[2]; lg[11] += hv * r2[3];
        lg[12] += hv * r3[0]; lg[13] += hv * r3[1]; lg[14] += hv * r3[2]; lg[15] += hv * r3[3]; }
    float sel = 0.f; const int li = lane & 15;
#pragma unroll
    for (int e = 0; e < 16; ++e) { const float r = row16_sum(lg[e]); sel = (li == e) ? r : sel; }
    sel += __shfl_xor(sel, 16); sel += __shfl_xor(sel, 32);
    const float mx = row16_max(sel); const float ex = __expf(sel - mx); const float den = row16_sum(ex);
    if (lane < 16) { const float a = ex / den;
        if (s < CTXL) ((float*)(C.ws + OFF_AFFC))[(size_t)(b * 16 + lane) * CTXL + s] = a;
        else ((float*)(C.ws + OFF_AFFL))[(size_t)(b * 16 + lane) * SEQ + (s - CTXL)] = a; }
}
DI void phase_h_router(const Ctx& C, int l, const float* lat, const float* ctxp) {
    LAS float* rw = (LAS float*)C.lds;
    { const float* src = C.in[28] + (size_t)l * 16384; for (int i = C.tid; i < 4096; i += NTHR) *(LAS f32x4*)(rw + (i >> 2) * 20 + (i & 3) * 4) = *(const f32x4*)(src + i * 4); }
    __syncthreads();
    const int gw = C.bid * 8 + C.wave, GW = C.G * 8, lane = C.lane;
    const float* nw = C.in[7] + l * 1024;
    const int NT_ = (l == 1) ? NBATCH * SEQ : T;
#define RT_TOK(i_) (((l == 1) ? ((i_) / SEQ) * SB + CTXL + ((i_) % SEQ) : (i_)))
    float va[16], vb[16];
    if (gw < NT_) { const int tokA = RT_TOK(gw); const int i2 = gw + GW; const int tokB = (i2 < NT_) ? RT_TOK(i2) : tokA;
        const float* xa = tok_row(lat, ctxp, tokA); const float* xb = tok_row(lat, ctxp, tokB);
#pragma unroll
        for (int m = 0; m < 16; ++m) { va[m] = xa[m * 64 + lane]; vb[m] = xb[m * 64 + lane]; } }
    for (int i = gw; i < NT_; i += 2 * GW) {
        const int i2 = i + GW; const bool has2 = i2 < NT_;
        const int tokA = RT_TOK(i); const int tokB = has2 ? RT_TOK(i2) : tokA;
        float na[16], nb[16]; const int j = i + 2 * GW; const bool hasn = j < NT_;
        if (hasn) { const int tA = RT_TOK(j); const int j2 = j + GW; const int tB = (j2 < NT_) ? RT_TOK(j2) : tA;
            const float* xa = tok_row(lat, ctxp, tA); const float* xb = tok_row(lat, ctxp, tB);
#pragma unroll
            for (int m = 0; m < 16; ++m) { na[m] = xa[m * 64 + lane]; nb[m] = xb[m * 64 + lane]; } }
        router_token(C, l, tokA, lane, va, rw, nw);
        if (has2) router_token(C, l, tokB, lane, vb, rw, nw);
        if (hasn) {
#pragma unroll
            for (int m = 0; m < 16; ++m) { va[m] = na[m]; vb[m] = nb[m]; } }
    }
#undef RT_TOK
}

DI void select_item(const Ctx& C, const float* aff, int n, int cap, int rowbase, int tokbase, int* inv  ) {
    LAS unsigned* keys = (LAS unsigned*)C.lds;
    LAS int* cnt = (LAS int*)(C.lds + 16384);
    LAS int* wsum = cnt + 64;
    const int tid = C.tid; const int m = (n + NTHR - 1) / NTHR;
    for (int i = tid; i < n; i += NTHR) keys[i] = __float_as_uint(aff[i]);
    __syncthreads();
    unsigned prefix = 0u; int krem = cap;
    LAS int* hist = cnt + 128;
    LAS int* selw = cnt + 96;
#pragma unroll 1
    for (int pass = 0; pass < 4; ++pass) { const int shift = 24 - 8 * pass;
        if (tid < 256) hist[tid] = 0;
        __syncthreads();
        for (int i = tid; i < n; i += NTHR) { const unsigned k = keys[i];
            if (pass == 0 || (k >> (shift + 8)) == (prefix >> (shift + 8))) __hip_atomic_fetch_add(&hist[(k >> shift) & 255u], 1, __ATOMIC_RELAXED, __HIP_MEMORY_SCOPE_WORKGROUP); }
        __syncthreads();
        if (C.wave == 0) { const int l4 = C.lane * 4; const int h0 = hist[l4], h1 = hist[l4 + 1], h2 = hist[l4 + 2], h3 = hist[l4 + 3]; const int s4 = h0 + h1 + h2 + h3;
            int incl = s4;
            for (int o = 1; o < 64; o <<= 1) { const int v = __shfl_down(incl, o); if (C.lane + o < 64) incl += v; }
            const int above = incl - s4;
            if (above < krem && incl >= krem) { int d = 3, a = above;
                if (a + h3 >= krem) d = 3; else { a += h3; if (a + h2 >= krem) d = 2; else { a += h2; if (a + h1 >= krem) d = 1; else { a += h1; d = 0; } } }
                selw[0] = l4 + d; selw[1] = krem - a; } }
        __syncthreads();
        prefix |= (unsigned)selw[0] << shift; krem = selw[1];
        __syncthreads();
    }
    const unsigned thr = prefix;
    int gtc = 0, eqc = 0;
    for (int q = 0; q < m; ++q) { const int i = tid * m + q; if (i < n) { const unsigned k = keys[i]; gtc += (k > thr); eqc += (k == thr); } }
    int g = gtc, e = eqc;
    for (int o = 1; o < 64; o <<= 1) { const int g2 = __shfl_up(g, o), e2 = __shfl_up(e, o); if (C.lane >= o) { g += g2; e += e2; } }
    if (C.lane == 63) { wsum[C.wave] = g; wsum[8 + C.wave] = e; }
    __syncthreads();
    int gb = 0, eb = 0, gtot = 0;
    for (int w = 0; w < 8; ++w) { if (w < C.wave) { gb += wsum[w]; eb += wsum[8 + w]; } gtot += wsum[w]; }
    int gpre = gb + g - gtc, epre = eb + e - eqc;
    const int need_eq = cap - gtot;
    int* idx = (int*)(C.ws + OFF_IDX); float* gate = (float*)(C.ws + OFF_GATE);
    for (int q = 0; q < m; ++q) { const int i = tid * m + q; if (i < n) { const unsigned k = keys[i];
        const bool sel = (k > thr) || (k == thr && epre < need_eq);
        const int sl = gpre + (epre < need_eq ? epre : need_eq);
        if (sel) { idx[rowbase + sl] = tokbase + i; gate[rowbase + sl] = __uint_as_float(k); }
        inv[(size_t)i * 16] = sel ? (rowbase + sl) : -1;
        gpre += (k > thr); epre += (k == thr); } }
    asm volatile("s_waitcnt vmcnt(0)" ::: "memory");
    __syncthreads();
    __syncthreads();
}
DI void phase_select(const Ctx& C, int l) {
    const int nitems = (l == 0) ? 256 : 128;
    for (int it = C.bid; it < nitems; it += C.G) {
        if (it < 128) { const int b = it >> 4, e = it & 15;
            select_item(C, (const float*)(C.ws + OFF_AFFL) + (size_t)(b * 16 + e) * SEQ, SEQ, CAPL, e * 4096 + b * 512, b * SB + CTXL, (int*)(C.ws + OFF_INVL) + (size_t)b * SEQ * 16 + e); }
        else { const int a = it - 128, b = a >> 4, e = a & 15;
            select_item(C, (const float*)(C.ws + OFF_AFFC) + (size_t)(b * 16 + e) * CTXL, CTXL, CAPC, XE_LROWS + e * 256 + b * 32, b * SB, (int*)(C.ws + OFF_INVC) + (size_t)b * CTXL * 16 + e); }
    }
#ifdef DIAG_TS
    if (l == 0 && C.bid == DIAG_BLK && C.tid == 0) ((unsigned long long*)(C.ws + OFF_CNT + 4096))[40] = __builtin_amdgcn_s_memrealtime();
#endif
    { Ctx C2 = C; asm volatile("" : "+v"(C2.tid)); C2.lane = C2.tid & 63; C2.wave = __builtin_amdgcn_readfirstlane(C2.tid >> 6); phase_wconv_experts(C2, l); }
}

struct CombTok { f32x4 x[4]; u32x2 y[4][4]; int myinv; int r[4]; unsigned long long rest; };
DI const int* comb_inv_ptr(const Ctx& C, int tok) { const int b = tok / SB, s = tok - b * SB;
    return (s < CTXL) ? (const int*)(C.ws + OFF_INVC) + (size_t)(b * CTXL + s) * 16 : (const int*)(C.ws + OFF_INVL) + (size_t)(b * SEQ + s - CTXL) * 16; }
DI void comb_issue_ye(const Ctx& C, int lane, CombTok& R) {
    const bf16_t* ye = (const bf16_t*)(C.ws + OFF_ARENA + AR_XE);
    unsigned long long msk = __ballot(R.myinv >= 0) & 0xffffull;
#pragma unroll
    for (int k = 0; k < 4; ++k) { R.r[k] = -1; if (msk) { const int e = __builtin_ctzll(msk); msk &= msk - 1; R.r[k] = __builtin_amdgcn_readlane(R.myinv, e); } }
    R.rest = msk;
#pragma unroll
    for (int k = 0; k < 4; ++k) if (R.r[k] >= 0) { const bf16_t* yr = ye + (size_t)R.r[k] * DM + lane * 4;
#pragma unroll
        for (int j = 0; j < 4; ++j) R.y[k][j] = *(const u32x2*)(yr + j * 256); }
}
DI void comb_finish(const Ctx& C, int l, int tok, int lane, float* lat, float* ctxp, const CombTok& R) {
    const bf16_t* ye = (const bf16_t*)(C.ws + OFF_ARENA + AR_XE);
    const int b = tok / SB, s = tok - b * SB;
    float* xr = (s < CTXL) ? ctxp + (size_t)(b * CTXL + s) * DM : lat + (size_t)(b * SEQ + s - CTXL) * DM;
    const float* modrow = C.modv(l) + (size_t)((s < CTXL) ? 8 : b) * 6144;
    f32x4 acc[4];
#pragma unroll
    for (int j = 0; j < 4; ++j) acc[j] = (f32x4){0.f, 0.f, 0.f, 0.f};
#pragma unroll
    for (int k = 0; k < 4; ++k) if (R.r[k] >= 0) {
#pragma unroll
        for (int j = 0; j < 4; ++j) { const u32x2 w = R.y[k][j]; acc[j][0] += lo_f(w.x); acc[j][1] += hi_f(w.x); acc[j][2] += lo_f(w.y); acc[j][3] += hi_f(w.y); } }
    unsigned long long msk = R.rest;
    while (msk) { const int e = __builtin_ctzll(msk); msk &= msk - 1; const int r = __builtin_amdgcn_readlane(R.myinv, e); const bf16_t* yr = ye + (size_t)r * DM + lane * 4;
#pragma unroll
        for (int j = 0; j < 4; ++j) { const u32x2 w = *(const u32x2*)(yr + j * 256); acc[j][0] += lo_f(w.x); acc[j][1] += hi_f(w.x); acc[j][2] += lo_f(w.y); acc[j][3] += hi_f(w.y); } }
    f32x4 v[4];
#pragma unroll
    for (int j = 0; j < 4; ++j) { const int c = j * 256 + lane * 4; const f32x4 ga = *(const f32x4*)(modrow + 5120 + c);
        v[j] = R.x[j] + ga * acc[j]; *(f32x4*)(xr + c) = v[j]; }
    if (l == 0) norm_mod_store(v, C.in[6] + 1024, C.modv(1) + (size_t)((s < CTXL) ? 8 : b) * 6144, 0, 1024, C.act() + (size_t)tok * DM, lane);
}
DI void phase_combine(const Ctx& C, int l, float* lat, float* ctxp) {
    const int gw = C.bid * 8 + C.wave, GW = C.G * 8, lane = C.lane;
    const int NT_ = (l == 1) ? NBATCH * SEQ : T;
#define CB_TOK(i_) (((l == 1) ? ((i_) / SEQ) * SB + CTXL + ((i_) % SEQ) : (i_)))
#define CB_LOAD(A_, B_, i_) do { const int tA_ = CB_TOK(i_); const int i2_ = (i_) + GW; const int tB_ = (i2_ < NT_) ? CB_TOK(i2_) : tA_; \
        A_.myinv = comb_inv_ptr(C, tA_)[lane & 15]; B_.myinv = comb_inv_ptr(C, tB_)[lane & 15]; \
        const float* xa_ = tok_row(lat, ctxp, tA_); const float* xb_ = tok_row(lat, ctxp, tB_); \
        _Pragma("unroll") for (int j_ = 0; j_ < 4; ++j_) { A_.x[j_] = *(const f32x4*)(xa_ + j_ * 256 + lane * 4); B_.x[j_] = *(const f32x4*)(xb_ + j_ * 256 + lane * 4); } } while (0)
    CombTok A, B;
    if (gw < NT_) CB_LOAD(A, B, gw);
    for (int i = gw; i < NT_; i += 2 * GW) {
        const int i2 = i + GW; const bool has2 = i2 < NT_;
        const int tokA = CB_TOK(i); const int tokB = has2 ? CB_TOK(i2) : tokA;
        comb_issue_ye(C, lane, A); comb_issue_ye(C, lane, B);
        int nIa = 0, nIb = 0; f32x4 nxa[4], nxb[4]; const int j = i + 2 * GW; const bool hasn = j < NT_;
        if (hasn) { const int tA_ = CB_TOK(j); const int j2 = j + GW; const int tB_ = (j2 < NT_) ? CB_TOK(j2) : tA_;
            nIa = comb_inv_ptr(C, tA_)[lane & 15]; nIb = comb_inv_ptr(C, tB_)[lane & 15];
            const float* xa_ = tok_row(lat, ctxp, tA_); const float* xb_ = tok_row(lat, ctxp, tB_);
#pragma unroll
            for (int q = 0; q < 4; ++q) { nxa[q] = *(const f32x4*)(xa_ + q * 256 + lane * 4); nxb[q] = *(const f32x4*)(xb_ + q * 256 + lane * 4); } }
        comb_finish(C, l, tokA, lane, lat, ctxp, A);
        if (has2) comb_finish(C, l, tokB, lane, lat, ctxp, B);
        if (hasn) { A.myinv = nIa; B.myinv = nIb;
#pragma unroll
            for (int q = 0; q < 4; ++q) { A.x[q] = nxa[q]; B.x[q] = nxb[q]; } }
    }
#undef CB_TOK
#undef CB_LOAD
}

#ifdef DIAG
DI void diag_scan(const Ctx& C, int code, const void* ptr, size_t bytes, bool isbf) {
    const u32x4* p = (const u32x4*)ptr; const size_t n = bytes / 16; bool bad = false;
    for (size_t i = (size_t)C.bid * NTHR + C.tid; i < n; i += (size_t)C.G * NTHR) { const u32x4 v = p[i];
#pragma unroll
        for (int q = 0; q < 4; ++q) { const unsigned w = v[q];
            if (isbf) { const unsigned a = w & 0x7fffu, b = (w >> 16) & 0x7fffu; bad |= (a >= 0x5000u) || (b >= 0x5000u); }
            else bad |= ((w & 0x7fffffffu) >= 0x50000000u); } }
    if (__any(bad) && C.lane == 0) atomicAdd((int*)(C.ws + OFF_CNT) + 64 + code, 1);
}
DI void diag_maxexp(const Ctx& C, int code, const void* ptr, size_t bytes) {
    const u32x4* p = (const u32x4*)ptr; const size_t n = bytes / 16; unsigned mx = 0; int nb = 0;
    for (size_t i = (size_t)C.bid * NTHR + C.tid; i < n; i += (size_t)C.G * NTHR) { const u32x4 v = p[i]; unsigned m = 0;
#pragma unroll
        for (int q = 0; q < 4; ++q) { const unsigned w = v[q]; const unsigned a = (w >> 7) & 0xffu, b = (w >> 23) & 0xffu; m = m > a ? m : a; m = m > b ? m : b; }
        mx = mx > m ? mx : m; nb += (m >= 160u); }
    atomicMax((int*)(C.ws + OFF_CNT) + 64 + code, (int)mx); if (nb) atomicAdd((int*)(C.ws + OFF_CNT) + 64 + code + 1, nb);
}
DI void diag_out(const Ctx& C) {
    const int* cnts = (const int*)(C.ws + OFF_CNT) + 64; int first = -1;
    for (int i = 0; i < 40; ++i) { const int v = __hip_atomic_load(cnts + i, __ATOMIC_RELAXED, __HIP_MEMORY_SCOPE_AGENT); if (v != 0 && first < 0) first = i; }
#ifdef DIAG_VAL
    const float K = 1000.f * (1.f + (float)__hip_atomic_load(cnts + DIAG_VAL, __ATOMIC_RELAXED, __HIP_MEMORY_SCOPE_AGENT));
#elif defined(DIAG_SEL)
    int mask = 0; for (int i = 0; i < 4; ++i) if (__hip_atomic_load(cnts + DIAG_SEL + i, __ATOMIC_RELAXED, __HIP_MEMORY_SCOPE_AGENT) != 0) mask |= 1 << i;
    const float K = 1000.f * (float)(1 + mask);
#else
    const float K = (first < 0) ? 1000.f : 1000.f * exp2f((float)(first + 1));
#endif
    const size_t n = (size_t)NBATCH * SEQ * DM / 4;
    for (size_t i = (size_t)C.bid * NTHR + C.tid; i < n; i += (size_t)C.G * NTHR) { const f32x4 v = ((const f32x4*)C.in[0])[i]; ((f32x4*)C.out)[i] = v * K; }
}
#define DSCAN(code, ptr, bytes, isbf) diag_scan(C, code, ptr, bytes, isbf)
#else
#define DSCAN(code, ptr, bytes, isbf) do {} while (0)
#endif

#ifdef PHASE_TEST
#define MKCTX() extern __shared__ __attribute__((aligned(16))) unsigned char smem[]; Ctx C; C.in = prm.in; C.out = prm.out; C.ws = prm.ws; C.G = gridDim.x; C.bid = blockIdx.x; C.tid = threadIdx.x; \
    C.wave = __builtin_amdgcn_readfirstlane(threadIdx.x >> 6); C.lane = threadIdx.x & 63; C.lds = (LAS unsigned char*)smem;
__global__ void __launch_bounds__(NTHR, 2) t_mod(Params prm) { MKCTX(); phase_mod(C); }
__global__ void __launch_bounds__(NTHR, 2) t_wconv(Params prm) { MKCTX(); phase_wconv_small(C); phase_wconv_experts(C, 1); }
__global__ void __launch_bounds__(NTHR, 2) t_u(Params prm) { MKCTX(); phase_u(C, 0, C.in[0], C.in[2]); }
__global__ void __launch_bounds__(NTHR, 2) t_gemm_bf(Params prm) { MKCTX(); pg8::Gemm g{C.act(), C.wsm(0, WSM_WIN), DM, DM, DM, nullptr}; pg8::Sched S; S.init(T / 256, NPC / 256, C.G, C.bid, 0); pg8::EpiBf16 E{C.pbuf(), NPC}; pg8::gemm_phase(C.lds, g, S, E, C.tid); }
__global__ void __launch_bounds__(NTHR, 2) t_gemm_res(Params prm) { MKCTX(); pg8::Gemm g{C.act(), C.wsm(0, WSM_WOUT), DM, DM, DM, nullptr}; pg8::Sched S; S.init(128, 4, C.G, C.bid, 1); pg8::EpiResid E{C.in[0], C.in[2], C.out, C.xc(), C.modv(0)}; pg8::gemm_phase(C.lds, g, S, E, C.tid); }
__global__ void __launch_bounds__(NTHR, 2) t_gemm_sw(Params prm) { MKCTX(); pg8::Gemm g{C.act(), C.wsm(0, WSM_WOUT), DM, DM, DM, nullptr}; pg8::Sched S; S.init(272, 8, C.G, C.bid, 2); pg8::EpiSwiglu E{C.pbuf(), DM}; pg8::gemm_phase(C.lds, g, S, E, C.tid); }
__global__ void __launch_bounds__(NTHR, 2) t_gemm_gate(Params prm) { MKCTX(); pg8::Gemm g{C.act(), C.wsm(0, WSM_WOUT), DM, DM, DM, nullptr}; pg8::Sched S; S.init(272, 4, C.G, C.bid, 2); pg8::EpiGate E{C.pbuf(), DM, (const float*)(C.ws + OFF_GATE)}; pg8::gemm_phase(C.lds, g, S, E, C.tid); }
__global__ void __launch_bounds__(NTHR, 2) t_rwkv_prep(Params prm) { MKCTX(); phase_rwkv_prep(C, 0); }
__global__ void __launch_bounds__(NTHR, 2) t_ret_prep(Params prm) { MKCTX(); phase_ret_prep(C); }
__global__ void __launch_bounds__(NTHR, 2) t_qk(Params prm) { MKCTX(); phase_qk_final(C, 0); }
__global__ void __launch_bounds__(NTHR, 2) t_attn(Params prm) { MKCTX(); att::attn_body(C.qkv(), C.kf(), C.qkv(), C.pbuf(), SB, (LAS char*)C.lds, C.tid, -16.f); }
__global__ void __launch_bounds__(NTHR, 2) t_rwkv(Params prm) { MKCTX(); rwkv_scan_item(C, 0, 1, C.bid & 1, 0); }
__global__ void __launch_bounds__(NTHR, 2) t_rwkvc(Params prm) { MKCTX(); rwkv_chunk_item(C, 0, 1, C.bid & 1); }
__global__ void __launch_bounds__(NTHR, 2) t_ret(Params prm) { MKCTX(); retention_item(C, 0, 0, 1, C.bid & 1); }
__global__ void __launch_bounds__(NTHR, 2) t_finish(Params prm) { MKCTX(); phase_finish(C, 0); }
__global__ void __launch_bounds__(NTHR, 2) t_router(Params prm) { MKCTX(); phase_h_router(C, 0, C.out, C.xc()); }
__global__ void __launch_bounds__(NTHR, 2) t_select(Params prm) { MKCTX(); phase_select(C, 0); }
__global__ void __launch_bounds__(NTHR, 2) t_combine(Params prm) { MKCTX(); phase_combine(C, 0, C.out, C.xc()); }
#endif

__global__ void __launch_bounds__(NTHR, 2) hybrid_fwd(Params prm) {
    extern __shared__ __attribute__((aligned(16))) unsigned char smem[];
    cg::grid_group grid = cg::this_grid();
    Ctx C; C.in = prm.in; C.out = prm.out; C.ws = prm.ws; C.G = gridDim.x; C.bid = blockIdx.x; C.tid = threadIdx.x;
    C.wave = __builtin_amdgcn_readfirstlane(threadIdx.x >> 6); C.lane = threadIdx.x & 63; C.lds = (LAS unsigned char*)smem;
#define CG_SYNC() do { asm volatile("s_waitcnt vmcnt(0) lgkmcnt(0)" ::: "memory"); __syncthreads(); grid.sync(); asm volatile("s_waitcnt vmcnt(0)" ::: "memory"); __syncthreads(); PH(); } while (0)
#ifdef DIAG_TS
#define TSTAMP() do { if (blockIdx.x == 0 && threadIdx.x == 0) { ((unsigned long long*)(C.ws + OFF_CNT + 4096))[ts_n] = __builtin_amdgcn_s_memrealtime(); } ++ts_n; } while (0)
#else
#define TSTAMP() do {} while (0)
#endif
#define GRID_SYNC() do { XcdBarrier xb_; xb_.bar = (unsigned*)(C.ws + OFF_BAR); xb_.x = xb_xcc_id(); xb_.st = (volatile LAS unsigned*)(smem + LDS_BYTES - 32); xcd_barrier(xb_); TSTAMP(); PH(); } while (0)
#define PH() do { asm volatile("" : "+v"(C.tid)); C.lane = C.tid & 63; C.wave = __builtin_amdgcn_readfirstlane(C.tid >> 6); } while (0)
    { volatile LAS unsigned* st = (volatile LAS unsigned*)(smem + LDS_BYTES - 32); if (threadIdx.x == 0) { st[0] = 0u; st[1] = 0u; } __syncthreads(); }
    (void)xcd_barrier_post((unsigned*)(C.ws + OFF_BAR), (volatile LAS unsigned*)(smem + LDS_BYTES - 32));
    int ts_n = 0; TSTAMP();
#ifdef DIAG_TS
    if (C.tid == 0) atomicMax(((unsigned long long*)(C.ws + OFF_CNT + 4096)) + 54, (unsigned long long)__builtin_amdgcn_s_memrealtime());
#endif
    PH();
    phase_p0(C);
#ifdef DIAG_TS
    if (C.bid == DIAG_BLK && C.tid == 0) ((unsigned long long*)(C.ws + OFF_CNT + 4096))[50] = __builtin_amdgcn_s_memrealtime();
#endif
    PH();
    phase_rope_tables(C);
#ifdef DIAG_TS
    if (C.bid == DIAG_BLK && C.tid == 0) ((unsigned long long*)(C.ws + OFF_CNT + 4096))[51] = __builtin_amdgcn_s_memrealtime();
#endif
    if (prm.pad != 0) { CG_SYNC(); }
    GRID_SYNC();
    DSCAN(0, C.ws + OFF_MOD, 2 * 9 * 6144 * 4, false); DSCAN(1, C.ws + OFF_WSM, 2 * WSM_STRIDE, true);
#pragma unroll 1
    for (int l = 0; l < 2; ++l) {
#define xl_in ((l == 0) ? C.in[0] : C.out)
#define xc_in ((l == 0) ? C.in[2] : C.xc())
        if (l == 0) { phase_u(C, 0, xl_in, xc_in); GRID_SYNC(); }
        DSCAN(2 + l * 16 + 0, C.act(), (size_t)T * DM * 2, true);
        { pg8::Gemm g{C.act(), C.wsm(l, WSM_WIN), DM, DM, DM, nullptr}; pg8::Sched S; S.init(T / 256, NPC / 256, C.G, C.bid, 0);
          pg8::EpiBf16 E{C.pbuf(), NPC}; pg8::gemm_phase(C.lds, g, S, E, C.tid); }
        GRID_SYNC();
        DSCAN(2 + l * 16 + 1, C.pbuf(), (size_t)T * NPC * 2, true);
        { pg8::Gemm g{C.pbuf(), C.wsm(l, WSM_WQKV), NPC, 640, 384, nullptr}; pg8::Sched S; S.init(T / 256, 3, C.G, C.bid, 0);
          pg8::EpiBf16 E{C.qkv(), QKVC}; pg8::gemm_phase(C.lds, g, S, E, C.tid); }
        PH();
        { pg8::Gemm g{C.pbuf() + 384, C.wsm(l, WSM_WQKV) + (size_t)768 * 640 + 384, NPC, 640, 256, nullptr}; pg8::Sched S; S.init(T / 256, 4, C.G, C.bid, 0);
          pg8::EpiBf16 E{C.qkv() + 768, QKVC}; pg8::gemm_phase(C.lds, g, S, E, C.tid); }
#ifdef DIAG_TS
        if (l == 0 && C.bid == DIAG_BLK && C.tid == 0) ((unsigned long long*)(C.ws + OFF_CNT + 4096))[41] = __builtin_amdgcn_s_memrealtime();
#endif
        PH();
        phase_rwkv_prep(C, l);
        GRID_SYNC();
        DSCAN(2 + l * 16 + 2, C.qkv(), (size_t)T * QKVC * 2, true); DSCAN(2 + l * 16 + 3, C.ops(0), 4 * OPS_STRIDE, true); if (l == 0) { DSCAN(40, C.ops(0), OPS_STRIDE, true); DSCAN(41, C.ops(1), OPS_STRIDE, true); DSCAN(42, C.ops(2), OPS_STRIDE, true); DSCAN(43, C.ops(3), OPS_STRIDE, true); } DSCAN(2 + l * 16 + 4, C.act(), (size_t)T * DM * 2, true);
        phase_qk_final(C, l);
        GRID_SYNC();
        DSCAN(2 + l * 16 + 5, C.qkv(), (size_t)T * QKVC * 2, true); DSCAN(2 + l * 16 + 6, C.kf(), (size_t)T * 768 * 2, true); DSCAN(2 + l * 16 + 7, C.pbuf(), (size_t)T * NPC * 2, true);
        phase_mixers(C, l);
        GRID_SYNC();
        if (l == 0) DSCAN(2 + l * 16 + 8, C.pbuf(), (size_t)T * NPC * 2, true);
        phase_finish(C, l);
        GRID_SYNC();
        if (l == 0) DSCAN(2 + l * 16 + 9, C.act(), (size_t)T * DM * 2, true);
        { pg8::Gemm g{C.pbuf(), C.wsm(l, WSM_WOUT), NPC, DM, DM, nullptr}; pg8::Sched S;
          if (l == 0) S.init(T / 256, 4, C.G, C.bid, 0); else S.init(128, 4, C.G, C.bid, 1);
          pg8::EpiResid E{xl_in, xc_in, C.out, C.xc(), C.modv(l)}; pg8::gemm_phase(C.lds, g, S, E, C.tid); }
        GRID_SYNC();
        DSCAN(2 + l * 16 + 10, C.out, (size_t)NBATCH * SEQ * DM * 4, false);
        phase_h_router(C, l, C.out, C.xc());
        GRID_SYNC();
        DSCAN(2 + l * 16 + 11, C.ws + OFF_AFFL, 2 * MiB, false);
        phase_select(C, l);
        GRID_SYNC();
        DSCAN(2 + l * 16 + 12, C.ws + OFF_ARENA + AR_WGU, 96 * MiB, true); DSCAN(2 + l * 16 + 13, C.ws + OFF_ARENA + AR_XE, (size_t)(l == 0 ? XE_ROWS : XE_LROWS) * DM * 2, true);
        { pg8::Gemm g{C.act(), (const bf16_t*)(C.ws + OFF_WGU2), DM, DM, DM, (const int*)(C.ws + OFF_IDX)}; pg8::Sched S;
          S.init(l == 0 ? 272 : 256, 8, C.G, C.bid, 2);
          pg8::EpiSwiglu E{(bf16_t*)(C.ws + OFF_ARENA + AR_HID), DM}; pg8::gemm_phase<pg8::EpiSwiglu, true, true, true>(C.lds, g, S, E, C.tid); }
        GRID_SYNC();
        DSCAN(2 + l * 16 + 14, C.ws + OFF_ARENA + AR_HID, (size_t)(l == 0 ? XE_ROWS : XE_LROWS) * DM * 2, true);
        { pg8::Gemm g{(const bf16_t*)(C.ws + OFF_ARENA + AR_HID), (const bf16_t*)(C.ws + OFF_ARENA + AR_WD), DM, DM, DM, nullptr}; pg8::Sched S;
          S.init(l == 0 ? 272 : 256, 4, C.G, C.bid, 2);
          pg8::EpiGate E{(bf16_t*)(C.ws + OFF_ARENA + AR_XE), DM, (const float*)(C.ws + OFF_GATE)}; pg8::gemm_phase(C.lds, g, S, E, C.tid); }
        GRID_SYNC();
        phase_combine(C, l, C.out, C.xc());
        if (l == 0) GRID_SYNC(); else { TSTAMP(); }
        DSCAN(2 + l * 16 + 15, C.out, (size_t)NBATCH * SEQ * DM * 4, false);
    }
#ifdef DIAG
    GRID_SYNC();
    diag_out(C);
#endif
#ifdef DIAG_TS
    if (blockIdx.x == 0 && threadIdx.x == 0) { const unsigned long long* ts = (const unsigned long long*)(C.ws + OFF_CNT + 4096);
        const float tot = (float)(ts[ts_n - 1] - ts[0]); const float part = (float)(ts[DIAG_TS_B] - ts[DIAG_TS_A]);
#ifndef DIAG_TS_SCALE
#define DIAG_TS_SCALE 1.f
#endif
        C.out[0] += 1.f + 29.f * fminf(1.f, DIAG_TS_SCALE * part / tot); }
#endif
}

extern "C" void kernel_launch(void* const* d_in, const int* in_sizes, int n_in, void* d_out, int out_size, void* d_ws, size_t ws_size, hipStream_t stream) {
    static int grid = 0;
    if (grid == 0) {
        int dev = 0, cus = 0, per_cu = 0;
        (void)hipGetDevice(&dev); (void)hipDeviceGetAttribute(&cus, hipDeviceAttributeMultiprocessorCount, dev);
        if (hipFuncSetAttribute((const void*)hybrid_fwd, hipFuncAttributeMaxDynamicSharedMemorySize, LDS_BYTES) != hipSuccess) { fprintf(stderr, "kernel_launch: hipFuncSetAttribute failed\n"); grid = -1; return; }
        if (hipOccupancyMaxActiveBlocksPerMultiprocessor(&per_cu, (const void*)hybrid_fwd, NTHR, LDS_BYTES) != hipSuccess || per_cu < 1) { fprintf(stderr, "kernel_launch: occupancy query gives %d\n", per_cu); grid = -1; return; }
        if (n_in != 32 || ws_size < WS_END) { fprintf(stderr, "kernel_launch: n_in %d ws %zu (need %zu)\n", n_in, ws_size, (size_t)WS_END); grid = -1; return; }
        grid = cus;
    }
    if (grid < 0) return;
    (void)hipMemsetAsync((char*)d_ws + OFF_BAR, 0, 65536, stream);
    Params p{}; for (int i = 0; i < 32; ++i) p.in[i] = (const float*)d_in[i];
    p.out = (float*)d_out; p.ws = (unsigned char*)d_ws; p.G = grid; p.pad = 0;
    void* args[] = {&p};
    hipError_t e = hipLaunchCooperativeKernel((const void*)hybrid_fwd, dim3(grid), dim3(NTHR), args, LDS_BYTES, stream);
    if (e != hipSuccess) fprintf(stderr, "cooperative launch failed: %s (grid %d)\n", hipGetErrorString(e), grid);
}
```

```cpp
#include <hip/hip_runtime.h>
#include <hip/hip_cooperative_groups.h>
#include <cstdio>
#include <cstdint>
namespace cg = cooperative_groups;

typedef unsigned short bf16_t;
typedef short bf16x8 __attribute__((ext_vector_type(8)));
typedef short s16x4 __attribute__((ext_vector_type(4)));
typedef float f32x4 __attribute__((ext_vector_type(4)));
typedef float f32x2 __attribute__((ext_vector_type(2)));
typedef float f32x16 __attribute__((ext_vector_type(16)));
typedef unsigned u32x4 __attribute__((ext_vector_type(4)));
typedef unsigned u32x2 __attribute__((ext_vector_type(2)));
#define LAS __attribute__((address_space(3)))
#define DI __device__ __forceinline__

constexpr int DM = 1024, NBATCH = 8, SEQ = 4096, CTXL = 256, SB = 4352, T = 34816;
constexpr int NPC = 2816;
constexpr int INC = 2784;
constexpr int QKVC = 1792;
constexpr int C_KR = 640, C_RQ = 672, C_RK = 928, C_RV = 1184, C_RG = 1440, C_RW = 1696;
constexpr int C_OF = 1696, C_OB = 1952, C_YF = 2208, C_YB = 2464;
constexpr int NE = 16, CAPL = 512, CAPC = 32;
constexpr int XE_LROWS = 65536, XE_ROWS = 65536 + 4096;
constexpr int NTHR = 512;
constexpr int LDS_BYTES = 160 * 1024;

constexpr size_t MiB = 1048576;
constexpr size_t OFF_BAR = 0, OFF_CNT = 32768, OFF_MOD = 1 * MiB, OFF_BONUS = 2 * MiB, OFF_AFFL = 3 * MiB, OFF_AFFC = 5 * MiB,
                 OFF_IDX = 6 * MiB, OFF_GATE = 6 * MiB + 512 * 1024, OFF_INVL = 7 * MiB, OFF_INVC = 9 * MiB, OFF_WSM = 10 * MiB,
                 OFF_XC = 31 * MiB, OFF_ACT = 39 * MiB, OFF_ARENA = 107 * MiB;
constexpr size_t WSM_STRIDE = 11010048, WSM_WIN = 0, WSM_WQKV = 5767168, WSM_WOUT = 8060928, WSM_W2F = 10158080, WSM_W2B = 10190848,
                 WSM_A2 = 10223616, WSM_G2 = 10256384;
constexpr size_t AR_P = 0, AR_QKV = 187 * MiB, AR_KF = 306 * MiB, AR_OPS = 357 * MiB, OPS_STRIDE = 17 * MiB;
constexpr size_t AR_WGU = 0, AR_WD = 64 * MiB, AR_XE = 96 * MiB, AR_HID = 232 * MiB;
constexpr size_t OFF_ROPE = OFF_ARENA + 425 * MiB;
constexpr size_t ROPE_AT = 4352 * 32 * 8;
constexpr size_t OFF_WGU2 = OFF_ROPE + 2 * MiB;
constexpr size_t WS_END = OFF_WGU2 + 64 * MiB;

struct Params { const float* in[32]; float* out; unsigned char* ws; int G; int pad; };

DI float bf2f(unsigned v) { return __uint_as_float(v << 16); }
DI bf16_t f2bf(float f) { return __builtin_bit_cast(bf16_t, (__bf16)f); }
typedef __bf16 bf16x2n __attribute__((ext_vector_type(2)));
DI unsigned pk2(float lo, float hi) { const f32x2 v = {lo, hi}; return __builtin_bit_cast(unsigned, __builtin_convertvector(v, bf16x2n)); }
DI float lo_f(unsigned w) { return __uint_as_float(w << 16); }
DI float hi_f(unsigned w) { return __uint_as_float(w & 0xffff0000u); }
DI float wave_sum(float v) { for (int o = 32; o >= 1; o >>= 1) v += __shfl_xor(v, o); return v; }
DI float dppf(float x, const int ctrl_sel) { return x; }
template <int CTRL> DI float dpp_mov(float x) { return __builtin_bit_cast(float, __builtin_amdgcn_update_dpp(0, __builtin_bit_cast(int, x), CTRL, 0xf, 0xf, true)); }
DI float row16_sum(float x) { x += dpp_mov<0xB1>(x); x += dpp_mov<0x4E>(x); x += dpp_mov<0x141>(x); x += dpp_mov<0x140>(x); return x; }
DI void row16_sum2(float& x, float& y) {
    asm("s_nop 1\n\t"
        "v_add_f32_dpp %0, %0, %0 quad_perm:[1,0,3,2] row_mask:0xf bank_mask:0xf bound_ctrl:1\n\t"
        "v_add_f32_dpp %1, %1, %1 quad_perm:[1,0,3,2] row_mask:0xf bank_mask:0xf bound_ctrl:1\n\t"
        "s_nop 0\n\t"
        "v_add_f32_dpp %0, %0, %0 quad_perm:[2,3,0,1] row_mask:0xf bank_mask:0xf bound_ctrl:1\n\t"
        "v_add_f32_dpp %1, %1, %1 quad_perm:[2,3,0,1] row_mask:0xf bank_mask:0xf bound_ctrl:1\n\t"
        "s_nop 0\n\t"
        "v_add_f32_dpp %0, %0, %0 row_half_mirror row_mask:0xf bank_mask:0xf bound_ctrl:1\n\t"
        "v_add_f32_dpp %1, %1, %1 row_half_mirror row_mask:0xf bank_mask:0xf bound_ctrl:1\n\t"
        "s_nop 0\n\t"
        "v_add_f32_dpp %0, %0, %0 row_mirror row_mask:0xf bank_mask:0xf bound_ctrl:1\n\t"
        "v_add_f32_dpp %1, %1, %1 row_mirror row_mask:0xf bank_mask:0xf bound_ctrl:1\n\t"
        "s_nop 0"
        : "+v"(x), "+v"(y));
}
DI float sigmoidf_(float x) { return __builtin_amdgcn_rcpf(1.f + __expf(-x)); }
DI float siluf_(float x) { return x * __builtin_amdgcn_rcpf(1.f + __expf(-x)); }
DI int tok_b(int tok) { return tok / SB; }

namespace pg8 {
constexpr int BM = 256, BK = 64, HALF = 128, HTB = HALF * BK * 2, STAGE_BYTES = 8 * HTB, NXCD = 8, WGM = 8;
DI int lds_byte(int r, int c) { const int st = (r >> 4) * 2 + (c >> 5), rr = r & 15, cc = c & 31, ob = rr * 64 + cc * 2; return st * 1024 + (ob ^ (((ob >> 9) & 1) << 5)); }
DI void stage_rc(int b, int& R, int& C) { const int st = b / 1024, sb = b % 1024, swz = sb ^ (((sb >> 9) & 1) << 5); R = (st >> 1) * 16 + swz / 64; C = (st & 1) * 32 + (swz % 64) / 2; }
DI int perm32(int rho) { const int n = rho >> 4, i = rho & 15; return 8 * (i >> 2) + 4 * n + (i & 3); }

struct Unit { int pm, pn, arow, brow; };
struct Gemm { const bf16_t* A; const bf16_t* Bt; int lda, ldb, K; const int* gidx; };

struct Sched {
    int nM, nN, nwg, G, c, mode;
    DI void init(int nM_, int nN_, int G_, int c_, int mode_) { nM = nM_; nN = nN_; nwg = nM * nN; G = G_; c = c_; mode = mode_; }
    DI bool next(int i, Unit& u) const {
        const long L = (long)i * G + c; if (L >= nwg) return false;
        int wgid = (int)L; { const int q = nwg / NXCD, r = nwg % NXCD, xcd = wgid % NXCD, off = wgid / NXCD; wgid = (xcd < r ? xcd * (q + 1) : r * (q + 1) + (xcd - r) * q) + off; }
        const int nig = WGM * nN, gid = wgid / nig, fm = gid * WGM, gsz = (nM - fm) < WGM ? (nM - fm) : WGM;
        int pm = fm + ((wgid % nig) % gsz); const int pn = (wgid % nig) / gsz;
        u.pn = pn;
        if (mode == 0) { u.pm = pm; u.arow = pm * 256; u.brow = pn * 256; }
        else if (mode == 1) { pm = pm + pm / 16 + 1; u.pm = pm; u.arow = pm * 256; u.brow = pn * 256; }
        else { const int e = pm < 256 ? (pm >> 4) : (pm - 256); u.pm = pm; u.arow = pm * 256; u.brow = e * (nN * 256) + pn * 256; }
        return true;
    }
};

struct EpiBf16 {
    static constexpr bool PERM = true;
    bf16_t* O; int ldc;
    DI void operator()(const f32x4 (&acc)[2][2][4][2], const Unit& u, int wr, int wc, int fr, int fq) const {
        const int row0 = u.pm * BM + wr * 64 + fr, col0 = u.pn * BM + wc * 32 + 8 * fq;
#pragma unroll
        for (int ai = 0; ai < 2; ++ai)
#pragma unroll
            for (int m = 0; m < 4; ++m) { bf16_t* rowp = O + (size_t)(row0 + ai * HALF + m * 16) * ldc + col0;
#pragma unroll
                for (int bj = 0; bj < 2; ++bj) { const f32x4 v0 = acc[ai][bj][m][0], v1 = acc[ai][bj][m][1];
                    u32x4 w; w.x = pk2(v0[0], v0[1]); w.y = pk2(v0[2], v0[3]); w.z = pk2(v1[0], v1[1]); w.w = pk2(v1[2], v1[3]);
                    *(u32x4*)(rowp + bj * HALF) = w; } }
    }
};
struct EpiGate {
    static constexpr bool PERM = true;
    bf16_t* O; int ldc; const float* gate;
    DI void operator()(const f32x4 (&acc)[2][2][4][2], const Unit& u, int wr, int wc, int fr, int fq) const {
        const int row0 = u.pm * BM + wr * 64 + fr, col0 = u.pn * BM + wc * 32 + 8 * fq;
#pragma unroll
        for (int ai = 0; ai < 2; ++ai)
#pragma unroll
            for (int m = 0; m < 4; ++m) { const int row = row0 + ai * HALF + m * 16; const float g = gate[row]; bf16_t* rowp = O + (size_t)row * ldc + col0;
#pragma unroll
                for (int bj = 0; bj < 2; ++bj) { const f32x4 v0 = acc[ai][bj][m][0] * g, v1 = acc[ai][bj][m][1] * g;
                    u32x4 w; w.x = pk2(v0[0], v0[1]); w.y = pk2(v0[2], v0[3]); w.z = pk2(v1[0], v1[1]); w.w = pk2(v1[2], v1[3]);
                    *(u32x4*)(rowp + bj * HALF) = w; } }
    }
};
struct EpiSwiglu {
    static constexpr bool PERM = true;
    bf16_t* O; int ldc;
    DI void operator()(const f32x4 (&acc)[2][2][4][2], const Unit& u, int wr, int wc, int fr, int fq) const {
        const int row0 = u.pm * BM + wr * 64 + fr, col0 = u.pn * 128 + wc * 16 + 4 * fq;
#pragma unroll
        for (int ai = 0; ai < 2; ++ai)
#pragma unroll
            for (int m = 0; m < 4; ++m) { bf16_t* rowp = O + (size_t)(row0 + ai * HALF + m * 16) * ldc + col0;
#pragma unroll
                for (int bj = 0; bj < 2; ++bj) { const f32x4 g = acc[ai][bj][m][0], up = acc[ai][bj][m][1];
                    u32x2 w; w.x = pk2(siluf_(g[0]) * up[0], siluf_(g[1]) * up[1]); w.y = pk2(siluf_(g[2]) * up[2], siluf_(g[3]) * up[3]);
                    *(u32x2*)(rowp + bj * 64) = w; } }
    }
};
struct EpiResid {
    static constexpr bool PERM = false;
    const float* xold_lat; const float* xold_ctx; float* xnew_lat; float* xnew_ctx; const float* modl;
    DI void operator()(const f32x4 (&acc)[2][2][4][2], const Unit& u, int wr, int wc, int fr, int fq) const {
        const int b = u.pm / 17, w = u.pm % 17;
        const float* xo = (w == 0) ? xold_ctx + (size_t)(b * 256) * DM : xold_lat + (size_t)(b * 4096 + (w - 1) * 256) * DM;
        float* xn = (w == 0) ? xnew_ctx + (size_t)(b * 256) * DM : xnew_lat + (size_t)(b * 4096 + (w - 1) * 256) * DM;
        const float* ga = modl + (size_t)((w == 0) ? 8 : b) * 6144 + 2048;
        const int r0 = wr * 64 + fr, col0 = u.pn * BM + wc * 32 + 4 * fq;
        f32x4 gv[2][2];
#pragma unroll
        for (int bj = 0; bj < 2; ++bj)
#pragma unroll
            for (int n = 0; n < 2; ++n) gv[bj][n] = *(const f32x4*)(ga + col0 + bj * HALF + n * 16);
#pragma unroll
        for (int ai = 0; ai < 2; ++ai)
#pragma unroll
            for (int m = 0; m < 4; ++m) { const size_t ro = (size_t)(r0 + ai * HALF + m * 16) * DM + col0;
#pragma unroll
                for (int bj = 0; bj < 2; ++bj)
#pragma unroll
                    for (int n = 0; n < 2; ++n) { const f32x4 o = *(const f32x4*)(xo + ro + bj * HALF + n * 16); *(f32x4*)(xn + ro + bj * HALF + n * 16) = o + gv[bj][n] * acc[ai][bj][m][n]; }
                asm volatile("" ::: "memory"); }
    }
};

template <class Epi, bool ALIGN_EPI = true, bool SP2 = true, bool GATHER = false>
DI void gemm_phase(LAS unsigned char* lds, const Gemm g, const Sched& S, const Epi& E, const int tid) {
    const int wid = __builtin_amdgcn_readfirstlane(tid >> 6), lane = tid & 63, wr = wid >> 2, wc = wid & 3, fr = lane & 15, fq = lane >> 4;
    const int K = g.K, nt = K / BK;
    unsigned voffA[2], voffB[2];
#pragma unroll
    for (int i = 0; i < 2; ++i) { int R, C; stage_rc(tid * 16 + i * 8192, R, C); const int Rb = Epi::PERM ? ((R & ~31) + perm32(R & 31)) : R;
        voffA[i] = (unsigned)(R * g.lda + C) * 2u; voffB[i] = (unsigned)(Rb * g.ldb + C) * 2u; }
    const size_t kstep = (size_t)(BK * 2);
    const size_t hstepA = GATHER ? (size_t)0 : (size_t)HALF * g.lda * 2, hstepB = (size_t)HALF * g.ldb * 2;
    unsigned vG[2][2], vN[2][2]; int gR[2], gC[2];
    LAS int* lidx = (LAS int*)(lds + STAGE_BYTES);
#pragma unroll
    for (int i = 0; i < 2; ++i) { int R, C; stage_rc(tid * 16 + i * 8192, R, C); gR[i] = R; gC[i] = C * 2; }
#define PG8_GOFF(V, ui_) do { _Pragma("unroll") for (int h_ = 0; h_ < 2; ++h_) _Pragma("unroll") for (int i_ = 0; i_ < 2; ++i_) \
        V[h_][i_] = (unsigned)lidx[(ui_) * 256 + h_ * 128 + gR[i_]] * (unsigned)(g.lda * 2) + (unsigned)gC[i_]; } while (0)
    const unsigned ldsw = (unsigned)wid * 1024u;
    const int aoff = lds_byte(wr * 64 + fr, fq * 8), boff = lds_byte(wc * 32 + fr, fq * 8);
#define PG8_SA(b, h) (((b) * 2 + (h)) * HTB)
#define PG8_SB(b, h) ((4 + (b) * 2 + (h)) * HTB)
#define PG8_STAGE(bufoff, gbase, voff) do { _Pragma("unroll") for (int _i = 0; _i < 2; ++_i) \
        __builtin_amdgcn_global_load_lds((const unsigned*)((const char*)(gbase) + (voff)[_i]), (LAS unsigned*)(lds + (bufoff) + ldsw + _i * 8192), 16, 0, 0); } while (0)
#define PG8_LDA(dst, b, h) do { _Pragma("unroll") for (int m = 0; m < 4; ++m) _Pragma("unroll") for (int k = 0; k < 2; ++k) dst[m][k] = *(const LAS bf16x8*)(lds + PG8_SA(b, h) + aoff + m * 2048 + k * 1024); } while (0)
#define PG8_LDB(dst, b, h) do { _Pragma("unroll") for (int n = 0; n < 2; ++n) _Pragma("unroll") for (int k = 0; k < 2; ++k) dst[n][k] = *(const LAS bf16x8*)(lds + PG8_SB(b, h) + boff + n * 2048 + k * 1024); } while (0)
#define PG8_MMA(ai, bj, At, Bt) do { __builtin_amdgcn_s_setprio(1); _Pragma("unroll") for (int m = 0; m < 4; ++m) _Pragma("unroll") for (int n = 0; n < 2; ++n) _Pragma("unroll") for (int k = 0; k < 2; ++k) \
        acc[ai][bj][m][n] = __builtin_amdgcn_mfma_f32_16x16x32_bf16(Bt[n][k], At[m][k], acc[ai][bj][m][n], 0, 0, 0); __builtin_amdgcn_s_setprio(0); } while (0)
#define PG8_WAIT_V(n) asm volatile("s_waitcnt vmcnt(" #n ")" ::: "memory")
#define PG8_WAIT_L(n) asm volatile("s_waitcnt lgkmcnt(" #n ")" ::: "memory")
#define PG8_BAR __builtin_amdgcn_s_barrier()
#define PG8_SCHED __builtin_amdgcn_sched_barrier(0)
    Unit cur, nxt; int ui = 0;
    if (!S.next(0, cur)) return;
    if constexpr (GATHER) { Unit u_; for (int q_ = 0; S.next(q_, u_); ++q_) if (tid < 256) lidx[q_ * 256 + tid] = g.gidx[u_.arow + tid];
        __syncthreads(); PG8_GOFF(vG, 0); }
    f32x4 acc[2][2][4][2];
#pragma unroll
    for (int a = 0; a < 2; ++a)
#pragma unroll
        for (int b = 0; b < 2; ++b)
#pragma unroll
            for (int m = 0; m < 4; ++m)
#pragma unroll
                for (int n = 0; n < 2; ++n) acc[a][b][m][n] = (f32x4){0.f, 0.f, 0.f, 0.f};
    bf16x8 At[4][2], B0[2][2], B1[2][2];
    const char* cA = GATHER ? (const char*)g.A : (const char*)g.A + (size_t)cur.arow * g.lda * 2; const char* cB = (const char*)g.Bt + (size_t)cur.brow * g.ldb * 2;
#define PG8_VA(h, nextu) (GATHER ? ((nextu) ? vN[h] : vG[h]) : voffA)
    if constexpr (SP2) {
        PG8_STAGE(PG8_SB(0, 0), cB, voffB); PG8_STAGE(PG8_SB(0, 1), cB + hstepB, voffB); PG8_STAGE(PG8_SA(0, 0), cA, PG8_VA(0, false)); PG8_STAGE(PG8_SA(0, 1), cA + hstepA, PG8_VA(1, false));
        if (wr == 1) PG8_BAR;
        PG8_WAIT_V(2); PG8_BAR;
        PG8_STAGE(PG8_SB(1, 0), cB + kstep, voffB); PG8_STAGE(PG8_SA(1, 0), cA + kstep, PG8_VA(0, false)); PG8_STAGE(PG8_SB(1, 1), cB + hstepB + kstep, voffB);
        PG8_WAIT_V(6); PG8_BAR;
    } else {
    PG8_STAGE(PG8_SB(0, 0), cB, voffB); PG8_STAGE(PG8_SA(0, 0), cA, voffA); PG8_STAGE(PG8_SB(0, 1), cB + hstepB, voffB); PG8_STAGE(PG8_SA(0, 1), cA + hstepA, voffA);
    if (wr == 1) PG8_BAR;
    PG8_WAIT_V(4); PG8_BAR;
    PG8_STAGE(PG8_SB(1, 0), cB + kstep, voffB); PG8_STAGE(PG8_SA(1, 0), cA + kstep, voffA); PG8_STAGE(PG8_SB(1, 1), cB + hstepB + kstep, voffB);
    PG8_WAIT_V(6); PG8_BAR;
    }
    for (;;) {
        const bool has_next = S.next(ui + 1, nxt);
        const char* nA = GATHER ? cA : (has_next ? (const char*)g.A + (size_t)nxt.arow * g.lda * 2 : cA); const char* nB = has_next ? (const char*)g.Bt + (size_t)nxt.brow * g.ldb * 2 : cB;
        if constexpr (GATHER) { if (has_next) PG8_GOFF(vN, ui + 1); else {
#pragma unroll
            for (int h_ = 0; h_ < 2; ++h_) { vN[h_][0] = vG[h_][0]; vN[h_][1] = vG[h_][1]; } } }
        for (int t = 0; t < nt; t += 2) {
            const bool last = (t == nt - 2);
            const char* a1 = cA + (size_t)(t + 1) * kstep;
            const char* a2 = last ? nA : cA + (size_t)(t + 2) * kstep; const char* b2 = last ? nB : cB + (size_t)(t + 2) * kstep;
            const char* a3 = a2 + kstep; const char* b3 = b2 + kstep;
            if constexpr (SP2) {
            PG8_LDB(B0, 0, 0); PG8_LDB(B1, 0, 1); PG8_SCHED; PG8_LDA(At, 0, 0); PG8_STAGE(PG8_SA(1, 1), a1 + hstepA, PG8_VA(1, false));
            PG8_WAIT_V(8); PG8_WAIT_L(0); PG8_BAR; PG8_MMA(0, 0, At, B0); PG8_MMA(0, 1, At, B1); PG8_BAR; PG8_SCHED;
            PG8_LDA(At, 0, 1); PG8_STAGE(PG8_SB(0, 0), b2, voffB); PG8_STAGE(PG8_SB(0, 1), b2 + hstepB, voffB); PG8_STAGE(PG8_SA(0, 0), a2, PG8_VA(0, last));
            PG8_WAIT_V(8); PG8_WAIT_L(0); PG8_BAR; PG8_MMA(1, 0, At, B0); PG8_MMA(1, 1, At, B1); PG8_BAR; PG8_SCHED;
            PG8_LDB(B0, 1, 0); PG8_LDB(B1, 1, 1); PG8_SCHED; PG8_LDA(At, 1, 0); PG8_STAGE(PG8_SA(0, 1), a2 + hstepA, PG8_VA(1, last));
            PG8_WAIT_V(8); PG8_WAIT_L(0); PG8_BAR; PG8_MMA(0, 0, At, B0); PG8_MMA(0, 1, At, B1); PG8_BAR; PG8_SCHED;
            PG8_LDA(At, 1, 1); PG8_STAGE(PG8_SB(1, 0), b3, voffB); PG8_STAGE(PG8_SB(1, 1), b3 + hstepB, voffB); PG8_STAGE(PG8_SA(1, 0), a3, PG8_VA(0, last));
            PG8_WAIT_V(8); PG8_WAIT_L(0); PG8_BAR; PG8_MMA(1, 0, At, B0); PG8_MMA(1, 1, At, B1); PG8_BAR; PG8_SCHED;
            } else {
            PG8_LDB(B0, 0, 0); PG8_SCHED; PG8_LDA(At, 0, 0); PG8_STAGE(PG8_SA(1, 1), a1 + hstepA, voffA);
            PG8_WAIT_L(8); PG8_BAR; PG8_WAIT_L(0); PG8_MMA(0, 0, At, B0); PG8_BAR; PG8_SCHED;
            PG8_LDB(B1, 0, 1); PG8_STAGE(PG8_SB(0, 0), b2, voffB);
            PG8_BAR; PG8_WAIT_L(0); PG8_MMA(0, 1, At, B1); PG8_BAR;
            PG8_LDA(At, 0, 1); PG8_STAGE(PG8_SA(0, 0), a2, voffA);
            PG8_BAR; PG8_WAIT_L(0); PG8_MMA(1, 0, At, B0); PG8_BAR; PG8_SCHED;
            PG8_STAGE(PG8_SB(0, 1), b2 + hstepB, voffB);
            PG8_WAIT_V(6); PG8_BAR; PG8_MMA(1, 1, At, B1); PG8_BAR;
            PG8_LDB(B0, 1, 0); PG8_SCHED; PG8_LDA(At, 1, 0); PG8_STAGE(PG8_SA(0, 1), a2 + hstepA, voffA);
            PG8_WAIT_L(8); PG8_BAR; PG8_WAIT_L(0); PG8_MMA(0, 0, At, B0); PG8_BAR; PG8_SCHED;
            PG8_LDB(B1, 1, 1); PG8_STAGE(PG8_SB(1, 0), b3, voffB);
            PG8_BAR; PG8_WAIT_L(0); PG8_MMA(0, 1, At, B1); PG8_BAR;
            PG8_LDA(At, 1, 1); PG8_STAGE(PG8_SA(1, 0), a3, voffA);
            PG8_BAR; PG8_WAIT_L(0); PG8_MMA(1, 0, At, B0); PG8_BAR; PG8_SCHED;
            PG8_STAGE(PG8_SB(1, 1), b3 + hstepB, voffB);
            PG8_WAIT_V(6); PG8_BAR; PG8_MMA(1, 1, At, B1); PG8_BAR;
            }
        }
        if constexpr (ALIGN_EPI) { if (wr == 0) PG8_BAR; }
        E(acc, cur, wr, wc, fr, fq);
        if (!has_next) break;
#pragma unroll
        for (int a = 0; a < 2; ++a)
#pragma unroll
            for (int b = 0; b < 2; ++b)
#pragma unroll
                for (int m = 0; m < 4; ++m)
#pragma unroll
                    for (int n = 0; n < 2; ++n) acc[a][b][m][n] = (f32x4){0.f, 0.f, 0.f, 0.f};
        cur = nxt; cA = nA; cB = nB; ++ui;
        if constexpr (GATHER) {
#pragma unroll
            for (int h_ = 0; h_ < 2; ++h_) { vG[h_][0] = vN[h_][0]; vG[h_][1] = vN[h_][1]; } }
        if constexpr (ALIGN_EPI) { if (wr == 1) PG8_BAR; }
    }
    PG8_WAIT_V(0);
    if constexpr (!ALIGN_EPI) { if (wr == 0) PG8_BAR; }
    PG8_BAR;
#undef PG8_SA
#undef PG8_VA
#undef PG8_GOFF
#undef PG8_SB
#undef PG8_STAGE
#undef PG8_LDA
#undef PG8_LDB
#undef PG8_MMA
#undef PG8_WAIT_V
#undef PG8_WAIT_L
#undef PG8_BAR
#undef PG8_SCHED
}
}


#define XB_TMO      128
#define XB_XCNT(j)  (256  + 64 * (j))
#define XB_XSUB(j)  (1280 + 64 * (j))
#define XB_XGEN(j)  (2304 + 64 * (j))
#define XB_TOP      3328
#define XB_TOPGEN   3392
#define XCD_BAR_WORDS 3456
#define XB_SPIN_CAP (1u << 22)
DI unsigned xb_ld(unsigned* p)              { return __hip_atomic_load(p, __ATOMIC_RELAXED, __HIP_MEMORY_SCOPE_AGENT); }
DI unsigned xb_add(unsigned* p, unsigned v) { return __hip_atomic_fetch_add(p, v, __ATOMIC_RELAXED, __HIP_MEMORY_SCOPE_AGENT); }
DI unsigned xb_xcc_id() { return (unsigned)__builtin_amdgcn_s_getreg((3 << 11) | 20) & 0xFu; }
#define XB_SPIN(cond, bar) do { unsigned _sp = 0; while (cond) { __builtin_amdgcn_s_sleep(1); \
    if ((++_sp & 255u) == 0u) { if (xb_ld(&(bar)[XB_TMO])) break; if (_sp > XB_SPIN_CAP) { atomicAdd(&(bar)[XB_TMO], 1u); break; } } } } while (0)
struct XcdBarrier { unsigned* bar; unsigned x; volatile LAS unsigned* st; };
DI XcdBarrier xcd_barrier_post(unsigned* bar, volatile LAS unsigned* st) {
    XcdBarrier b; b.bar = bar; b.x = xb_xcc_id(); b.st = st;
    if (threadIdx.x == 0) (void)xb_add(&bar[XB_XCNT(b.x)], 1u);
    return b;
}
DI void xcd_barrier_complete(unsigned* bar, unsigned x, unsigned& nloc, unsigned& nx) {
    const unsigned G = gridDim.x * gridDim.y * gridDim.z;
    unsigned sum, cnt, mine, sp = 0u;
    for (;;) {
        sum = 0u; cnt = 0u; mine = 0u;
#pragma unroll
        for (unsigned j = 0; j < 16; ++j) { const unsigned c = xb_ld(&bar[XB_XCNT(j)]); sum += c; cnt += (c > 0u) ? 1u : 0u; mine = (j == x) ? c : mine; }
        if (sum == G) break;
        __builtin_amdgcn_s_sleep(1);
        if ((++sp & 255u) == 0u) { if (xb_ld(&bar[XB_TMO])) break; if (sp > XB_SPIN_CAP) { atomicAdd(&bar[XB_TMO], 1u); break; } }
    }
    nloc = mine > 0u ? mine : 1u; nx = cnt > 0u ? cnt : 1u;
}
DI void xcd_barrier(const XcdBarrier& b) {
    asm volatile("s_waitcnt vmcnt(0)" ::: "memory");
    __syncthreads();
    if (threadIdx.x == 0) {
        unsigned* bar = b.bar;
        __builtin_amdgcn_s_waitcnt(0);
        unsigned nloc = b.st[0], nx = b.st[1];
        if (nloc == 0u) { xcd_barrier_complete(bar, b.x, nloc, nx); b.st[0] = nloc; b.st[1] = nx; }
        const unsigned old = xb_add(&bar[XB_XSUB(b.x)], 1u);
        const unsigned gen = old / nloc;
        if (old + 1u == (gen + 1u) * nloc) {
            __builtin_amdgcn_fence(__ATOMIC_RELEASE, "agent");
            asm volatile("s_waitcnt vmcnt(0)" ::: "memory");
            const unsigned og = xb_add(&bar[XB_TOP], 1u);
            const unsigned tg = og / nx;
            if (og + 1u == (tg + 1u) * nx) xb_add(&bar[XB_TOPGEN], 1u);
            else XB_SPIN(xb_ld(&bar[XB_TOPGEN]) == tg, bar);
            __builtin_amdgcn_fence(__ATOMIC_ACQUIRE, "agent");
            xb_add(&bar[XB_XGEN(b.x)], 1u);
            asm volatile("s_waitcnt vmcnt(0)" ::: "memory");
        } else {
            XB_SPIN(xb_ld(&bar[XB_XGEN(b.x)]) == gen, bar);
            __builtin_amdgcn_fence(__ATOMIC_ACQUIRE, "agent");
            asm volatile("s_waitcnt vmcnt(0)" ::: "memory");
        }
    }
    __syncthreads();
}

struct Ctx {
    const float* const* in; float* out; unsigned char* ws; int G, bid, tid, wave, lane; LAS unsigned char* lds;
    DI float* modv(int l) const { return (float*)(ws + OFF_MOD) + (size_t)l * 9 * 6144; }
    DI bf16_t* wsm(int l, size_t off) const { return (bf16_t*)(ws + OFF_WSM + (size_t)l * WSM_STRIDE + off); }
    DI bf16_t* act() const { return (bf16_t*)(ws + OFF_ACT); }
    DI bf16_t* pbuf() const { return (bf16_t*)(ws + OFF_ARENA + AR_P); }
    DI bf16_t* qkv() const { return (bf16_t*)(ws + OFF_ARENA + AR_QKV); }
    DI bf16_t* kf() const { return (bf16_t*)(ws + OFF_ARENA + AR_KF); }
    DI bf16_t* ops(int i) const { return (bf16_t*)(ws + OFF_ARENA + AR_OPS + (size_t)i * OPS_STRIDE); }
    DI float* xc() const { return (float*)(ws + OFF_XC); }
    DI float* bonus() const { return (float*)(ws + OFF_BONUS); }
    DI int* cnt() const { return (int*)(ws + OFF_CNT); }
};

DI void phase_mod(const Ctx& C) {
    LAS float* sl = (LAS float*)C.lds;
    LAS float* red = (LAS float*)(C.lds + 40960);
    const float* cv = C.in[1]; const float* ccx = C.in[3];
    for (int i = C.tid; i < 9 * 1024; i += NTHR) { const int s = i >> 10, k = i & 1023; const float v = (s < 8) ? cv[s * 1024 + k] : ccx[k]; sl[i] = siluf_(v); }
    __syncthreads();
    for (int item = C.bid; item < 192; item += C.G) {
        const int l = item / 96, col = (item % 96) * 64 + C.lane;
        const float* W = C.in[4] + (size_t)l * 1024 * 6144 + col;
        float acc[9];
#pragma unroll
        for (int j = 0; j < 9; ++j) acc[j] = 0.f;
        const int k0 = C.wave * 128;
        for (int kb = 0; kb < 128; kb += 16) { float wv[16];
#pragma unroll
            for (int k = 0; k < 16; ++k) wv[k] = W[(size_t)(k0 + kb + k) * 6144];
#pragma unroll
            for (int k = 0; k < 16; ++k)
#pragma unroll
                for (int j = 0; j < 9; ++j) acc[j] += sl[j * 1024 + k0 + kb + k] * wv[k]; }
#pragma unroll
        for (int j = 0; j < 9; ++j) red[(C.wave * 9 + j) * 64 + C.lane] = acc[j];
        __syncthreads();
        for (int o = C.tid; o < 9 * 64; o += NTHR) { const int j = o >> 6, ln = o & 63; float s = 0.f;
            for (int w = 0; w < 8; ++w) s += red[(w * 9 + j) * 64 + ln];
            const int cc = (item % 96) * 64 + ln;
            C.modv(l)[(size_t)j * 6144 + cc] = s + C.in[5][(size_t)l * 6144 + cc]; }
        __syncthreads();
    }
}

DI void phase_rope_tables(const Ctx& C) {
    f32x2* RT = (f32x2*)(C.ws + OFF_ROPE); f32x2* AT = (f32x2*)(C.ws + OFF_ROPE + ROPE_AT);
    const int n1 = SB * 32, n2 = SEQ * 16;
    for (int i = C.bid * NTHR + C.tid; i < n1 + n2; i += C.G * NTHR) {
        float sn, cs;
        if (i < n1) { const int pos = i >> 5, k = i & 31; const float inv = exp2f(-(float)k * (13.287712379549449f / 31.f)); sincosf((float)pos * inv, &sn, &cs); RT[i] = (f32x2){cs, sn}; }
        else { const int j = i - n1, t = j >> 4, p = j & 15, f = p & 7; const float inv = exp2f(-(float)f * (13.287712379549449f / 8.f)); const float pos = (p < 8) ? (float)(t >> 6) : (float)(t & 63);
            sincosf(pos * inv, &sn, &cs); AT[j] = (f32x2){cs, sn}; }
    }
}

struct TJob { const float* src; int ldsrc, Ks, Ns; const float* kscale; bf16_t* dst; int lddst, row0, col0, nkt, nnt, rowmap; };
DI void tconv_tile(const TJob& J, int kt, int nt, LAS float* lds, const int tid) {
    const int k0 = kt * 64, n0 = nt * 64;
    { const int kk = tid >> 3, nn = (tid & 7) * 8; const int k = k0 + kk; float v[8];
#pragma unroll
      for (int j = 0; j < 8; ++j) v[j] = 0.f;
      if (J.src && k < J.Ks) { const float* sp = J.src + (size_t)k * J.ldsrc + n0 + nn;
          if (n0 + nn + 7 < J.Ns) { const f32x4 a = *(const f32x4*)sp, b = *(const f32x4*)(sp + 4); v[0] = a[0]; v[1] = a[1]; v[2] = a[2]; v[3] = a[3]; v[4] = b[0]; v[5] = b[1]; v[6] = b[2]; v[7] = b[3]; }
          else {
#pragma unroll
              for (int j = 0; j < 8; ++j) if (n0 + nn + j < J.Ns) v[j] = sp[j]; }
          const float sc = J.kscale ? J.kscale[k] : 1.f;
#pragma unroll
          for (int j = 0; j < 8; ++j) v[j] *= sc; }
#pragma unroll
      for (int j = 0; j < 8; ++j) lds[kk * 65 + nn + j] = v[j]; }
    __syncthreads();
    { const int n = tid >> 3, kq = (tid & 7) * 8; float v[8];
#pragma unroll
      for (int j = 0; j < 8; ++j) v[j] = lds[(kq + j) * 65 + n];
      const int nl = n0 + n; int dr;
      if (J.rowmap == 0) dr = nl; else dr = 8 * (nl >> 2) + (nl & 3) + (J.rowmap == 2 ? 4 : 0);
      u32x4 w; w.x = pk2(v[0], v[1]); w.y = pk2(v[2], v[3]); w.z = pk2(v[4], v[5]); w.w = pk2(v[6], v[7]);
      *(u32x4*)(J.dst + (size_t)(J.row0 + dr) * J.lddst + J.col0 + k0 + kq) = w; }
    __syncthreads();
}
DI TJob small_job(const Ctx& C, int l, int j) {
    TJob J; J.kscale = nullptr; J.rowmap = 0; J.row0 = 0; J.col0 = 0;
    switch (j) {
    case 0: J.src = C.in[8] + (size_t)l * 1024 * INC; J.ldsrc = INC; J.Ks = 1024; J.Ns = INC; J.dst = C.wsm(l, WSM_WIN); J.lddst = 1024; J.nkt = 16; J.nnt = 44; break;
    case 1: J.src = C.in[10] + (size_t)l * 384 * 768; J.ldsrc = 768; J.Ks = 384; J.Ns = 768; J.kscale = C.in[9] + l * 384; J.dst = C.wsm(l, WSM_WQKV); J.lddst = 640; J.nkt = 6; J.nnt = 12; break;
    case 2: J.src = C.in[12] + (size_t)l * 256 * 1024; J.ldsrc = 1024; J.Ks = 256; J.Ns = 1024; J.kscale = C.in[11] + l * 256; J.dst = C.wsm(l, WSM_WQKV); J.lddst = 640; J.row0 = 768; J.col0 = 384; J.nkt = 4; J.nnt = 16; break;
    case 3: J.src = nullptr; J.ldsrc = 0; J.Ks = 0; J.Ns = 0; J.dst = C.wsm(l, WSM_WQKV); J.lddst = 640; J.row0 = 0; J.col0 = 384; J.nkt = 4; J.nnt = 12; break;
    case 4: J.src = nullptr; J.ldsrc = 0; J.Ks = 0; J.Ns = 0; J.dst = C.wsm(l, WSM_WQKV); J.lddst = 640; J.row0 = 768; J.col0 = 0; J.nkt = 6; J.nnt = 16; break;
    case 5: J.src = C.in[27] + (size_t)l * 1024 * 1024; J.ldsrc = 1024; J.Ks = 1024; J.Ns = 1024; J.dst = C.wsm(l, WSM_WOUT); J.lddst = 1024; J.nkt = 16; J.nnt = 16; break;
    case 6: J.src = C.in[19] + (size_t)(l * 2 + 0) * 64 * 256; J.ldsrc = 256; J.Ks = 64; J.Ns = 256; J.dst = C.wsm(l, WSM_W2F); J.lddst = 64; J.nkt = 1; J.nnt = 4; break;
    case 7: J.src = C.in[19] + (size_t)(l * 2 + 1) * 64 * 256; J.ldsrc = 256; J.Ks = 64; J.Ns = 256; J.dst = C.wsm(l, WSM_W2B); J.lddst = 64; J.nkt = 1; J.nnt = 4; break;
    case 8: J.src = C.in[21] + (size_t)l * 64 * 256; J.ldsrc = 256; J.Ks = 64; J.Ns = 256; J.dst = C.wsm(l, WSM_A2); J.lddst = 64; J.nkt = 1; J.nnt = 4; break;
    default: J.src = C.in[22] + (size_t)l * 128 * 256; J.ldsrc = 256; J.Ks = 128; J.Ns = 256; J.dst = C.wsm(l, WSM_G2); J.lddst = 128; J.nkt = 2; J.nnt = 4; break;
    }
    return J;
}
DI void phase_wconv_small(const Ctx& C) {
    LAS float* lds = (LAS float*)C.lds;
    int base = 0;
    for (int l = 0; l < 2; ++l)
        for (int j = 0; j < 10; ++j) {
            const TJob J = small_job(C, l, j); const int ntile = J.nkt * J.nnt;
            int first = (C.bid - base % C.G + C.G) % C.G;
            for (int t = first; t < ntile; t += C.G) tconv_tile(J, t / J.nnt, t % J.nnt, lds, C.tid);
            base += ntile;
        }
}
constexpr int SM_TILES = 1260, P0_NMOD = 192, P0_NB = 2 * SM_TILES / 8;
struct TDst { bf16_t* dp; int ld; };
DI TDst tconv_ld(const Ctx& C, int t, const int tid, f32x4& a, f32x4& b, float& sc) {
    int l = 0; if (t >= SM_TILES) { l = 1; t -= SM_TILES; }
    int j;
    if (t < 704) j = 0; else if (t < 776) { j = 1; t -= 704; } else if (t < 840) { j = 2; t -= 776; } else if (t < 888) { j = 3; t -= 840; } else if (t < 984) { j = 4; t -= 888; }
    else if (t < 1240) { j = 5; t -= 984; } else if (t < 1244) { j = 6; t -= 1240; } else if (t < 1248) { j = 7; t -= 1244; } else if (t < 1252) { j = 8; t -= 1248; } else { j = 9; t -= 1252; }
    const TJob J = small_job(C, l, j);
    const int kt = t / J.nnt, nt = t - kt * J.nnt; const int k0 = kt * 64, n0 = nt * 64; const int kk = tid >> 3, nn = (tid & 7) * 8;
    a = (f32x4){0.f, 0.f, 0.f, 0.f}; b = a; sc = 1.f;
    if (J.src) { if (n0 + nn < J.Ns) { const float* sp = J.src + (size_t)(k0 + kk) * J.ldsrc + n0 + nn; a = *(const f32x4*)sp; b = *(const f32x4*)(sp + 4); }
                 if (J.kscale) sc = J.kscale[k0 + kk]; }
    TDst r; r.dp = J.dst + (size_t)(J.row0 + n0) * J.lddst + J.col0 + k0; r.ld = J.lddst; return r;
}
DI void tconv_range8(const Ctx& C, int t0) {
    LAS float* lds = (LAS float*)(C.lds + 65536);
    const int tid = C.tid, kk = tid >> 3, nn = (tid & 7) * 8, n = tid >> 3, kq = (tid & 7) * 8;
    f32x4 A0[4], B0[4], A1[4], B1[4]; float s0[4], s1[4]; TDst d0[4], d1[4];
#define TQ_PROC(A, B, S, D) do { \
        _Pragma("unroll") for (int q_ = 0; q_ < 4; ++q_) { LAS float* d_ = lds + q_ * 4160 + kk * 65 + nn; const f32x4 a_ = A[q_] * S[q_], b_ = B[q_] * S[q_]; \
            d_[0] = a_[0]; d_[1] = a_[1]; d_[2] = a_[2]; d_[3] = a_[3]; d_[4] = b_[0]; d_[5] = b_[1]; d_[6] = b_[2]; d_[7] = b_[3]; } \
        __syncthreads(); \
        _Pragma("unroll") for (int q_ = 0; q_ < 4; ++q_) { const LAS float* s_ = lds + q_ * 4160 + kq * 65 + n; \
            u32x4 w_; w_.x = pk2(s_[0], s_[65]); w_.y = pk2(s_[130], s_[195]); w_.z = pk2(s_[260], s_[325]); w_.w = pk2(s_[390], s_[455]); \
            *(u32x4*)(D[q_].dp + (size_t)n * D[q_].ld + kq) = w_; } \
        __syncthreads(); } while (0)
#pragma unroll
    for (int q = 0; q < 4; ++q) d0[q] = tconv_ld(C, t0 + q, tid, A0[q], B0[q], s0[q]);
#pragma unroll
    for (int q = 0; q < 4; ++q) d1[q] = tconv_ld(C, t0 + 4 + q, tid, A1[q], B1[q], s1[q]);
    TQ_PROC(A0, B0, s0, d0);
    TQ_PROC(A1, B1, s1, d1);
#undef TQ_PROC
}
DI void mod_item(const Ctx& C, int item, bool need_sl) {
    LAS float* sl = (LAS float*)C.lds;
    LAS float* red = (LAS float*)(C.lds + 40960);
    const int l = item / 96, col = (item % 96) * 64 + C.lane;
    const int k0 = C.wave * 128;
    const float* W = C.in[4] + (size_t)l * 1024 * 6144 + (size_t)k0 * 6144 + col;
    float wv[128];
#pragma unroll
    for (int k = 0; k < 128; ++k) wv[k] = W[(size_t)k * 6144];
    if (need_sl) { const float* cv = C.in[1]; const float* ccx = C.in[3];
        float tv[18];
#pragma unroll
        for (int q = 0; q < 18; ++q) { const int i = C.tid + q * NTHR; const int s = i >> 10, k = i & 1023; tv[q] = (s < 8) ? cv[s * 1024 + k] : ccx[k]; }
#pragma unroll
        for (int q = 0; q < 18; ++q) sl[C.tid + q * NTHR] = siluf_(tv[q]);
        __syncthreads(); }
    float acc[9];
#pragma unroll
    for (int j = 0; j < 9; ++j) acc[j] = 0.f;
#pragma unroll
    for (int k = 0; k < 128; ++k)
#pragma unroll
        for (int j = 0; j < 9; ++j) acc[j] += sl[j * 1024 + k0 + k] * wv[k];
#pragma unroll
    for (int j = 0; j < 9; ++j) red[(C.wave * 9 + j) * 64 + C.lane] = acc[j];
    __syncthreads();
    for (int o = C.tid; o < 9 * 64; o += NTHR) { const int j = o >> 6, ln = o & 63; float s = 0.f;
        for (int w = 0; w < 8; ++w) s += red[(w * 9 + j) * 64 + ln];
        const int cc = (item % 96) * 64 + ln;
        C.modv(l)[(size_t)j * 6144 + cc] = s + C.in[5][(size_t)l * 6144 + cc]; }
    __syncthreads();
}
DI void phase_p0(const Ctx& C0) {
    LAS int* slot = (LAS int*)(C0.lds + LDS_BYTES - 16);
    bool have_sl = false;
    for (;;) {
        __syncthreads(); if (C0.tid == 0) *slot = atomicAdd(C0.cnt() + 16, 1); __syncthreads();
        const int it = *slot;
#ifdef DIAG_TS
        if (it >= P0_NMOD + P0_NB && C0.tid == 0) atomicMax(((unsigned long long*)(C0.ws + OFF_CNT + 4096)) + 52, (unsigned long long)__builtin_amdgcn_s_memrealtime());
#endif
        if (it >= P0_NMOD + P0_NB) break;
        Ctx C2 = C0; asm volatile("" : "+v"(C2.tid)); C2.lane = C2.tid & 63; C2.wave = __builtin_amdgcn_readfirstlane(C2.tid >> 6); const Ctx& C = C2;
        if (it < P0_NMOD) {
            mod_item(C, it, !have_sl); have_sl = true;
#ifdef DIAG_TS
            if (C.tid == 0) atomicMax(((unsigned long long*)(C.ws + OFF_CNT + 4096)) + 53, (unsigned long long)__builtin_amdgcn_s_memrealtime());
#endif
        } else tconv_range8(C, (it - P0_NMOD) * 8);
    }
}
constexpr int WX_NGU = 2048, WX_NALL = 3072;
DI void wconv_range(const Ctx& C, int l, int t0, int cnt) {
    LAS float* lds = (LAS float*)C.lds;
    const int tid = C.tid, kk = tid >> 3, nn = (tid & 7) * 8, n = tid >> 3, kq = (tid & 7) * 8;
    f32x4 RA[8], RB[8];
#define WX_DEC(t) const int mat_ = (t) >> 6, kt_ = ((t) >> 2) & 15, ng_ = (t) & 3; const int kind_ = (mat_ < 32) ? (mat_ & 1) : 2, e_ = (mat_ < 32) ? (mat_ >> 1) : mat_ - 32
#define WX_LD(R, t) do { WX_DEC(t); \
        const float* p_ = C.in[29 + kind_] + (size_t)(l * 16 + e_) * 1048576 + (size_t)(kt_ * 64 + kk) * 1024 + ng_ * 256 + nn; \
        _Pragma("unroll") for (int j_ = 0; j_ < 4; ++j_) { R[2 * j_] = *(const f32x4*)(p_ + j_ * 64); R[2 * j_ + 1] = *(const f32x4*)(p_ + j_ * 64 + 4); } } while (0)
#define WX_PROC(R, t) do { WX_DEC(t); \
        _Pragma("unroll") for (int j_ = 0; j_ < 4; ++j_) { LAS float* d_ = lds + j_ * 4160 + kk * 65 + nn; \
            d_[0] = R[2 * j_][0]; d_[1] = R[2 * j_][1]; d_[2] = R[2 * j_][2]; d_[3] = R[2 * j_][3]; d_[4] = R[2 * j_ + 1][0]; d_[5] = R[2 * j_ + 1][1]; d_[6] = R[2 * j_ + 1][2]; d_[7] = R[2 * j_ + 1][3]; } \
        __syncthreads(); \
        bf16_t* dst_ = (kind_ < 2) ? (bf16_t*)(C.ws + OFF_WGU2) + (size_t)(e_ * 2048) * 1024 : (bf16_t*)(C.ws + OFF_ARENA + AR_WD) + (size_t)(e_ * 1024) * 1024; \
        _Pragma("unroll") for (int j_ = 0; j_ < 4; ++j_) { const LAS float* s_ = lds + j_ * 4160 + kq * 65 + n; const int nl_ = ng_ * 256 + j_ * 64 + n; \
            const int dr_ = (kind_ == 2) ? nl_ : 8 * (nl_ >> 2) + (nl_ & 3) + (kind_ == 1 ? 4 : 0); \
            u32x4 w_; w_.x = pk2(s_[0], s_[65]); w_.y = pk2(s_[130], s_[195]); w_.z = pk2(s_[260], s_[325]); w_.w = pk2(s_[390], s_[455]); \
            *(u32x4*)(dst_ + (size_t)dr_ * 1024 + kt_ * 64 + kq) = w_; } \
        __syncthreads(); } while (0)
    __syncthreads();
    WX_LD(RA, t0);
    for (int i = 0; i < cnt; i += 2) {
        if (i + 1 < cnt) WX_LD(RB, t0 + i + 1);
        WX_PROC(RA, t0 + i);
        if (i + 2 < cnt) WX_LD(RA, t0 + i + 2);
        if (i + 1 < cnt) WX_PROC(RB, t0 + i + 1);
    }
#undef WX_DEC
#undef WX_LD
#undef WX_PROC
}
DI void phase_wconv_experts(const Ctx& C, int l) {
    LAS int* slot = (LAS int*)(C.lds + LDS_BYTES - 16);
    int* ctr = C.cnt() + 8 + l;
    for (;;) {
        __syncthreads(); if (C.tid == 0) *slot = atomicAdd(ctr, 1); __syncthreads();
        const int bt = *slot; if (bt >= (WX_NALL - WX_NGU) / 4) break;
        wconv_range(C, l, WX_NGU + bt * 4, 4);
    }
}

DI const float* tok_row(const float* lat, const float* ctxp, int tok) { const int b = tok / SB, s = tok - b * SB; return (s < CTXL) ? ctxp + (size_t)(b * CTXL + s) * DM : lat + (size_t)(b * SEQ + s - CTXL) * DM; }

DI void norm_mod_store(const f32x4 (&v)[4], const float* nw, const float* modrow, int shoff, int scoff, bf16_t* dst, int lane) {
    float ss = 0.f;
#pragma unroll
    for (int j = 0; j < 4; ++j) ss += v[j][0] * v[j][0] + v[j][1] * v[j][1] + v[j][2] * v[j][2] + v[j][3] * v[j][3];
    ss = wave_sum(ss);
    const float rstd = rsqrtf(ss * (1.f / 1024.f) + 1e-6f);
#pragma unroll
    for (int j = 0; j < 4; ++j) { const int c = j * 256 + lane * 4;
        const f32x4 w = *(const f32x4*)(nw + c), sc = *(const f32x4*)(modrow + scoff + c), sh = *(const f32x4*)(modrow + shoff + c);
        const f32x4 o = v[j] * rstd * w * (sc + 1.f) + sh;
        u32x2 pkd; pkd.x = pk2(o[0], o[1]); pkd.y = pk2(o[2], o[3]); *(u32x2*)(dst + c) = pkd; }
}

DI void phase_u(const Ctx& C, int l, const float* lat, const float* ctxp) {
    const int gw = C.bid * 8 + C.wave, GW = C.G * 8;
    f32x4 v[4], v2[4];
#define PU_LOAD(V, V2, t_) do { const int t2_ = ((t_) + GW < T) ? (t_) + GW : (t_); const float* xr_ = tok_row(lat, ctxp, (t_)); const float* xr2_ = tok_row(lat, ctxp, t2_); \
        _Pragma("unroll") for (int j_ = 0; j_ < 4; ++j_) { V[j_] = *(const f32x4*)(xr_ + j_ * 256 + C.lane * 4); V2[j_] = *(const f32x4*)(xr2_ + j_ * 256 + C.lane * 4); } } while (0)
    if (gw < T) PU_LOAD(v, v2, gw);
    for (int tok = gw; tok < T; tok += 2 * GW) {
        const int tok2 = (tok + GW < T) ? tok + GW : tok; const int nt = tok + 2 * GW;
        f32x4 n[4], n2[4]; if (nt < T) PU_LOAD(n, n2, nt);
        { const int b = tok / SB, s = tok - b * SB; norm_mod_store(v, C.in[6] + l * 1024, C.modv(l) + (size_t)((s < CTXL) ? 8 : b) * 6144, 0, 1024, C.act() + (size_t)tok * DM, C.lane); }
        if (tok2 != tok) { const int b = tok2 / SB, s = tok2 - b * SB; norm_mod_store(v2, C.in[6] + l * 1024, C.modv(l) + (size_t)((s < CTXL) ? 8 : b) * 6144, 0, 1024, C.act() + (size_t)tok2 * DM, C.lane); }
        if (nt < T) {
#pragma unroll
            for (int j = 0; j < 4; ++j) { v[j] = n[j]; v2[j] = n2[j]; } }
    }
#undef PU_LOAD
}

DI void phase_ret_prep(const Ctx& C) {
    const int gw = C.bid * 8 + C.wave, GW = C.G * 8;
    const int hh = C.lane >> 4, i2 = (C.lane & 15) * 2;
    const f32x4* RT = (const f32x4*)(C.ws + OFF_ROPE);
    for (int tok = gw; tok < T; tok += GW) {
        const int s = tok % SB; bf16_t* pr = C.pbuf() + (size_t)tok * NPC;
        const f32x4 cssn = RT[(s * 32 + i2) >> 1]; const float c0 = cssn[0], s0 = cssn[1], c1 = cssn[2], s1 = cssn[3];
#pragma unroll
        for (int qk = 0; qk < 2; ++qk) { bf16_t* base = pr + (qk ? C_RK : C_RQ) + hh * 64 + i2; const float sc = qk ? 0.125f : 1.f;
            const unsigned a = *(const unsigned*)base, bq = *(const unsigned*)(base + 32);
            const float x10 = lo_f(a), x11 = hi_f(a), x20 = lo_f(bq), x21 = hi_f(bq);
            *(unsigned*)base = pk2((x10 * c0 - x20 * s0) * sc, (x11 * c1 - x21 * s1) * sc);
            *(unsigned*)(base + 32) = pk2((x10 * s0 + x20 * c0) * sc, (x11 * s1 + x21 * c1) * sc); }
    }
}

DI float shift_val(float pc, float pp, float pn, float mu) { return pc + (0.5f * (pp + pn) - pc) * mu; }
DI void phase_rwkv_prep(const Ctx& C, int l) {
    LAS bf16_t* X = (LAS bf16_t*)C.lds;
    LAS bf16_t* AL = (LAS bf16_t*)(C.lds + 64 * 328 * 2);
    const float* mu = C.in[17] + l * 1088;
    const bf16_t* P = C.pbuf();
    const int wave = C.wave;
    LAS float* Lmu = (LAS float*)(C.lds + 80 * 1024);
    LAS float* Lw0 = Lmu + 1088; LAS float* La0 = Lw0 + 512;
    for (int i = C.tid; i < 1088; i += NTHR) Lmu[i] = mu[i];
    for (int i = C.tid; i < 512; i += NTHR) Lw0[i] = C.in[18][(size_t)l * 512 + i];
    for (int i = C.tid; i < 256; i += NTHR) La0[i] = C.in[20][l * 256 + i];
    __syncthreads();
    bf16x8 wf0[2][2], wf1[2][2], wf2[2][2], wf3[2][4];
    { const int l0 = C.lane;
#pragma unroll
      for (int nt2 = 0; nt2 < 2; ++nt2) { const int row = wave * 32 + nt2 * 16 + (l0 & 15);
#pragma unroll
          for (int ks = 0; ks < 2; ++ks) { wf0[nt2][ks] = *(const bf16x8*)(C.wsm(l, WSM_W2F) + (size_t)row * 64 + ks * 32 + 8 * (l0 >> 4));
              wf1[nt2][ks] = *(const bf16x8*)(C.wsm(l, WSM_W2B) + (size_t)row * 64 + ks * 32 + 8 * (l0 >> 4));
              wf2[nt2][ks] = *(const bf16x8*)(C.wsm(l, WSM_A2) + (size_t)row * 64 + ks * 32 + 8 * (l0 >> 4)); }
#pragma unroll
          for (int ks = 0; ks < 4; ++ks) wf3[nt2][ks] = *(const bf16x8*)(C.wsm(l, WSM_G2) + (size_t)row * 128 + ks * 32 + 8 * (l0 >> 4)); } }
    LAS int* slot = (LAS int*)(C.lds + LDS_BYTES - 16);
    for (;;) {
        __syncthreads(); if (C.tid == 0) *slot = atomicAdd(C.cnt() + 20 + l, 1); __syncthreads();
        const int tile = *slot; if (tile >= 544) break;
        int tid_ = C.tid; asm volatile("" : "+v"(tid_)); const int lane = tid_ & 63;
        const int b = tile / 68, tt = tile % 68; const int s0 = tt * 64; const int tok0 = b * SB + s0;
        const int sfirst = (s0 < CTXL) ? 0 : CTXL, slast = (s0 < CTXL) ? CTXL - 1 : SB - 1;
#ifdef DIAG_TS
#define PSTAMP(k) do { if (l == 0 && tile == C.bid && C.bid == DIAG_BLK && C.tid == 0) ((unsigned long long*)(C.ws + OFF_CNT + 4096))[k] = __builtin_amdgcn_s_memrealtime(); } while (0)
#else
#define PSTAMP(k) do {} while (0)
#endif
        PSTAMP(42);
        { const int ti = tid_ >> 3, s = s0 + ti; const bf16_t* pc = P + (size_t)(tok0 + ti) * NPC + C_RW + 768;
          const bool hp = s > sfirst, hn = s < slast;
#pragma unroll
          for (int jj = 0; jj < 5; ++jj) { const int col = (tid_ & 7) * 8 + 64 * jj;
              const u32x4 vc = *(const u32x4*)(pc + col); u32x4 vp = {0u, 0u, 0u, 0u}, vn = {0u, 0u, 0u, 0u};
              if (hp) vp = *(const u32x4*)(pc - NPC + col); if (hn) vn = *(const u32x4*)(pc + NPC + col);
              unsigned o[4];
#pragma unroll
              for (int q = 0; q < 4; ++q) { float a = shift_val(lo_f(vc[q]), lo_f(vp[q]), lo_f(vn[q]), Lmu[768 + col + 2 * q]);
                  float bq = shift_val(hi_f(vc[q]), hi_f(vp[q]), hi_f(vn[q]), Lmu[768 + col + 2 * q + 1]);
                  if (col < 128) { a = 1.f - 2.f / (1.f + __expf(2.f * a)); bq = 1.f - 2.f / (1.f + __expf(2.f * bq)); } else if (col >= 192) { a = sigmoidf_(a); bq = sigmoidf_(bq); }
                  o[q] = pk2(a, bq); }
              *(LAS u32x4*)(X + ti * 328 + col) = (u32x4){o[0], o[1], o[2], o[3]}; } }
        __syncthreads();
        PSTAMP(43);
        {
#pragma unroll
          for (int mat = 0; mat < 4; ++mat) {
              const int xoff = (mat == 3) ? 192 : mat * 64; const int nks = (mat == 3) ? 4 : 2;
#pragma unroll 1
              for (int tg = 0; tg < 4; ++tg) { const int tk = tg * 16 + (lane & 15); const int tok = tok0 + tk;
                  bf16x8 xfr[4];
#pragma unroll
                  for (int ks = 0; ks < 4; ++ks) if (ks < nks) xfr[ks] = *(const LAS bf16x8*)(X + tk * 328 + xoff + ks * 32 + 8 * (lane >> 4));
#pragma unroll
                  for (int nt2 = 0; nt2 < 2; ++nt2) { f32x4 acc = {0.f, 0.f, 0.f, 0.f};
#pragma unroll
                      for (int ks = 0; ks < 4; ++ks) if (ks < nks) acc = __builtin_amdgcn_mfma_f32_16x16x32_bf16(mat == 0 ? wf0[nt2][ks & 1] : mat == 1 ? wf1[nt2][ks & 1] : mat == 2 ? wf2[nt2][ks & 1] : wf3[nt2][ks], xfr[ks], acc, 0, 0, 0);
                      const int n0 = wave * 32 + nt2 * 16 + 4 * (lane >> 4);
                      float o[4];
                      if (mat < 2) { const LAS float* w0 = Lw0 + mat * 256 + n0;
#pragma unroll
                          for (int q = 0; q < 4; ++q) o[q] = 1.f - __expf(-0.606531f * __builtin_amdgcn_rcpf(1.f + __expf(-(w0[q] + acc[q]))));
                          u32x2 w; w.x = pk2(o[0], o[1]); w.y = pk2(o[2], o[3]); *(u32x2*)(C.ops(1 + mat) + (size_t)tok * 256 + n0) = w; }
                      else if (mat == 2) { const LAS float* a0 = La0 + n0;
#pragma unroll
                          for (int q = 0; q < 4; ++q) o[q] = __builtin_amdgcn_rcpf(1.f + __expf(-(a0[q] + acc[q])));
                          u32x2 w; w.x = pk2(o[0], o[1]); w.y = pk2(o[2], o[3]); *(LAS u32x2*)(AL + tk * 264 + n0) = w; }
                      else { u32x2 w; w.x = pk2(acc[0], acc[1]); w.y = pk2(acc[2], acc[3]); *(u32x2*)(C.ops(3) + (size_t)tok * 256 + n0) = w; } } } } }
        __syncthreads();
        PSTAMP(44);
        { const int c4 = lane * 4;
          const f32x4 mur = *(const f32x4*)(mu + c4), muk = *(const f32x4*)(mu + 256 + c4), muv = *(const f32x4*)(mu + 512 + c4);
          const f32x4 kkw = *(const f32x4*)(C.in[23] + l * 256 + c4), kaw = *(const f32x4*)(C.in[24] + l * 256 + c4), rkw = *(const f32x4*)(C.in[25] + l * 256 + c4);
          u32x2 rowv[10][3];
#pragma unroll
          for (int rr = 0; rr < 10; ++rr) { const int sr = s0 + wave * 8 + rr - 1; const bool ok = (sr >= sfirst) && (sr <= slast);
              const bf16_t* pr_ = P + (size_t)(tok0 + wave * 8 + rr - 1) * NPC + C_RW + c4;
#pragma unroll
              for (int part = 0; part < 3; ++part) rowv[rr][part] = ok ? *(const u32x2*)(pr_ + part * 256) : (u32x2){0u, 0u}; }
#pragma unroll
          for (int q8 = 0; q8 < 8; ++q8) { const int ti = wave * 8 + q8, tok = tok0 + ti;
              f32x4 rs, ks_, vs;
#pragma unroll
              for (int part = 0; part < 3; ++part) { const u32x2 vc = rowv[q8 + 1][part], vp = rowv[q8][part], vn = rowv[q8 + 2][part];
                  const f32x4 m = part == 0 ? mur : part == 1 ? muk : muv; f32x4 o;
                  o[0] = shift_val(lo_f(vc.x), lo_f(vp.x), lo_f(vn.x), m[0]); o[1] = shift_val(hi_f(vc.x), hi_f(vp.x), hi_f(vn.x), m[1]);
                  o[2] = shift_val(lo_f(vc.y), lo_f(vp.y), lo_f(vn.y), m[2]); o[3] = shift_val(hi_f(vc.y), hi_f(vp.y), hi_f(vn.y), m[3]);
                  if (part == 0) rs = o; else if (part == 1) ks_ = o; else vs = o; }
              const u32x2 aw = *(const LAS u32x2*)(AL + ti * 264 + c4); const f32x4 a = {lo_f(aw.x), hi_f(aw.x), lo_f(aw.y), hi_f(aw.y)};
              f32x4 kk = ks_ * kkw; float nn = kk[0] * kk[0] + kk[1] * kk[1] + kk[2] * kk[2] + kk[3] * kk[3]; nn = row16_sum(nn);
              kk = kk * rsqrtf(fmaxf(nn, 1e-24f));
              const f32x4 kp = ks_ * ((a - 1.f) * kaw + 1.f); const f32x4 bb = kk * a;
              float bon = rs[0] * kp[0] * rkw[0] + rs[1] * kp[1] * rkw[1] + rs[2] * kp[2] * rkw[2] + rs[3] * kp[3] * rkw[3]; bon = row16_sum(bon);
              if ((lane & 15) == 0) C.bonus()[(size_t)tok * 4 + (lane >> 4)] = bon;
              bf16_t* ar = C.act() + (size_t)tok * DM + c4;
              u32x2 w; w.x = pk2(rs[0], rs[1]); w.y = pk2(rs[2], rs[3]); *(u32x2*)(ar) = w;
              w.x = pk2(kp[0], kp[1]); w.y = pk2(kp[2], kp[3]); *(u32x2*)(ar + 256) = w;
              w.x = pk2(vs[0], vs[1]); w.y = pk2(vs[2], vs[3]); *(u32x2*)(ar + 512) = w;
              w.x = pk2(bb[0], bb[1]); w.y = pk2(bb[2], bb[3]); *(u32x2*)(ar + 768) = w;
              w.x = pk2(kk[0], kk[1]); w.y = pk2(kk[2], kk[3]); *(u32x2*)(C.ops(0) + (size_t)tok * 256 + c4) = w; } }
        __syncthreads();
        PSTAMP(45);
    }
}

DI float row8_sum(float x) { x += dpp_mov<0xB1>(x); x += dpp_mov<0x4E>(x); x += dpp_mov<0x141>(x); return x; }
struct QKTok { u32x4 cq, ckv, qn, kn, at; unsigned qr1, qr2, kr1, kr2, rq1, rq2, rk1, rk2; f32x4 rt; };
DI void qk_load(const Ctx& C, int tok, int lane, QKTok& R) {
    const int h = lane >> 3, sub = lane & 7; const int s = tok % SB;
    const bf16_t* pr = C.pbuf() + (size_t)tok * NPC; const bf16_t* qr = C.qkv() + (size_t)tok * QKVC;
    R.cq = (lane < 48) ? *(const u32x4*)(pr + lane * 8) : (u32x4){0u, 0u, 0u, 0u};
    R.ckv = (lane < 32) ? *(const u32x4*)(pr + 384 + lane * 8) : (u32x4){0u, 0u, 0u, 0u};
    R.qn = *(const u32x4*)(qr + h * 96 + sub * 8); R.qr1 = *(const unsigned*)(qr + h * 96 + 64 + 2 * sub); R.qr2 = *(const unsigned*)(qr + h * 96 + 80 + 2 * sub);
    R.kn = *(const u32x4*)(qr + 768 + h * 128 + sub * 8); R.kr1 = *(const unsigned*)(pr + C_KR + 2 * sub); R.kr2 = *(const unsigned*)(pr + C_KR + 16 + 2 * sub);
    R.at = *(const u32x4*)(C.ws + OFF_ROPE + ROPE_AT + ((size_t)((s >= CTXL) ? s - CTXL : 0) * 16 + 2 * sub) * 8);
    const int hh = lane >> 4, i2 = (lane & 15) * 2;
    R.rq1 = *(const unsigned*)(pr + C_RQ + hh * 64 + i2); R.rq2 = *(const unsigned*)(pr + C_RQ + hh * 64 + 32 + i2);
    R.rk1 = *(const unsigned*)(pr + C_RK + hh * 64 + i2); R.rk2 = *(const unsigned*)(pr + C_RK + hh * 64 + 32 + i2);
    R.rt = ((const f32x4*)(C.ws + OFF_ROPE))[(s * 32 + i2) >> 1];
}
DI float ssq4(u32x4 w) { float a = 0.f;
#pragma unroll
    for (int q = 0; q < 4; ++q) a += lo_f(w[q]) * lo_f(w[q]) + hi_f(w[q]) * hi_f(w[q]); return a; }
DI void qk_compute_store(const Ctx& C, int l, int tok, int lane, const QKTok& R, const float (&qgn)[8], const float (&kgn)[8], const float (&qgr)[4], const float (&kgr)[4]) {
    const int h = lane >> 3, sub = lane & 7;
    bf16_t* pr = C.pbuf() + (size_t)tok * NPC; bf16_t* qr = C.qkv() + (size_t)tok * QKVC; bf16_t* kr = C.kf() + (size_t)tok * 768;
    const float QS = 0.10206207261596577f * 1.4426950408889634f;
    const float sq = wave_sum(ssq4(R.cq)), sk = wave_sum(ssq4(R.ckv));
    const float rq = rsqrtf(sq * (1.f / 384.f) + 1e-6f), rk = rsqrtf(sk * (1.f / 256.f) + 1e-6f);
    const bool lat_ = (tok % SB) >= CTXL;
    const float cs0 = lat_ ? __uint_as_float(R.at[0]) : 1.f, sn0 = lat_ ? __uint_as_float(R.at[1]) : 0.f, cs1 = lat_ ? __uint_as_float(R.at[2]) : 1.f, sn1 = lat_ ? __uint_as_float(R.at[3]) : 0.f;
    { float n[8];
#pragma unroll
      for (int q = 0; q < 4; ++q) { n[2 * q] = lo_f(R.qn[q]) * rq; n[2 * q + 1] = hi_f(R.qn[q]) * rq; }
      const float a0 = lo_f(R.qr1) * rq, a1 = hi_f(R.qr1) * rq, b0 = lo_f(R.qr2) * rq, b1 = hi_f(R.qr2) * rq;
      float ss = a0 * a0 + a1 * a1 + b0 * b0 + b1 * b1;
#pragma unroll
      for (int q = 0; q < 8; ++q) ss += n[q] * n[q];
      ss = row8_sum(ss); const float rs = rsqrtf(ss * (1.f / 96.f) + 1e-6f) * QS;
      u32x4 w;
#pragma unroll
      for (int q = 0; q < 4; ++q) w[q] = pk2(n[2 * q] * rs * qgn[2 * q], n[2 * q + 1] * rs * qgn[2 * q + 1]);
      *(u32x4*)(qr + h * 96 + sub * 8) = w;
      const float x0 = a0 * rs * qgr[0], x1 = a1 * rs * qgr[1], y0 = b0 * rs * qgr[2], y1 = b1 * rs * qgr[3];
      *(unsigned*)(qr + h * 96 + 64 + 2 * sub) = pk2(x0 * cs0 - y0 * sn0, x1 * cs1 - y1 * sn1);
      *(unsigned*)(qr + h * 96 + 80 + 2 * sub) = pk2(x0 * sn0 + y0 * cs0, x1 * sn1 + y1 * cs1); }
    { float n[8];
#pragma unroll
      for (int q = 0; q < 4; ++q) { n[2 * q] = lo_f(R.kn[q]) * rk; n[2 * q + 1] = hi_f(R.kn[q]) * rk; }
      const float a0 = lo_f(R.kr1), a1 = hi_f(R.kr1), b0 = lo_f(R.kr2), b1 = hi_f(R.kr2);
      float ss = a0 * a0 + a1 * a1 + b0 * b0 + b1 * b1;
#pragma unroll
      for (int q = 0; q < 8; ++q) ss += n[q] * n[q];
      ss = row8_sum(ss); const float rs = rsqrtf(ss * (1.f / 96.f) + 1e-6f);
      u32x4 w;
#pragma unroll
      for (int q = 0; q < 4; ++q) w[q] = pk2(n[2 * q] * rs * kgn[2 * q], n[2 * q + 1] * rs * kgn[2 * q + 1]);
      *(u32x4*)(kr + h * 96 + sub * 8) = w;
      const float x0 = a0 * rs * kgr[0], x1 = a1 * rs * kgr[1], y0 = b0 * rs * kgr[2], y1 = b1 * rs * kgr[3];
      *(unsigned*)(kr + h * 96 + 64 + 2 * sub) = pk2(x0 * cs0 - y0 * sn0, x1 * cs1 - y1 * sn1);
      *(unsigned*)(kr + h * 96 + 80 + 2 * sub) = pk2(x0 * sn0 + y0 * cs0, x1 * sn1 + y1 * cs1); }
    { const int hh = lane >> 4, i2 = (lane & 15) * 2; const float c0 = R.rt[0], s0 = R.rt[1], c1 = R.rt[2], s1 = R.rt[3];
      { const float x10 = lo_f(R.rq1), x11 = hi_f(R.rq1), x20 = lo_f(R.rq2), x21 = hi_f(R.rq2);
        *(unsigned*)(pr + C_RQ + hh * 64 + i2) = pk2(x10 * c0 - x20 * s0, x11 * c1 - x21 * s1);
        *(unsigned*)(pr + C_RQ + hh * 64 + 32 + i2) = pk2(x10 * s0 + x20 * c0, x11 * s1 + x21 * c1); }
      { const float x10 = lo_f(R.rk1), x11 = hi_f(R.rk1), x20 = lo_f(R.rk2), x21 = hi_f(R.rk2);
        *(unsigned*)(pr + C_RK + hh * 64 + i2) = pk2((x10 * c0 - x20 * s0) * 0.125f, (x11 * c1 - x21 * s1) * 0.125f);
        *(unsigned*)(pr + C_RK + hh * 64 + 32 + i2) = pk2((x10 * s0 + x20 * c0) * 0.125f, (x11 * s1 + x21 * c1) * 0.125f); } }
}
DI void phase_qk_final(const Ctx& C, int l) {
    const int gw = C.bid * 8 + C.wave, GW = C.G * 8, lane = C.lane, sub = lane & 7;
    float qgn[8], kgn[8], qgr[4], kgr[4];
    { const float* qg = C.in[13] + l * 96; const float* kg = C.in[14] + l * 96;
#pragma unroll
      for (int q = 0; q < 8; ++q) { qgn[q] = qg[sub * 8 + q]; kgn[q] = kg[sub * 8 + q]; }
      qgr[0] = qg[64 + 2 * sub]; qgr[1] = qg[65 + 2 * sub]; qgr[2] = qg[80 + 2 * sub]; qgr[3] = qg[81 + 2 * sub];
      kgr[0] = kg[64 + 2 * sub]; kgr[1] = kg[65 + 2 * sub]; kgr[2] = kg[80 + 2 * sub]; kgr[3] = kg[81 + 2 * sub]; }
    QKTok A, B;
    int tok = gw;
    if (tok < T) qk_load(C, tok, lane, A);
    for (; tok < T; tok += 2 * GW) {
        const int tok2 = tok + GW; const bool has2 = tok2 < T;
        if (has2) qk_load(C, tok2, lane, B);
        qk_compute_store(C, l, tok, lane, A, qgn, kgn, qgr, kgr);
        if (tok2 + GW < T) qk_load(C, tok2 + GW, lane, A);
        if (has2) qk_compute_store(C, l, tok2, lane, B, qgn, kgn, qgr, kgr);
    }
}

namespace att {
constexpr int KVBLK = 64; constexpr int SHM_V = 64 * 128 * 2, SHM_K = 64 * 256;
#define KSWZ(row, colB) ((row) * 256 + ((colB) ^ (((row) & 7) << 4)))
#define SBAR() __builtin_amdgcn_sched_barrier(0)
DI int crow(int r, int hi) { return (r & 3) + 8 * (r >> 2) + 4 * hi; }
DI void partialSM(f32x16& p0, f32x16& p1) {
#pragma unroll
    for (int r = 0; r < 16; ++r) p0[r] = __builtin_amdgcn_exp2f(p0[r]);
}
DI void finishSM(f32x16& p0, f32x16& p1, float& l_reg, bf16x8& pa0, bf16x8& pa1, bf16x8& pa2, bf16x8& pa3) {
#pragma unroll
    for (int r = 0; r < 16; ++r) p1[r] = __builtin_amdgcn_exp2f(p1[r]);
    float ps = 0;
#pragma unroll
    for (int r = 0; r < 16; ++r) ps += p0[r];
#pragma unroll
    for (int r = 0; r < 16; ++r) ps += p1[r];
    l_reg += ps;
#define PK4(P, BASE, OUT) do { unsigned a0 = pk2(P[BASE + 0], P[BASE + 1]), a1 = pk2(P[BASE + 2], P[BASE + 3]);   \
    unsigned b0 = pk2(P[BASE + 4], P[BASE + 5]), b1 = pk2(P[BASE + 6], P[BASE + 7]);                              \
    auto r0 = __builtin_amdgcn_permlane32_swap(a0, b0, false, false); auto r1 = __builtin_amdgcn_permlane32_swap(a1, b1, false, false); \
    u32x4 w = {r0[0], r1[0], r0[1], r1[1]}; OUT = __builtin_bit_cast(bf16x8, w); } while (0)
    PK4(p0, 0, pa0); PK4(p0, 8, pa1); PK4(p1, 0, pa2); PK4(p1, 8, pa3);
#undef PK4
}
DI void qkt(f32x16& p0, f32x16& p1, const LAS char* Ks, const bf16x8* qr, int r32, int hi, float negM) {
#pragma unroll
    for (int r = 0; r < 16; ++r) { p0[r] = negM; p1[r] = negM; }
#pragma unroll
    for (int d0 = 0; d0 < 6; ++d0) { const int cb = (d0 * 16 + hi * 8) * 2;
        const bf16x8 b0 = *(const LAS bf16x8*)(Ks + KSWZ(r32, cb));
        const bf16x8 b1 = *(const LAS bf16x8*)(Ks + KSWZ(32 + r32, cb));
        p0 = __builtin_amdgcn_mfma_f32_32x32x16_bf16(b0, qr[d0], p0, 0, 0, 0);
        p1 = __builtin_amdgcn_mfma_f32_32x32x16_bf16(b1, qr[d0], p1, 0, 0, 0); }
}
DI int v_st(int k, int c) { const int kk = (k & ~0xC) | ((k & 4) << 1) | ((k & 8) >> 1); return ((kk >> 3) * 4 + (c >> 5)) * 512 + ((kk & 7) * 32 + (c & 31)) * 2; }
DI int v_rd_base(int lane) { return ((lane & 3) << 3) | (((lane >> 2) & 3) << 6) | (((lane >> 4) & 1) << 5) | (((lane >> 5) & 1) << 8); }
constexpr int v_rd_off(int d0, int ks, int half) { return d0 * 512 + ks * 4096 + half * 2048; }
template <int OFF> DI s16x4 tr_read(int vb) { s16x4 r; asm volatile("ds_read_b64_tr_b16 %0, %1 offset:%2" : "=&v"(r) : "v"(vb), "i"(OFF) : "memory"); return r; }
template <int D0> DI void pv_one(f32x16& od, int vb, bf16x8 pa0, bf16x8 pa1, bf16x8 pa2, bf16x8 pa3) {
    const s16x4 l0 = tr_read<v_rd_off(D0, 0, 0)>(vb), h0 = tr_read<v_rd_off(D0, 0, 1)>(vb), l1 = tr_read<v_rd_off(D0, 1, 0)>(vb), h1 = tr_read<v_rd_off(D0, 1, 1)>(vb);
    const s16x4 l2 = tr_read<v_rd_off(D0, 2, 0)>(vb), h2 = tr_read<v_rd_off(D0, 2, 1)>(vb), l3 = tr_read<v_rd_off(D0, 3, 0)>(vb), h3 = tr_read<v_rd_off(D0, 3, 1)>(vb);
    asm volatile("s_waitcnt lgkmcnt(0)" ::: "memory"); SBAR();
#define PKV(L, H) (bf16x8){L[0], L[1], L[2], L[3], H[0], H[1], H[2], H[3]}
    od = __builtin_amdgcn_mfma_f32_32x32x16_bf16(pa0, PKV(l0, h0), od, 0, 0, 0);
    od = __builtin_amdgcn_mfma_f32_32x32x16_bf16(pa1, PKV(l1, h1), od, 0, 0, 0);
    od = __builtin_amdgcn_mfma_f32_32x32x16_bf16(pa2, PKV(l2, h2), od, 0, 0, 0);
    od = __builtin_amdgcn_mfma_f32_32x32x16_bf16(pa3, PKV(l3, h3), od, 0, 0, 0);
#undef PKV
}
constexpr int LDQ = QKVC, LDK = 768, LDV = QKVC, LDO = NPC;
DI void attn_body(const bf16_t* __restrict__ Qb, const bf16_t* __restrict__ Kh, const bf16_t* __restrict__ Vh, bf16_t* __restrict__ Ob, int seq, LAS char* lds, const int tid, const float negM) {
    const int wid = tid >> 6, lane = tid & 63, r32 = lane & 31, hi = lane >> 5;
    LAS char* V_lds = lds; LAS char* K_lds = lds + 2 * SHM_V;
    LAS float* wsl = (LAS float*)(lds + 2 * SHM_V + 2 * SHM_K) + wid * 64; LAS float* li_l = wsl;
    float l_reg = 0; f32x16 o[2]; bf16x8 qr[6];
#pragma unroll
    for (int d = 0; d < 2; ++d)
#pragma unroll
        for (int r = 0; r < 16; ++r) o[d][r] = 0.f;
    const bf16_t* Qw = Qb + (size_t)(wid * 32 + r32) * LDQ + hi * 8;
#pragma unroll
    for (int d0 = 0; d0 < 6; ++d0) qr[d0] = *(const bf16x8*)(Qw + d0 * 16);
    const int kc1 = tid, kc2 = 512 + (tid & 255);
    const int kr1 = kc1 / 12, kq1 = kc1 % 12, kr2 = kc2 / 12, kq2 = kc2 % 12;
    const int vr = tid >> 3, vq = (tid & 7) * 8, vst = v_st(vr, vq);
    const int vb0 = (int)(uintptr_t)V_lds + v_rd_base(lane);
    struct { bf16x8 k1, k2, v; } sr_[2];
#define SLOAD(i, k0) do { sr_[i].k1 = *(const bf16x8*)(Kh + (size_t)((k0) + kr1) * LDK + kq1 * 8); sr_[i].k2 = *(const bf16x8*)(Kh + (size_t)((k0) + kr2) * LDK + kq2 * 8); \
    sr_[i].v = *(const bf16x8*)(Vh + (size_t)((k0) + vr) * LDV + vq); } while (0)
#define SWRITE(b, i) do { *(LAS bf16x8*)(V_lds + (b) * SHM_V + vst) = sr_[i].v; \
    *(LAS bf16x8*)(K_lds + (b) * SHM_K + KSWZ(kr1, kq1 * 16)) = sr_[i].k1; *(LAS bf16x8*)(K_lds + (b) * SHM_K + KSWZ(kr2, kq2 * 16)) = sr_[i].k2; } while (0)
#define SWAIT() asm volatile("s_waitcnt vmcnt(3)" ::: "memory")
    f32x16 pA0, pA1, pB0, pB1; bf16x8 pa0, pa1, pa2, pa3; const int NT = seq / KVBLK;
    constexpr int SE = 0, SO = 1;
    SLOAD(SE, 0); asm volatile("s_waitcnt vmcnt(0)" ::: "memory"); SWRITE(0, SE); __syncthreads();
    qkt(pA0, pA1, K_lds, qr, r32, hi, negM); partialSM(pA0, pA1);
    SLOAD(SO, KVBLK); if (2 < NT) SLOAD(SE, 2 * KVBLK);
    SWAIT(); SWRITE(1, SO); __syncthreads();
    for (int j = 1; j + 1 < NT; j += 2) {
        SBAR(); qkt(pB0, pB1, K_lds + SHM_K, qr, r32, hi, negM);
        finishSM(pA0, pA1, l_reg, pa0, pa1, pa2, pa3); SBAR();
        SLOAD(SO, (j + 2) * KVBLK); SBAR();
        pv_one<0>(o[0], vb0, pa0, pa1, pa2, pa3); pv_one<1>(o[1], vb0, pa0, pa1, pa2, pa3); partialSM(pB0, pB1);
        __syncthreads(); SWAIT(); SWRITE(0, SE);
        __syncthreads();
        SBAR(); qkt(pA0, pA1, K_lds, qr, r32, hi, negM);
        finishSM(pB0, pB1, l_reg, pa0, pa1, pa2, pa3); SBAR();
        if (j + 3 < NT) SLOAD(SE, (j + 3) * KVBLK); else SLOAD(SE, 0); SBAR();
        pv_one<0>(o[0], vb0 + SHM_V, pa0, pa1, pa2, pa3); pv_one<1>(o[1], vb0 + SHM_V, pa0, pa1, pa2, pa3); partialSM(pA0, pA1);
        __syncthreads(); SWAIT(); SWRITE(1, SO);
        __syncthreads();
    }
    SBAR(); qkt(pB0, pB1, K_lds + SHM_K, qr, r32, hi, negM);
    finishSM(pA0, pA1, l_reg, pa0, pa1, pa2, pa3); SBAR();
    pv_one<0>(o[0], vb0, pa0, pa1, pa2, pa3); pv_one<1>(o[1], vb0, pa0, pa1, pa2, pa3); partialSM(pB0, pB1);
    __syncthreads();
    finishSM(pB0, pB1, l_reg, pa0, pa1, pa2, pa3); SBAR();
    pv_one<0>(o[0], vb0 + SHM_V, pa0, pa1, pa2, pa3); pv_one<1>(o[1], vb0 + SHM_V, pa0, pa1, pa2, pa3);
    { auto rr = __builtin_amdgcn_permlane32_swap(__float_as_uint(l_reg), __float_as_uint(l_reg), false, false); l_reg = __uint_as_float(rr[0]) + __uint_as_float(rr[1]); }
    if (hi == 0) li_l[r32] = l_reg; asm volatile("s_waitcnt lgkmcnt(0)" ::: "memory");
    float rli[16];
#pragma unroll
    for (int r = 0; r < 16; ++r) rli[r] = __builtin_amdgcn_rcpf(li_l[crow(r, hi)]);
    bf16_t* Ow = Ob + (size_t)(wid * 32) * LDO;
#pragma unroll
    for (int r = 0; r < 16; ++r) { const int orow = crow(r, hi);
#pragma unroll
        for (int d0 = 0; d0 < 2; ++d0) Ow[(size_t)orow * LDO + d0 * 32 + r32] = f2bf(o[d0][r] * rli[r]); }
    asm volatile("s_waitcnt vmcnt(0)" ::: "memory");
    __syncthreads();
#undef SLOAD
#undef SWRITE
#undef SWAIT
}
}

DI int scan_tok(int base, int dir, int n) { return base + (dir == 0 ? n : (n < CTXL ? (CTXL - 1 - n) : (SB + CTXL - 1 - n))); }
DI void cvt8(const bf16x8 v, float (&f)[8]) {
    const u32x4 w = __builtin_bit_cast(u32x4, v);
    f[0] = lo_f(w.x); f[1] = hi_f(w.x); f[2] = lo_f(w.y); f[3] = hi_f(w.y); f[4] = lo_f(w.z); f[5] = hi_f(w.z); f[6] = lo_f(w.w); f[7] = hi_f(w.w);
}
DI float row16_sum1(float x) {
    asm("s_nop 1\n\t"
        "v_add_f32_dpp %0, %0, %0 quad_perm:[1,0,3,2] row_mask:0xf bank_mask:0xf bound_ctrl:1\n\t"
        "s_nop 1\n\t"
        "v_add_f32_dpp %0, %0, %0 quad_perm:[2,3,0,1] row_mask:0xf bank_mask:0xf bound_ctrl:1\n\t"
        "s_nop 1\n\t"
        "v_add_f32_dpp %0, %0, %0 row_half_mirror row_mask:0xf bank_mask:0xf bound_ctrl:1\n\t"
        "s_nop 1\n\t"
        "v_add_f32_dpp %0, %0, %0 row_mirror row_mask:0xf bank_mask:0xf bound_ctrl:1\n\t"
        "s_nop 0"
        : "+v"(x));
    return x;
}
DI void row16_sum4(float& a, float& b, float& c, float& d) {
#define R4_(MODE) "v_add_f32_dpp %0, %0, %0 " MODE " row_mask:0xf bank_mask:0xf bound_ctrl:1\n\t" "v_add_f32_dpp %1, %1, %1 " MODE " row_mask:0xf bank_mask:0xf bound_ctrl:1\n\t" \
                  "v_add_f32_dpp %2, %2, %2 " MODE " row_mask:0xf bank_mask:0xf bound_ctrl:1\n\t" "v_add_f32_dpp %3, %3, %3 " MODE " row_mask:0xf bank_mask:0xf bound_ctrl:1\n\t"
    asm("s_nop 1\n\t" R4_("quad_perm:[1,0,3,2]") R4_("quad_perm:[2,3,0,1]") R4_("row_half_mirror") R4_("row_mirror") "s_nop 0" : "+v"(a), "+v"(b), "+v"(c), "+v"(d));
#undef R4_
}
DI void rwkv_scan_item(const Ctx& C, int b, int h, int dir, int half) {
    constexpr int TC = 32, ARR = TC * 64;
    LAS float* buf = (LAS float*)C.lds;
    LAS float* yL = (LAS float*)(C.lds + 2 * 6 * ARR * 4);
    const int tid = C.tid, i0 = tid >> 4, cgp = tid & 15;
    const int base = b * SB;
    const bf16_t* ACT = C.act(); const bf16_t* O0 = C.ops(0); const bf16_t* OW = C.ops(1 + dir);
    bf16_t* ydst = C.pbuf() + (dir ? C_YB : C_YF) + h * 64 + half * 32;
    f32x2 S01 = {0.f, 0.f}, S23 = {0.f, 0.f};
    const int sidx = tid & 255, sti = sidx >> 3, spart = sidx & 7, styp = tid >> 8;
    bf16x8 la, lb, lc, ld; la = lb = lc = ld = (bf16x8){0, 0, 0, 0, 0, 0, 0, 0};
#define RW_LOAD(c) do { const int tk = scan_tok(base, dir, (c) * TC + sti); const bf16_t* ar = ACT + (size_t)tk * DM + h * 64 + spart * 8; \
        la = *(const bf16x8*)(ar + (styp ? 256 : 0)); \
        lb = styp ? *(const bf16x8*)(OW + (size_t)tk * 256 + h * 64 + spart * 8) : *(const bf16x8*)(ar + 512); \
        if (styp == 0) { lc = *(const bf16x8*)(O0 + (size_t)tk * 256 + h * 64 + spart * 8); ld = *(const bf16x8*)(ar + 768); } } while (0)
#define RW_WRITE(nb) do { LAS float* B = buf + (nb) * 6 * ARR; float f[8]; const int o = sti * 64 + spart * 8; \
        cvt8(la, f); { LAS float* d = B + (styp ? 3 : 4) * ARR + o; *(LAS f32x4*)d = (f32x4){f[0], f[1], f[2], f[3]}; *(LAS f32x4*)(d + 4) = (f32x4){f[4], f[5], f[6], f[7]}; } \
        cvt8(lb, f); if (styp) { LAS float* d = B + 1 * ARR + o; *(LAS f32x4*)d = (f32x4){1.f - f[0], 1.f - f[1], 1.f - f[2], 1.f - f[3]}; *(LAS f32x4*)(d + 4) = (f32x4){1.f - f[4], 1.f - f[5], 1.f - f[6], 1.f - f[7]}; } \
        else { LAS float* d = B + 5 * ARR + o; *(LAS f32x4*)d = (f32x4){f[0], f[1], f[2], f[3]}; *(LAS f32x4*)(d + 4) = (f32x4){f[4], f[5], f[6], f[7]}; } \
        if (styp == 0) { cvt8(lc, f); { LAS float* d = B + 0 * ARR + o; *(LAS f32x4*)d = (f32x4){f[0], f[1], f[2], f[3]}; *(LAS f32x4*)(d + 4) = (f32x4){f[4], f[5], f[6], f[7]}; } \
            cvt8(ld, f); { LAS float* d = B + 2 * ARR + o; *(LAS f32x4*)d = (f32x4){f[0], f[1], f[2], f[3]}; *(LAS f32x4*)(d + 4) = (f32x4){f[4], f[5], f[6], f[7]}; } } } while (0)
    constexpr int NCH = SB / TC;
    RW_LOAD(0); RW_WRITE(0); __syncthreads();
    for (int c = 0; c < NCH; ++c) {
        const int cur = c & 1;
        if (c + 1 < NCH) RW_LOAD(c + 1);
        const LAS float* B = buf + cur * 6 * ARR;
        const LAS float* Bq = B + cgp * 4; const LAS float* Bv = B + 5 * ARR + half * 32 + i0;
        float yk = 0.f;
#define RW_FETCH(P, t) const f32x4 P##kk = *(const LAS f32x4*)(Bq + (t) * 64), P##w = *(const LAS f32x4*)(Bq + ARR + (t) * 64), P##b = *(const LAS f32x4*)(Bq + 2 * ARR + (t) * 64), \
            P##k = *(const LAS f32x4*)(Bq + 3 * ARR + (t) * 64), P##r = *(const LAS f32x4*)(Bq + 4 * ARR + (t) * 64); const float P##v = Bv[(t) * 64]
#define RW_STEP(P, YP) do { const f32x2 kk01 = {P##kk[0], P##kk[1]}, kk23 = {P##kk[2], P##kk[3]}, w01 = {P##w[0], P##w[1]}, w23 = {P##w[2], P##w[3]}, b01 = {P##b[0], P##b[1]}, b23 = {P##b[2], P##b[3]}, \
                k01 = {P##k[0], P##k[1]}, k23 = {P##k[2], P##k[3]}, r01 = {P##r[0], P##r[1]}, r23 = {P##r[2], P##r[3]}; \
            const f32x2 d2 = S01 * kk01 + S23 * kk23; const float d = row16_sum1(d2.x + d2.y); \
            S01 = S01 * w01 + (k01 * P##v - b01 * d); S23 = S23 * w23 + (k23 * P##v - b23 * d); \
            const f32x2 y2 = S01 * r01 + S23 * r23; YP = y2.x + y2.y; } while (0)
#pragma unroll 1
        for (int g = 0; g < TC / 16; ++g) {
#pragma unroll 1
            for (int tt = 0; tt < 16; tt += 4) { const int t = g * 16 + tt;
                float y0, y1, y2_, y3;
                RW_FETCH(a_, t); RW_FETCH(b_, t + 1);
                __builtin_amdgcn_sched_barrier(0);
                RW_STEP(a_, y0);
                RW_FETCH(c_, t + 2);
                __builtin_amdgcn_sched_barrier(0);
                RW_STEP(b_, y1);
                RW_FETCH(d_, t + 3);
                __builtin_amdgcn_sched_barrier(0);
                RW_STEP(c_, y2_);
                __builtin_amdgcn_sched_barrier(0);
                RW_STEP(d_, y3);
                row16_sum4(y0, y1, y2_, y3);
                const int q = cgp - tt; yk = (q == 0) ? y0 : (q == 1) ? y1 : (q == 2) ? y2_ : (q == 3) ? y3 : yk; }
            yL[(g * 16 + cgp) * 32 + i0] = yk;
        }
#undef RW_FETCH
#undef RW_STEP
        __syncthreads();
        { const int ti = tid >> 4, c2 = (tid & 15) * 2; const f32x2 y = *(const LAS f32x2*)(yL + ti * 32 + c2);
          const int tk = scan_tok(base, dir, c * TC + ti);
          *(unsigned*)(ydst + (size_t)tk * NPC + c2) = pk2(y[0], y[1]); }
        if (c + 1 < NCH) RW_WRITE(cur ^ 1);
        __syncthreads();
    }
#undef RW_LOAD
#undef RW_WRITE
}

namespace rk {
constexpr int RAW_BYTES = 64 * 6 * 64 * 2;
constexpr int SL_KK = 0, SL_R = 2304, SL_K = 4608, SL_B = 6912, SL_KT = 9216, SL_BT = 11776, SL_VT = 14336, SL_P16 = 16896, SL_ABF = 17152,
              SL_T = 18304, SL_AK = 18944, SL_GK = 19584, SL_GB = 20224, SLOT = 20992;
typedef short s16x4v __attribute__((ext_vector_type(4)));
DI s16x4v pack4(const f32x4 v) { u32x2 w; w.x = pk2(v[0], v[1]); w.y = pk2(v[2], v[3]); return __builtin_bit_cast(s16x4v, w); }
DI f32x4 mm16(const s16x4v a, const s16x4v b, const f32x4 c) { return __builtin_amdgcn_mfma_f32_16x16x16bf16_1k(a, b, c, 0, 0, 0); }
DI void prep(LAS unsigned char* lds, int q, int lane) {
    const LAS bf16_t* raw = (const LAS bf16_t*)lds + (size_t)(16 * q) * 384;
    LAS unsigned char* sl = lds + RAW_BYTES + q * SLOT;
    LAS bf16_t* KKs = (LAS bf16_t*)(sl + SL_KK); LAS bf16_t* Rs = (LAS bf16_t*)(sl + SL_R); LAS bf16_t* Ks = (LAS bf16_t*)(sl + SL_K); LAS bf16_t* Bs = (LAS bf16_t*)(sl + SL_B);
    LAS bf16_t* KT = (LAS bf16_t*)(sl + SL_KT); LAS bf16_t* BT = (LAS bf16_t*)(sl + SL_BT); LAS bf16_t* VT = (LAS bf16_t*)(sl + SL_VT);
    LAS float* P16 = (LAS float*)(sl + SL_P16); LAS float* Abf = (LAS float*)(sl + SL_ABF);
    LAS bf16_t* Tb = (LAS bf16_t*)(sl + SL_T); LAS bf16_t* AKb = (LAS bf16_t*)(sl + SL_AK); LAS bf16_t* GKb = (LAS bf16_t*)(sl + SL_GK); LAS bf16_t* GBb = (LAS bf16_t*)(sl + SL_GB);
    float P = 1.f;
#pragma unroll
    for (int t4 = 0; t4 < 4; ++t4) { unsigned kq[4], bq[4], vq[4];
#pragma unroll
        for (int tj = 0; tj < 4; ++tj) { const int t = t4 * 4 + tj; const LAS bf16_t* rt = raw + t * 384 + lane;
            const float wv = 1.f - bf2f(rt[5 * 64]); const float Pp = P; P *= wv; const float ip = __builtin_amdgcn_rcpf(P);
            const float kkv = bf2f(rt[4 * 64]) * Pp, rv = bf2f(rt[0]) * P, kv = bf2f(rt[64]) * ip, bv = bf2f(rt[3 * 64]) * ip;
            const bf16_t kb = f2bf(kv), bbv = f2bf(bv);
            KKs[t * 72 + lane] = f2bf(kkv); Rs[t * 72 + lane] = f2bf(rv); Ks[t * 72 + lane] = kb; Bs[t * 72 + lane] = bbv;
            kq[tj] = kb; bq[tj] = f2bf(-bv); vq[tj] = rt[2 * 64]; }
        u32x2 w; w.x = kq[0] | (kq[1] << 16); w.y = kq[2] | (kq[3] << 16); *(LAS u32x2*)(KT + lane * 20 + t4 * 4) = w;
        w.x = bq[0] | (bq[1] << 16); w.y = bq[2] | (bq[3] << 16); *(LAS u32x2*)(BT + lane * 20 + t4 * 4) = w;
        w.x = vq[0] | (vq[1] << 16); w.y = vq[2] | (vq[3] << 16); *(LAS u32x2*)(VT + lane * 20 + t4 * 4) = w; }
    P16[lane] = P;
    asm volatile("s_waitcnt lgkmcnt(0)" ::: "memory"); __builtin_amdgcn_wave_barrier();
    const int r_ = lane & 15, g = lane >> 4;
    f32x4 ab = {0.f, 0.f, 0.f, 0.f}, ak = ab, gk = ab, gb = ab;
#pragma unroll
    for (int ks = 0; ks < 2; ++ks) { const int o = r_ * 72 + ks * 32 + 8 * g;
        const bf16x8 akk = *(const LAS bf16x8*)(KKs + o), ar = *(const LAS bf16x8*)(Rs + o), bk = *(const LAS bf16x8*)(Ks + o), bbf = *(const LAS bf16x8*)(Bs + o);
        ab = __builtin_amdgcn_mfma_f32_16x16x32_bf16(akk, bbf, ab, 0, 0, 0); ak = __builtin_amdgcn_mfma_f32_16x16x32_bf16(akk, bk, ak, 0, 0, 0);
        gk = __builtin_amdgcn_mfma_f32_16x16x32_bf16(ar, bk, gk, 0, 0, 0); gb = __builtin_amdgcn_mfma_f32_16x16x32_bf16(ar, bbf, gb, 0, 0, 0); }
#pragma unroll
    for (int rg = 0; rg < 4; ++rg) { const int t = 4 * g + rg, s_ = r_;
        Abf[t * 17 + s_] = (s_ < t) ? ab[rg] : 0.f;
        AKb[t * 20 + s_] = f2bf((s_ < t) ? ak[rg] : 0.f); GKb[t * 20 + s_] = f2bf((s_ <= t) ? gk[rg] : 0.f); GBb[t * 20 + s_] = f2bf((s_ <= t) ? -gb[rg] : 0.f); }
    asm volatile("s_waitcnt lgkmcnt(0)" ::: "memory"); __builtin_amdgcn_wave_barrier();
    float Tc[16];
#pragma unroll
    for (int t = 0; t < 16; ++t) { float a = (t == r_) ? 1.f : 0.f;
#pragma unroll
        for (int s_ = 0; s_ < t; ++s_) a -= Abf[t * 17 + s_] * Tc[s_];
        Tc[t] = a; }
    if (g == 0) {
#pragma unroll
        for (int t = 0; t < 16; ++t) Tb[t * 20 + r_] = f2bf(Tc[t]); }
}
DI void crit(LAS unsigned char* lds, int q, int vt, int lane, f32x4 (&ST)[4], bf16_t* ydst, int base, int dir, int n0) {
    LAS unsigned char* sl = lds + RAW_BYTES + q * SLOT;
    const LAS bf16_t* KKs = (const LAS bf16_t*)(sl + SL_KK); const LAS bf16_t* Rs = (const LAS bf16_t*)(sl + SL_R);
    const LAS bf16_t* KT = (const LAS bf16_t*)(sl + SL_KT); const LAS bf16_t* BT = (const LAS bf16_t*)(sl + SL_BT); const LAS bf16_t* VT = (const LAS bf16_t*)(sl + SL_VT);
    const LAS float* P16 = (const LAS float*)(sl + SL_P16);
    const LAS bf16_t* Tb = (const LAS bf16_t*)(sl + SL_T); const LAS bf16_t* AKb = (const LAS bf16_t*)(sl + SL_AK); const LAS bf16_t* GKb = (const LAS bf16_t*)(sl + SL_GK); const LAS bf16_t* GBb = (const LAS bf16_t*)(sl + SL_GB);
    const int r_ = lane & 15, g = lane >> 4; const f32x4 zero = {0.f, 0.f, 0.f, 0.f};
    const s16x4v vf = *(const LAS s16x4v*)(VT + (16 * vt + r_) * 20 + 4 * g);
    s16x4v ps[4];
#pragma unroll
    for (int kt = 0; kt < 4; ++kt) ps[kt] = pack4(ST[kt]);
    f32x4 x1 = mm16(*(const LAS s16x4v*)(AKb + r_ * 20 + 4 * g), vf, zero);
#pragma unroll
    for (int kt = 0; kt < 4; ++kt) x1 = mm16(*(const LAS s16x4v*)(KKs + r_ * 72 + 16 * kt + 4 * g), ps[kt], x1);
    const f32x4 u = mm16(*(const LAS s16x4v*)(Tb + r_ * 20 + 4 * g), pack4(x1), zero);
    const s16x4v pu = pack4(u);
    f32x4 y = mm16(*(const LAS s16x4v*)(GKb + r_ * 20 + 4 * g), vf, zero);
#pragma unroll
    for (int kt = 0; kt < 4; ++kt) y = mm16(*(const LAS s16x4v*)(Rs + r_ * 72 + 16 * kt + 4 * g), ps[kt], y);
    y = mm16(*(const LAS s16x4v*)(GBb + r_ * 20 + 4 * g), pu, y);
#pragma unroll
    for (int kt = 0; kt < 4; ++kt) { f32x4 a = mm16(*(const LAS s16x4v*)(KT + (16 * kt + r_) * 20 + 4 * g), vf, ST[kt]);
        a = mm16(*(const LAS s16x4v*)(BT + (16 * kt + r_) * 20 + 4 * g), pu, a);
        ST[kt] = a * *(const LAS f32x4*)(P16 + 16 * kt + 4 * g); }
#pragma unroll
    for (int rg = 0; rg < 4; ++rg) { const int tk = scan_tok(base, dir, n0 + 4 * g + rg); ydst[(size_t)tk * NPC + 16 * vt + r_] = f2bf(y[rg]); }
}
}
DI void rwkv_chunk_item(const Ctx& C, int b, int h, int dir) {
    LAS unsigned char* lds = C.lds; const int tid = C.tid, lane = C.lane, wave = C.wave;
    const int base = b * SB; const int tl = tid >> 3, part = tid & 7;
    const bf16_t* ACT = C.act() + h * 64 + part * 8; const bf16_t* O0 = C.ops(0) + h * 64 + part * 8; const bf16_t* OW = C.ops(1 + dir) + h * 64 + part * 8;
    bf16_t* ydst = C.pbuf() + (dir ? C_YB : C_YF) + h * 64;
    f32x4 ST[4];
#pragma unroll
    for (int kt = 0; kt < 4; ++kt) ST[kt] = (f32x4){0.f, 0.f, 0.f, 0.f};
    u32x4 RA[6], RB[6];
#define RK_LD(R, bt) do { const int tk = scan_tok(base, dir, (bt) * 64 + tl); const bf16_t* ar = ACT + (size_t)tk * DM; \
        R[0] = *(const u32x4*)(ar); R[1] = *(const u32x4*)(ar + 256); R[2] = *(const u32x4*)(ar + 512); R[3] = *(const u32x4*)(ar + 768); \
        R[4] = *(const u32x4*)(O0 + (size_t)tk * 256); R[5] = *(const u32x4*)(OW + (size_t)tk * 256); } while (0)
#define RK_WR(R) do { LAS unsigned char* d_ = lds + (tl * 6) * 128 + part * 16; _Pragma("unroll") for (int a_ = 0; a_ < 6; ++a_) *(LAS u32x4*)(d_ + a_ * 128) = R[a_]; } while (0)
    RK_LD(RA, 0); RK_WR(RA); __syncthreads();
    RK_LD(RA, 1); RK_LD(RB, 2);
    for (int i = 0; i < 68; i += 2) {
        if (wave < 4) rk::prep(lds, wave, lane);
        __syncthreads();
        RK_WR(RA); if (i + 3 < 68) RK_LD(RA, i + 3);
        if (wave < 4) {
#pragma unroll 1
            for (int q = 0; q < 4; ++q) rk::crit(lds, q, wave, lane, ST, ydst, base, dir, i * 64 + q * 16); }
        __syncthreads();
        if (wave < 4) rk::prep(lds, wave, lane);
        __syncthreads();
        if (i + 2 < 68) RK_WR(RB); if (i + 4 < 68) RK_LD(RB, i + 4);
        if (wave < 4) {
#pragma unroll 1
            for (int q = 0; q < 4; ++q) rk::crit(lds, q, wave, lane, ST, ydst, base, dir, (i + 1) * 64 + q * 16); }
        __syncthreads();
    }
#undef RK_LD
#undef RK_WR
}

DI f32x4 mma16(const LAS bf16_t* A, int lda, const LAS bf16_t* Bm, int ldb, int ksteps, int lane, f32x4 acc) {
    for (int ks = 0; ks < ksteps; ++ks) {
        const bf16x8 a = *(const LAS bf16x8*)(A + (lane & 15) * lda + ks * 32 + 8 * (lane >> 4));
        const bf16x8 b = *(const LAS bf16x8*)(Bm + (lane & 15) * ldb + ks * 32 + 8 * (lane >> 4));
        acc = __builtin_amdgcn_mfma_f32_16x16x32_bf16(a, b, acc, 0, 0, 0); }
    return acc;
}
DI void retention_item(const Ctx& C, int l, int b, int h, int dir) {
    constexpr int LQ = 72, LT = 136;
    LAS bf16_t* Qs = (LAS bf16_t*)C.lds;
    LAS bf16_t* Ks = Qs + 128 * LQ;
    LAS bf16_t* Kzt = Ks + 128 * LQ;
    LAS bf16_t* Vt = Kzt + 64 * LT;
    LAS bf16_t* At = Vt + 64 * LT;
    LAS bf16_t* rT = At + 128 * LT;
    const int tid = C.tid, lane = C.lane, wave = C.wave; const int base = b * SB;
    const float x = C.in[15][(l * 2 + dir) * 4 + h];
    const float lg2 = -log1pf(__expf(-x)) * 1.4426950408889634f;
    const float gchunk = exp2f(lg2 * 128.f);
    const float zeta_c = exp2f(lg2 * (float)(127 - (tid >> 2)));
    float dmc[8][4], xic[4];
#pragma unroll
    for (int nt = 0; nt < 8; ++nt)
#pragma unroll
        for (int r = 0; r < 4; ++r) { const int i = wave * 16 + 4 * (lane >> 4) + r, j = nt * 16 + (lane & 15); dmc[nt][r] = (i >= j) ? exp2f(lg2 * (float)(i - j)) : 0.f; }
#pragma unroll
    for (int r = 0; r < 4; ++r) xic[r] = exp2f(lg2 * (float)(wave * 16 + 4 * (lane >> 4) + r + 1));
    bf16_t* Pp = C.pbuf(); bf16_t* odst = Pp + (dir ? C_OB : C_OF) + h * 64;
    f32x4 rst[2] = {{0.f, 0.f, 0.f, 0.f}, {0.f, 0.f, 0.f, 0.f}};
    for (int i = tid; i < 64 * LQ; i += NTHR) rT[i] = 0;
    const int si = tid >> 2, sp = tid & 3;
    bf16x8 gq[2], gk[2], gv[2];
#define RT_LOAD(c) do { const int tk = scan_tok(base, dir, (c) * 128 + si); const bf16_t* pr = Pp + (size_t)tk * NPC + h * 64 + sp * 16; \
        gq[0] = *(const bf16x8*)(pr + C_RQ); gq[1] = *(const bf16x8*)(pr + C_RQ + 8); gk[0] = *(const bf16x8*)(pr + C_RK); gk[1] = *(const bf16x8*)(pr + C_RK + 8); \
        gv[0] = *(const bf16x8*)(pr + C_RV); gv[1] = *(const bf16x8*)(pr + C_RV + 8); } while (0)
    RT_LOAD(0);
    __syncthreads();
    for (int c = 0; c < 34; ++c) {
        { *(LAS bf16x8*)(Qs + si * LQ + sp * 16) = gq[0]; *(LAS bf16x8*)(Qs + si * LQ + sp * 16 + 8) = gq[1];
          *(LAS bf16x8*)(Ks + si * LQ + sp * 16) = gk[0]; *(LAS bf16x8*)(Ks + si * LQ + sp * 16 + 8) = gk[1];
          const float zeta = zeta_c;
#pragma unroll
          for (int hh = 0; hh < 2; ++hh) { float f[8]; cvt8(gk[hh], f);
#pragma unroll
              for (int j = 0; j < 8; ++j) Kzt[(sp * 16 + hh * 8 + j) * LT + si] = f2bf(f[j] * zeta);
#pragma unroll
              for (int j = 0; j < 8; ++j) Vt[(sp * 16 + hh * 8 + j) * LT + si] = (bf16_t)gv[hh][j]; } }
        __syncthreads();
        if (c + 1 < 34) RT_LOAD(c + 1);
        { const LAS bf16_t* Aq = Qs + (wave * 16) * LQ;
#pragma unroll
          for (int nt = 0; nt < 8; ++nt) { f32x4 acc = {0.f, 0.f, 0.f, 0.f}; acc = mma16(Aq, LQ, Ks + (nt * 16) * LQ, LQ, 2, lane, acc);
              const int j = nt * 16 + (lane & 15);
#pragma unroll
              for (int r = 0; r < 4; ++r) { const int i = wave * 16 + 4 * (lane >> 4) + r; const float dm = dmc[nt][r];
                  At[i * LT + j] = f2bf(acc[r] * dm); } } }
        asm volatile("s_waitcnt lgkmcnt(0)" ::: "memory");
        __builtin_amdgcn_wave_barrier();
        { const LAS bf16_t* Aa = At + (wave * 16) * LT; const LAS bf16_t* Aq = Qs + (wave * 16) * LQ;
#pragma unroll
          for (int nt = 0; nt < 4; ++nt) { f32x4 a1 = {0.f, 0.f, 0.f, 0.f}, a2 = {0.f, 0.f, 0.f, 0.f};
              a1 = mma16(Aa, LT, Vt + (nt * 16) * LT, LT, 4, lane, a1);
              a2 = mma16(Aq, LQ, rT + (nt * 16) * LQ, LQ, 2, lane, a2);
              const int dv = nt * 16 + (lane & 15);
#pragma unroll
              for (int r = 0; r < 4; ++r) { const int i = wave * 16 + 4 * (lane >> 4) + r; const float xi = xic[r];
                  const int tk = scan_tok(base, dir, c * 128 + i);
                  odst[(size_t)tk * NPC + dv] = f2bf(a1[r] + a2[r] * xi); } } }
        __syncthreads();
        { const int mt = wave >> 1;
#pragma unroll
          for (int i2 = 0; i2 < 2; ++i2) { const int nt = 2 * (wave & 1) + i2; f32x4 acc = {0.f, 0.f, 0.f, 0.f};
              acc = mma16(Kzt + (mt * 16) * LT, LT, Vt + (nt * 16) * LT, LT, 4, lane, acc);
              rst[i2] = rst[i2] * gchunk + acc;
              const int dv = nt * 16 + (lane & 15), dk0 = mt * 16 + 4 * (lane >> 4);
              u32x2 w; w.x = pk2(rst[i2][0], rst[i2][1]); w.y = pk2(rst[i2][2], rst[i2][3]);
              *(LAS u32x2*)(rT + dv * LQ + dk0) = w; } }
        __syncthreads();
    }
#undef RT_LOAD
}

DI void phase_mixers(const Ctx& C0, int l) {
    LAS int* slot = (LAS int*)(C0.lds + LDS_BYTES - 16);
    const int n_att = (l == 0) ? 1024 + 64 : 1024;
    const int total = 128 + n_att + WX_NGU / 8;
#ifdef DIAG_ITEMS
    int nit = 0;
#endif
    float gqm = 0.f, gkm = 0.f;
    for (int i = 0; i < 96; ++i) { gqm = fmaxf(gqm, fabsf(C0.in[13][l * 96 + i])); gkm = fmaxf(gkm, fabsf(C0.in[14][l * 96 + i])); }
    const float negM = -(96.f * 0.10206207261596577f * 1.4426950408889634f) * gqm * gkm;
    bool first = true;
    for (;;) {
        __syncthreads();
        if (C0.tid == 0) *slot = (first && C0.bid < 128) ? C0.bid : 128 + atomicAdd(C0.cnt() + l, 1);
        first = false;
        __syncthreads();
        const int it = *slot;
#ifdef DIAG_ITEMS
        if (l == 0 && C0.bid == DIAG_BLK && C0.tid == 0 && nit < 6) ((unsigned long long*)(C0.ws + OFF_CNT + 4096))[32 + nit] = __builtin_amdgcn_s_memrealtime();
        ++nit;
#endif
        if (it >= total) break;
        Ctx C2 = C0; asm volatile("" : "+v"(C2.tid)); C2.lane = C2.tid & 63; C2.wave = __builtin_amdgcn_readfirstlane(C2.tid >> 6); const Ctx& C = C2;
        if (it < 64) rwkv_chunk_item(C, it >> 3, (it >> 1) & 3, it & 1);
        else if (it < 128) { const int r = it - 64; retention_item(C, l, r >> 3, (r >> 1) & 3, r & 1); }
        else if (it >= 128 + n_att) wconv_range(C, l, (it - 128 - n_att) * 8, 8);
        else {
            int a = it - 128; int b, h, q0, seq;
            if (a < 1024) { b = a >> 7; h = (a >> 4) & 7; q0 = CTXL + (a & 15) * 256; seq = SB; }
            else { a -= 1024; b = a >> 3; h = a & 7; q0 = 0; seq = CTXL; }
            const size_t tb = (size_t)b * SB;
            att::attn_body(C.qkv() + (tb + q0) * QKVC + h * 96, C.kf() + tb * 768 + h * 96, C.qkv() + tb * QKVC + 768 + h * 128 + 64,
                           C.pbuf() + (tb + q0) * NPC + h * 64, seq, (LAS char*)C.lds, C.tid, negM);
        }
    }
}

struct FinTok { u32x2 of, ob, gg, yf, yb, vv, gt; float bon; };
DI void fin_load(const Ctx& C, int tok, int lane, FinTok& R) {
    const int c4 = lane * 4; const bf16_t* pr = C.pbuf() + (size_t)tok * NPC; const bf16_t* ar = C.act() + (size_t)tok * DM;
    R.of = *(const u32x2*)(pr + C_OF + c4); R.ob = *(const u32x2*)(pr + C_OB + c4); R.gg = *(const u32x2*)(pr + C_RG + c4);
    R.yf = *(const u32x2*)(pr + C_YF + c4); R.yb = *(const u32x2*)(pr + C_YB + c4);
    R.vv = *(const u32x2*)(ar + 512 + c4); R.gt = *(const u32x2*)(C.ops(3) + (size_t)tok * 256 + c4);
    R.bon = C.bonus()[(size_t)tok * 4 + (lane >> 4)];
}
DI void fin_store(const Ctx& C, int tok, int lane, const FinTok& R, const f32x4 gnw, const f32x4 lnw) {
    const int c4 = lane * 4;
    const u32x2 of = R.of, ob = R.ob, gg = R.gg, yf = R.yf, yb = R.yb, vv = R.vv, gt = R.gt; const float bon = R.bon;
    f32x4 o = {lo_f(of.x) + lo_f(ob.x), hi_f(of.x) + hi_f(ob.x), lo_f(of.y) + lo_f(ob.y), hi_f(of.y) + hi_f(ob.y)};
    float mu = row16_sum(o[0] + o[1] + o[2] + o[3]) * (1.f / 64.f);
    f32x4 d = o - mu; float var = row16_sum(d[0] * d[0] + d[1] * d[1] + d[2] * d[2] + d[3] * d[3]) * (1.f / 64.f);
    float eps1 = 1e-5f, eps2 = 64e-5f; asm volatile("" : "+v"(eps1), "+v"(eps2));
    float rs = rsqrtf(var + eps1);
    const f32x4 g = {lo_f(gg.x), hi_f(gg.x), lo_f(gg.y), hi_f(gg.y)};
    f32x4 r1; r1[0] = d[0] * rs * gnw[0] * siluf_(g[0]); r1[1] = d[1] * rs * gnw[1] * siluf_(g[1]); r1[2] = d[2] * rs * gnw[2] * siluf_(g[2]); r1[3] = d[3] * rs * gnw[3] * siluf_(g[3]);
    f32x4 y = {lo_f(yf.x) + lo_f(yb.x), hi_f(yf.x) + hi_f(yb.x), lo_f(yf.y) + lo_f(yb.y), hi_f(yf.y) + hi_f(yb.y)};
    mu = row16_sum(y[0] + y[1] + y[2] + y[3]) * (1.f / 64.f);
    d = y - mu; var = row16_sum(d[0] * d[0] + d[1] * d[1] + d[2] * d[2] + d[3] * d[3]) * (1.f / 64.f);
    rs = rsqrtf(var + eps2);
    const f32x4 v = {lo_f(vv.x), hi_f(vv.x), lo_f(vv.y), hi_f(vv.y)}, gate = {lo_f(gt.x), hi_f(gt.x), lo_f(gt.y), hi_f(gt.y)};
    const f32x4 r2 = (d * rs * lnw + v * bon) * gate;
    bf16_t* pw = C.pbuf() + (size_t)tok * NPC;
    u32x2 w; w.x = pk2(r1[0], r1[1]); w.y = pk2(r1[2], r1[3]); *(u32x2*)(pw + 512 + c4) = w;
    w.x = pk2(r2[0], r2[1]); w.y = pk2(r2[2], r2[3]); *(u32x2*)(pw + 768 + c4) = w;
}
DI void phase_finish(const Ctx& C, int l) {
    const int gw = C.bid * 8 + C.wave, GW = C.G * 8, lane = C.lane, c4 = lane * 4;
    const f32x4 gnw = *(const f32x4*)(C.in[16] + l * 256 + c4), lnw = *(const f32x4*)(C.in[26] + l * 256 + c4);
    const int NT_ = (l == 1) ? NBATCH * SEQ : T;
#define FN_TOK(i_) (((l == 1) ? ((i_) / SEQ) * SB + CTXL + ((i_) % SEQ) : (i_)))
    FinTok A, B, NA, NB;
    if (gw < NT_) { fin_load(C, FN_TOK(gw), lane, A); const int i2 = gw + GW; fin_load(C, FN_TOK(i2 < NT_ ? i2 : gw), lane, B); }
    for (int i = gw; i < NT_; i += 2 * GW) {
        const int i2 = i + GW; const bool has2 = i2 < NT_; const int j = i + 2 * GW; const bool hasn = j < NT_;
        if (hasn) { fin_load(C, FN_TOK(j), lane, NA); const int j2 = j + GW; fin_load(C, FN_TOK(j2 < NT_ ? j2 : j), lane, NB); }
        fin_store(C, FN_TOK(i), lane, A, gnw, lnw);
        if (has2) fin_store(C, FN_TOK(i2), lane, B, gnw, lnw);
        if (hasn) { A = NA; B = NB; }
    }
#undef FN_TOK
}

DI float wave_sum2(float v) { v = row16_sum(v); v += __shfl_xor(v, 16); v += __shfl_xor(v, 32); return v; }
DI float row16_max(float x) { x = fmaxf(x, dpp_mov<0xB1>(x)); x = fmaxf(x, dpp_mov<0x4E>(x)); x = fmaxf(x, dpp_mov<0x141>(x)); x = fmaxf(x, dpp_mov<0x140>(x)); return x; }
DI void router_token(const Ctx& C, int l, int tok, int lane, const float (&v)[16], const LAS float* rw, const float* nw) {
    const int b = tok / SB, s = tok - b * SB; const float* modrow = C.modv(l) + (size_t)((s < CTXL) ? 8 : b) * 6144;
    float ss = 0.f;
#pragma unroll
    for (int m = 0; m < 16; ++m) ss += v[m] * v[m];
    ss = wave_sum2(ss); const float rstd = rsqrtf(ss * (1.f / 1024.f) + 1e-6f);
    float lg[16];
#pragma unroll
    for (int e = 0; e < 16; ++e) lg[e] = 0.f;
    bf16_t* dst = C.act() + (size_t)tok * DM;
#pragma unroll
    for (int m = 0; m < 16; ++m) { const int c = m * 64 + lane;
        const float hv = v[m] * rstd * nw[c] * (modrow[4096 + c] + 1.f) + modrow[3072 + c];
        dst[c] = f2bf(hv);
        const LAS float* rr = rw + c * 20;
        const f32x4 r0 = *(const LAS f32x4*)rr, r1 = *(const LAS f32x4*)(rr + 4), r2 = *(const LAS f32x4*)(rr + 8), r3 = *(const LAS f32x4*)(rr + 12);
        lg[0] += hv * r0[0]; lg[1] += hv * r0[1]; lg[2] += hv * r0[2]; lg[3] += hv * r0[3];
        lg[4] += hv * r1[0]; lg[5] += hv * r1[1]; lg[6] += hv * r1[2]; lg[7] += hv * r1[3];
        lg[8] += hv * r2[0]; lg[9] += hv * r2[1]; lg[10] += hv * r2[2]; lg[11] += hv * r2[3];
        lg[12] += hv * r3[0]; lg[13] += hv * r3[1]; lg[14] += hv * r3[2]; lg[15] += hv * r3[3]; }
    float sel = 0.f; const int li = lane & 15;
#pragma unroll
    for (int e = 0; e < 16; ++e) { const float r = row16_sum(lg[e]); sel = (li == e) ? r : sel; }
    sel += __shfl_xor(sel, 16); sel += __shfl_xor(sel, 32);
    const float mx = row16_max(sel); const float ex = __expf(sel - mx); const float den = row16_sum(ex);
    if (lane < 16) { const float a = ex / den;
        if (s < CTXL) ((float*)(C.ws + OFF_AFFC))[(size_t)(b * 16 + lane) * CTXL + s] = a;
        else ((float*)(C.ws + OFF_AFFL))[(size_t)(b * 16 + lane) * SEQ + (s - CTXL)] = a; }
}
DI void phase_h_router(const Ctx& C, int l, const float* lat, const float* ctxp) {
    LAS float* rw = (LAS float*)C.lds;
    { const float* src = C.in[28] + (size_t)l * 16384; for (int i = C.tid; i < 4096; i += NTHR) *(LAS f32x4*)(rw + (i >> 2) * 20 + (i & 3) * 4) = *(const f32x4*)(src + i * 4); }
    __syncthreads();
    const int gw = C.bid * 8 + C.wave, GW = C.G * 8, lane = C.lane;
    const float* nw = C.in[7] + l * 1024;
    const int NT_ = (l == 1) ? NBATCH * SEQ : T;
#define RT_TOK(i_) (((l == 1) ? ((i_) / SEQ) * SB + CTXL + ((i_) % SEQ) : (i_)))
    float va[16], vb[16];
    if (gw < NT_) { const int tokA = RT_TOK(gw); const int i2 = gw + GW; const int tokB = (i2 < NT_) ? RT_TOK(i2) : tokA;
        const float* xa = tok_row(lat, ctxp, tokA); const float* xb = tok_row(lat, ctxp, tokB);
#pragma unroll
        for (int m = 0; m < 16; ++m) { va[m] = xa[m * 64 + lane]; vb[m] = xb[m * 64 + lane]; } }
    for (int i = gw; i < NT_; i += 2 * GW) {
        const int i2 = i + GW; const bool has2 = i2 < NT_;
        const int tokA = RT_TOK(i); const int tokB = has2 ? RT_TOK(i2) : tokA;
        float na[16], nb[16]; const int j = i + 2 * GW; const bool hasn = j < NT_;
        if (hasn) { const int tA = RT_TOK(j); const int j2 = j + GW; const int tB = (j2 < NT_) ? RT_TOK(j2) : tA;
            const float* xa = tok_row(lat, ctxp, tA); const float* xb = tok_row(lat, ctxp, tB);
#pragma unroll
            for (int m = 0; m < 16; ++m) { na[m] = xa[m * 64 + lane]; nb[m] = xb[m * 64 + lane]; } }
        router_token(C, l, tokA, lane, va, rw, nw);
        if (has2) router_token(C, l, tokB, lane, vb, rw, nw);
        if (hasn) {
#pragma unroll
            for (int m = 0; m < 16; ++m) { va[m] = na[m]; vb[m] = nb[m]; } }
    }
#undef RT_TOK
}

DI void select_item(const Ctx& C, const float* aff, int n, int cap, int rowbase, int tokbase, int* inv  ) {
    LAS unsigned* keys = (LAS unsigned*)C.lds;
    LAS int* cnt = (LAS int*)(C.lds + 16384);
    LAS int* wsum = cnt + 64;
    const int tid = C.tid; const int m = (n + NTHR - 1) / NTHR;
    for (int i = tid; i < n; i += NTHR) keys[i] = __float_as_uint(aff[i]);
    __syncthreads();
    unsigned prefix = 0u; int krem = cap;
    LAS int* hist = cnt + 128;
    LAS int* selw = cnt + 96;
#pragma unroll 1
    for (int pass = 0; pass < 4; ++pass) { const int shift = 24 - 8 * pass;
        if (tid < 256) hist[tid] = 0;
        __syncthreads();
        for (int i = tid; i < n; i += NTHR) { const unsigned k = keys[i];
            if (pass == 0 || (k >> (shift + 8)) == (prefix >> (shift + 8))) __hip_atomic_fetch_add(&hist[(k >> shift) & 255u], 1, __ATOMIC_RELAXED, __HIP_MEMORY_SCOPE_WORKGROUP); }
        __syncthreads();
        if (C.wave == 0) { const int l4 = C.lane * 4; const int h0 = hist[l4], h1 = hist[l4 + 1], h2 = hist[l4 + 2], h3 = hist[l4 + 3]; const int s4 = h0 + h1 + h2 + h3;
            int incl = s4;
            for (int o = 1; o < 64; o <<= 1) { const int v = __shfl_down(incl, o); if (C.lane + o < 64) incl += v; }
            const int above = incl - s4;
            if (above < krem && incl >= krem) { int d = 3, a = above;
                if (a + h3 >= krem) d = 3; else { a += h3; if (a + h2 >= krem) d = 2; else { a += h2; if (a + h1 >= krem) d = 1; else { a += h1; d = 0; } } }
                selw[0] = l4 + d; selw[1] = krem - a; } }
        __syncthreads();
        prefix |= (unsigned)selw[0] << shift; krem = selw[1];
        __syncthreads();
    }
    const unsigned thr = prefix;
    int gtc = 0, eqc = 0;
    for (int q = 0; q < m; ++q) { const int i = tid * m + q; if (i < n) { const unsigned k = keys[i]; gtc += (k > thr); eqc += (k == thr); } }
    int g = gtc, e = eqc;
    for (int o = 1; o < 64; o <<= 1) { const int g2 = __shfl_up(g, o), e2 = __shfl_up(e, o); if (C.lane >= o) { g += g2; e += e2; } }
    if (C.lane == 63) { wsum[C.wave] = g; wsum[8 + C.wave] = e; }
    __syncthreads();
    int gb = 0, eb = 0, gtot = 0;
    for (int w = 0; w < 8; ++w) { if (w < C.wave) { gb += wsum[w]; eb += wsum[8 + w]; } gtot += wsum[w]; }
    int gpre = gb + g - gtc, epre = eb + e - eqc;
    const int need_eq = cap - gtot;
    int* idx = (int*)(C.ws + OFF_IDX); float* gate = (float*)(C.ws + OFF_GATE);
    for (int q = 0; q < m; ++q) { const int i = tid * m + q; if (i < n) { const unsigned k = keys[i];
        const bool sel = (k > thr) || (k == thr && epre < need_eq);
        const int sl = gpre + (epre < need_eq ? epre : need_eq);
        if (sel) { idx[rowbase + sl] = tokbase + i; gate[rowbase + sl] = __uint_as_float(k); }
        inv[(size_t)i * 16] = sel ? (rowbase + sl) : -1;
        gpre += (k > thr); epre += (k == thr); } }
    asm volatile("s_waitcnt vmcnt(0)" ::: "memory");
    __syncthreads();
    __syncthreads();
}
DI void phase_select(const Ctx& C, int l) {
    const int nitems = (l == 0) ? 256 : 128;
    for (int it = C.bid; it < nitems; it += C.G) {
        if (it < 128) { const int b = it >> 4, e = it & 15;
            select_item(C, (const float*)(C.ws + OFF_AFFL) + (size_t)(b * 16 + e) * SEQ, SEQ, CAPL, e * 4096 + b * 512, b * SB + CTXL, (int*)(C.ws + OFF_INVL) + (size_t)b * SEQ * 16 + e); }
        else { const int a = it - 128, b = a >> 4, e = a & 15;
            select_item(C, (const float*)(C.ws + OFF_AFFC) + (size_t)(b * 16 + e) * CTXL, CTXL, CAPC, XE_LROWS + e * 256 + b * 32, b * SB, (int*)(C.ws + OFF_INVC) + (size_t)b * CTXL * 16 + e); }
    }
#ifdef DIAG_TS
    if (l == 0 && C.bid == DIAG_BLK && C.tid == 0) ((unsigned long long*)(C.ws + OFF_CNT + 4096))[40] = __builtin_amdgcn_s_memrealtime();
#endif
    { Ctx C2 = C; asm volatile("" : "+v"(C2.tid)); C2.lane = C2.tid & 63; C2.wave = __builtin_amdgcn_readfirstlane(C2.tid >> 6); phase_wconv_experts(C2, l); }
}

struct CombTok { f32x4 x[4]; u32x2 y[4][4]; int myinv; int r[4]; unsigned long long rest; };
DI const int* comb_inv_ptr(const Ctx& C, int tok) { const int b = tok / SB, s = tok - b * SB;
    return (s < CTXL) ? (const int*)(C.ws + OFF_INVC) + (size_t)(b * CTXL + s) * 16 : (const int*)(C.ws + OFF_INVL) + (size_t)(b * SEQ + s - CTXL) * 16; }
DI void comb_issue_ye(const Ctx& C, int lane, CombTok& R) {
    const bf16_t* ye = (const bf16_t*)(C.ws + OFF_ARENA + AR_XE);
    unsigned long long msk = __ballot(R.myinv >= 0) & 0xffffull;
#pragma unroll
    for (int k = 0; k < 4; ++k) { R.r[k] = -1; if (msk) { const int e = __builtin_ctzll(msk); msk &= msk - 1; R.r[k] = __builtin_amdgcn_readlane(R.myinv, e); } }
    R.rest = msk;
#pragma unroll
    for (int k = 0; k < 4; ++k) if (R.r[k] >= 0) { const bf16_t* yr = ye + (size_t)R.r[k] * DM + lane * 4;
#pragma unroll
        for (int j = 0; j < 4; ++j) R.y[k][j] = *(const u32x2*)(yr + j * 256); }
}
DI void comb_finish(const Ctx& C, int l, int tok, int lane, float* lat, float* ctxp, const CombTok& R) {
    const bf16_t* ye = (const bf16_t*)(C.ws + OFF_ARENA + AR_XE);
    const int b = tok / SB, s = tok - b * SB;
    float* xr = (s < CTXL) ? ctxp + (size_t)(b * CTXL + s) * DM : lat + (size_t)(b * SEQ + s - CTXL) * DM;
    const float* modrow = C.modv(l) + (size_t)((s < CTXL) ? 8 : b) * 6144;
    f32x4 acc[4];
#pragma unroll
    for (int j = 0; j < 4; ++j) acc[j] = (f32x4){0.f, 0.f, 0.f, 0.f};
#pragma unroll
    for (int k = 0; k < 4; ++k) if (R.r[k] >= 0) {
#pragma unroll
        for (int j = 0; j < 4; ++j) { const u32x2 w = R.y[k][j]; acc[j][0] += lo_f(w.x); acc[j][1] += hi_f(w.x); acc[j][2] += lo_f(w.y); acc[j][3] += hi_f(w.y); } }
    unsigned long long msk = R.rest;
    while (msk) { const int e = __builtin_ctzll(msk); msk &= msk - 1; const int r = __builtin_amdgcn_readlane(R.myinv, e); const bf16_t* yr = ye + (size_t)r * DM + lane * 4;
#pragma unroll
        for (int j = 0; j < 4; ++j) { const u32x2 w = *(const u32x2*)(yr + j * 256); acc[j][0] += lo_f(w.x); acc[j][1] += hi_f(w.x); acc[j][2] += lo_f(w.y); acc[j][3] += hi_f(w.y); } }
    f32x4 v[4];
#pragma unroll
    for (int j = 0; j < 4; ++j) { const int c = j * 256 + lane * 4; const f32x4 ga = *(const f32x4*)(modrow + 5120 + c);
        v[j] = R.x[j] + ga * acc[j]; *(f32x4*)(xr + c) = v[j]; }
    if (l == 0) norm_mod_store(v, C.in[6] + 1024, C.modv(1) + (size_t)((s < CTXL) ? 8 : b) * 6144, 0, 1024, C.act() + (size_t)tok * DM, lane);
}
DI void phase_combine(const Ctx& C, int l, float* lat, float* ctxp) {
    const int gw = C.bid * 8 + C.wave, GW = C.G * 8, lane = C.lane;
    const int NT_ = (l == 1) ? NBATCH * SEQ : T;
#define CB_TOK(i_) (((l == 1) ? ((i_) / SEQ) * SB + CTXL + ((i_) % SEQ) : (i_)))
#define CB_LOAD(A_, B_, i_) do { const int tA_ = CB_TOK(i_); const int i2_ = (i_) + GW; const int tB_ = (i2_ < NT_) ? CB_TOK(i2_) : tA_; \
        A_.myinv = comb_inv_ptr(C, tA_)[lane & 15]; B_.myinv = comb_inv_ptr(C, tB_)[lane & 15]; \
        const float* xa_ = tok_row(lat, ctxp, tA_); const float* xb_ = tok_row(lat, ctxp, tB_); \
        _Pragma("unroll") for (int j_ = 0; j_ < 4; ++j_) { A_.x[j_] = *(const f32x4*)(xa_ + j_ * 256 + lane * 4); B_.x[j_] = *(const f32x4*)(xb_ + j_ * 256 + lane * 4); } } while (0)
    CombTok A, B;
    if (gw < NT_) CB_LOAD(A, B, gw);
    for (int i = gw; i < NT_; i += 2 * GW) {
        const int i2 = i + GW; const bool has2 = i2 < NT_;
        const int tokA = CB_TOK(i); const int tokB = has2 ? CB_TOK(i2) : tokA;
        comb_issue_ye(C, lane, A); comb_issue_ye(C, lane, B);
        int nIa = 0, nIb = 0; f32x4 nxa[4], nxb[4]; const int j = i + 2 * GW; const bool hasn = j < NT_;
        if (hasn) { const int tA_ = CB_TOK(j); const int j2 = j + GW; const int tB_ = (j2 < NT_) ? CB_TOK(j2) : tA_;
            nIa = comb_inv_ptr(C, tA_)[lane & 15]; nIb = comb_inv_ptr(C, tB_)[lane & 15];
            const float* xa_ = tok_row(lat, ctxp, tA_); const float* xb_ = tok_row(lat, ctxp, tB_);
#pragma unroll
            for (int q = 0; q < 4; ++q) { nxa[q] = *(const f32x4*)(xa_ + q * 256 + lane * 4); nxb[q] = *(const f32x4*)(xb_ + q * 256 + lane * 4); } }
        comb_finish(C, l, tokA, lane, lat, ctxp, A);
        if (has2) comb_finish(C, l, tokB, lane, lat, ctxp, B);
        if (hasn) { A.myinv = nIa; B.myinv = nIb;
#pragma unroll
            for (int q = 0; q < 4; ++q) { A.x[q] = nxa[q]; B.x[q] = nxb[q]; } }
    }
#undef CB_TOK
#undef CB_LOAD
}

#ifdef DIAG
DI void diag_scan(const Ctx& C, int code, const void* ptr, size_t bytes, bool isbf) {
    const u32x4* p = (const u32x4*)ptr; const size_t n = bytes / 16; bool bad = false;
    for (size_t i = (size_t)C.bid * NTHR + C.tid; i < n; i += (size_t)C.G * NTHR) { const u32x4 v = p[i];
#pragma unroll
        for (int q = 0; q < 4; ++q) { const unsigned w = v[q];
            if (isbf) { const unsigned a = w & 0x7fffu, b = (w >> 16) & 0x7fffu; bad |= (a >= 0x5000u) || (b >= 0x5000u); }
            else bad |= ((w & 0x7fffffffu) >= 0x50000000u); } }
    if (__any(bad) && C.lane == 0) atomicAdd((int*)(C.ws + OFF_CNT) + 64 + code, 1);
}
DI void diag_maxexp(const Ctx& C, int code, const void* ptr, size_t bytes) {
    const u32x4* p = (const u32x4*)ptr; const size_t n = bytes / 16; unsigned mx = 0; int nb = 0;
    for (size_t i = (size_t)C.bid * NTHR + C.tid; i < n; i += (size_t)C.G * NTHR) { const u32x4 v = p[i]; unsigned m = 0;
#pragma unroll
        for (int q = 0; q < 4; ++q) { const unsigned w = v[q]; const unsigned a = (w >> 7) & 0xffu, b = (w >> 23) & 0xffu; m = m > a ? m : a; m = m > b ? m : b; }
        mx = mx > m ? mx : m; nb += (m >= 160u); }
    atomicMax((int*)(C.ws + OFF_CNT) + 64 + code, (int)mx); if (nb) atomicAdd((int*)(C.ws + OFF_CNT) + 64 + code + 1, nb);
}
DI void diag_out(const Ctx& C) {
    const int* cnts = (const int*)(C.ws + OFF_CNT) + 64; int first = -1;
    for (int i = 0; i < 40; ++i) { const int v = __hip_atomic_load(cnts + i, __ATOMIC_RELAXED, __HIP_MEMORY_SCOPE_AGENT); if (v != 0 && first < 0) first = i; }
#ifdef DIAG_VAL
    const float K = 1000.f * (1.f + (float)__hip_atomic_load(cnts + DIAG_VAL, __ATOMIC_RELAXED, __HIP_MEMORY_SCOPE_AGENT));
#elif defined(DIAG_SEL)
    int mask = 0; for (int i = 0; i < 4; ++i) if (__hip_atomic_load(cnts + DIAG_SEL + i, __ATOMIC_RELAXED, __HIP_MEMORY_SCOPE_AGENT) != 0) mask |= 1 << i;
    const float K = 1000.f * (float)(1 + mask);
#else
    const float K = (first < 0) ? 1000.f : 1000.f * exp2f((float)(first + 1));
#endif
    const size_t n = (size_t)NBATCH * SEQ * DM / 4;
    for (size_t i = (size_t)C.bid * NTHR + C.tid; i < n; i += (size_t)C.G * NTHR) { const f32x4 v = ((const f32x4*)C.in[0])[i]; ((f32x4*)C.out)[i] = v * K; }
}
#define DSCAN(code, ptr, bytes, isbf) diag_scan(C, code, ptr, bytes, isbf)
#else
#define DSCAN(code, ptr, bytes, isbf) do {} while (0)
#endif

#ifdef PHASE_TEST
#define MKCTX() extern __shared__ __attribute__((aligned(16))) unsigned char smem[]; Ctx C; C.in = prm.in; C.out = prm.out; C.ws = prm.ws; C.G = gridDim.x; C.bid = blockIdx.x; C.tid = threadIdx.x; \
    C.wave = __builtin_amdgcn_readfirstlane(threadIdx.x >> 6); C.lane = threadIdx.x & 63; C.lds = (LAS unsigned char*)smem;
__global__ void __launch_bounds__(NTHR, 2) t_mod(Params prm) { MKCTX(); phase_mod(C); }
__global__ void __launch_bounds__(NTHR, 2) t_wconv(Params prm) { MKCTX(); phase_wconv_small(C); phase_wconv_experts(C, 1); }
__global__ void __launch_bounds__(NTHR, 2) t_u(Params prm) { MKCTX(); phase_u(C, 0, C.in[0], C.in[2]); }
__global__ void __launch_bounds__(NTHR, 2) t_gemm_bf(Params prm) { MKCTX(); pg8::Gemm g{C.act(), C.wsm(0, WSM_WIN), DM, DM, DM, nullptr}; pg8::Sched S; S.init(T / 256, NPC / 256, C.G, C.bid, 0); pg8::EpiBf16 E{C.pbuf(), NPC}; pg8::gemm_phase(C.lds, g, S, E, C.tid); }
__global__ void __launch_bounds__(NTHR, 2) t_gemm_res(Params prm) { MKCTX(); pg8::Gemm g{C.act(), C.wsm(0, WSM_WOUT), DM, DM, DM, nullptr}; pg8::Sched S; S.init(128, 4, C.G, C.bid, 1); pg8::EpiResid E{C.in[0], C.in[2], C.out, C.xc(), C.modv(0)}; pg8::gemm_phase(C.lds, g, S, E, C.tid); }
__global__ void __launch_bounds__(NTHR, 2) t_gemm_sw(Params prm) { MKCTX(); pg8::Gemm g{C.act(), C.wsm(0, WSM_WOUT), DM, DM, DM, nullptr}; pg8::Sched S; S.init(272, 8, C.G, C.bid, 2); pg8::EpiSwiglu E{C.pbuf(), DM}; pg8::gemm_phase(C.lds, g, S, E, C.tid); }
__global__ void __launch_bounds__(NTHR, 2) t_gemm_gate(Params prm) { MKCTX(); pg8::Gemm g{C.act(), C.wsm(0, WSM_WOUT), DM, DM, DM, nullptr}; pg8::Sched S; S.init(272, 4, C.G, C.bid, 2); pg8::EpiGate E{C.pbuf(), DM, (const float*)(C.ws + OFF_GATE)}; pg8::gemm_phase(C.lds, g, S, E, C.tid); }
__global__ void __launch_bounds__(NTHR, 2) t_rwkv_prep(Params prm) { MKCTX(); phase_rwkv_prep(C, 0); }
__global__ void __launch_bounds__(NTHR, 2) t_ret_prep(Params prm) { MKCTX(); phase_ret_prep(C); }
__global__ void __launch_bounds__(NTHR, 2) t_qk(Params prm) { MKCTX(); phase_qk_final(C, 0); }
__global__ void __launch_bounds__(NTHR, 2) t_attn(Params prm) { MKCTX(); att::attn_body(C.qkv(), C.kf(), C.qkv(), C.pbuf(), SB, (LAS char*)C.lds, C.tid, -16.f); }
__global__ void __launch_bounds__(NTHR, 2) t_rwkv(Params prm) { MKCTX(); rwkv_scan_item(C, 0, 1, C.bid & 1, 0); }
__global__ void __launch_bounds__(NTHR, 2) t_rwkvc(Params prm) { MKCTX(); rwkv_chunk_item(C, 0, 1, C.bid & 1); }
__global__ void __launch_bounds__(NTHR, 2) t_ret(Params prm) { MKCTX(); retention_item(C, 0, 0, 1, C.bid & 1); }
__global__ void __launch_bounds__(NTHR, 2) t_finish(Params prm) { MKCTX(); phase_finish(C, 0); }
__global__ void __launch_bounds__(NTHR, 2) t_router(Params prm) { MKCTX(); phase_h_router(C, 0, C.out, C.xc()); }
__global__ void __launch_bounds__(NTHR, 2) t_select(Params prm) { MKCTX(); phase_select(C, 0); }
__global__ void __launch_bounds__(NTHR, 2) t_combine(Params prm) { MKCTX(); phase_combine(C, 0, C.out, C.xc()); }
#endif

__global__ void __launch_bounds__(NTHR, 2) hybrid_fwd(Params prm) {
    extern __shared__ __attribute__((aligned(16))) unsigned char smem[];
    cg::grid_group grid = cg::this_grid();
    Ctx C; C.in = prm.in; C.out = prm.out; C.ws = prm.ws; C.G = gridDim.x; C.bid = blockIdx.x; C.tid = threadIdx.x;
    C.wave = __builtin_amdgcn_readfirstlane(threadIdx.x >> 6); C.lane = threadIdx.x & 63; C.lds = (LAS unsigned char*)smem;
#define CG_SYNC() do { asm volatile("s_waitcnt vmcnt(0) lgkmcnt(0)" ::: "memory"); __syncthreads(); grid.sync(); asm volatile("s_waitcnt vmcnt(0)" ::: "memory"); __syncthreads(); PH(); } while (0)
#ifdef DIAG_TS
#define TSTAMP() do { if (blockIdx.x == 0 && threadIdx.x == 0) { ((unsigned long long*)(C.ws + OFF_CNT + 4096))[ts_n] = __builtin_amdgcn_s_memrealtime(); } ++ts_n; } while (0)
#else
#define TSTAMP() do {} while (0)
#endif
#define GRID_SYNC() do { XcdBarrier xb_; xb_.bar = (unsigned*)(C.ws + OFF_BAR); xb_.x = xb_xcc_id(); xb_.st = (volatile LAS unsigned*)(smem + LDS_BYTES - 32); xcd_barrier(xb_); TSTAMP(); PH(); } while (0)
#define PH() do { asm volatile("" : "+v"(C.tid)); C.lane = C.tid & 63; C.wave = __builtin_amdgcn_readfirstlane(C.tid >> 6); } while (0)
    { volatile LAS unsigned* st = (volatile LAS unsigned*)(smem + LDS_BYTES - 32); if (threadIdx.x == 0) { st[0] = 0u; st[1] = 0u; } __syncthreads(); }
    (void)xcd_barrier_post((unsigned*)(C.ws + OFF_BAR), (volatile LAS unsigned*)(smem + LDS_BYTES - 32));
    int ts_n = 0; TSTAMP();
#ifdef DIAG_TS
    if (C.tid == 0) atomicMax(((unsigned long long*)(C.ws + OFF_CNT + 4096)) + 54, (unsigned long long)__builtin_amdgcn_s_memrealtime());
#endif
    PH();
    phase_p0(C);
#ifdef DIAG_TS
    if (C.bid == DIAG_BLK && C.tid == 0) ((unsigned long long*)(C.ws + OFF_CNT + 4096))[50] = __builtin_amdgcn_s_memrealtime();
#endif
    PH();
    phase_rope_tables(C);
#ifdef DIAG_TS
    if (C.bid == DIAG_BLK && C.tid == 0) ((unsigned long long*)(C.ws + OFF_CNT + 4096))[51] = __builtin_amdgcn_s_memrealtime();
#endif
    if (prm.pad != 0) { CG_SYNC(); }
    GRID_SYNC();
    DSCAN(0, C.ws + OFF_MOD, 2 * 9 * 6144 * 4, false); DSCAN(1, C.ws + OFF_WSM, 2 * WSM_STRIDE, true);
#pragma unroll 1
    for (int l = 0; l < 2; ++l) {
#define xl_in ((l == 0) ? C.in[0] : C.out)
#define xc_in ((l == 0) ? C.in[2] : C.xc())
        if (l == 0) { phase_u(C, 0, xl_in, xc_in); GRID_SYNC(); }
        DSCAN(2 + l * 16 + 0, C.act(), (size_t)T * DM * 2, true);
        { pg8::Gemm g{C.act(), C.wsm(l, WSM_WIN), DM, DM, DM, nullptr}; pg8::Sched S; S.init(T / 256, NPC / 256, C.G, C.bid, 0);
          pg8::EpiBf16 E{C.pbuf(), NPC}; pg8::gemm_phase(C.lds, g, S, E, C.tid); }
        GRID_SYNC();
        DSCAN(2 + l * 16 + 1, C.pbuf(), (size_t)T * NPC * 2, true);
        { pg8::Gemm g{C.pbuf(), C.wsm(l, WSM_WQKV), NPC, 640, 384, nullptr}; pg8::Sched S; S.init(T / 256, 3, C.G, C.bid, 0);
          pg8::EpiBf16 E{C.qkv(), QKVC}; pg8::gemm_phase(C.lds, g, S, E, C.tid); }
        PH();
        { pg8::Gemm g{C.pbuf() + 384, C.wsm(l, WSM_WQKV) + (size_t)768 * 640 + 384, NPC, 640, 256, nullptr}; pg8::Sched S;
          S.init(T / 256, 4, C.G, (C.G == 256) ? ((C.bid + 104) & 255) : C.bid, 0);
          pg8::EpiBf16 E{C.qkv() + 768, QKVC}; pg8::gemm_phase(C.lds, g, S, E, C.tid); }
#ifdef DIAG_TS
        if (l == 0 && C.bid == DIAG_BLK && C.tid == 0) ((unsigned long long*)(C.ws + OFF_CNT + 4096))[41] = __builtin_amdgcn_s_memrealtime();
#endif
        PH();
        phase_rwkv_prep(C, l);
        GRID_SYNC();
        DSCAN(2 + l * 16 + 2, C.qkv(), (size_t)T * QKVC * 2, true); DSCAN(2 + l * 16 + 3, C.ops(0), 4 * OPS_STRIDE, true); if (l == 0) { DSCAN(40, C.ops(0), OPS_STRIDE, true); DSCAN(41, C.ops(1), OPS_STRIDE, true); DSCAN(42, C.ops(2), OPS_STRIDE, true); DSCAN(43, C.ops(3), OPS_STRIDE, true); } DSCAN(2 + l * 16 + 4, C.act(), (size_t)T * DM * 2, true);
        phase_qk_final(C, l);
        GRID_SYNC();
        DSCAN(2 + l * 16 + 5, C.qkv(), (size_t)T * QKVC * 2, true); DSCAN(2 + l * 16 + 6, C.kf(), (size_t)T * 768 * 2, true); DSCAN(2 + l * 16 + 7, C.pbuf(), (size_t)T * NPC * 2, true);
        phase_mixers(C, l);
        GRID_SYNC();
        if (l == 0) DSCAN(2 + l * 16 + 8, C.pbuf(), (size_t)T * NPC * 2, true);
        phase_finish(C, l);
        GRID_SYNC();
        if (l == 0) DSCAN(2 + l * 16 + 9, C.act(), (size_t)T * DM * 2, true);
        { pg8::Gemm g{C.pbuf(), C.wsm(l, WSM_WOUT), NPC, DM, DM, nullptr}; pg8::Sched S;
          if (l == 0) S.init(T / 256, 4, C.G, C.bid, 0); else S.init(128, 4, C.G, C.bid, 1);
          pg8::EpiResid E{xl_in, xc_in, C.out, C.xc(), C.modv(l)}; pg8::gemm_phase(C.lds, g, S, E, C.tid); }
        GRID_SYNC();
        DSCAN(2 + l * 16 + 10, C.out, (size_t)NBATCH * SEQ * DM * 4, false);
        phase_h_router(C, l, C.out, C.xc());
        GRID_SYNC();
        DSCAN(2 + l * 16 + 11, C.ws + OFF_AFFL, 2 * MiB, false);
        phase_select(C, l);
        GRID_SYNC();
        DSCAN(2 + l * 16 + 12, C.ws + OFF_ARENA + AR_WGU, 96 * MiB, true); DSCAN(2 + l * 16 + 13, C.ws + OFF_ARENA + AR_XE, (size_t)(l == 0 ? XE_ROWS : XE_LROWS) * DM * 2, true);
        { pg8::Gemm g{C.act(), (const bf16_t*)(C.ws + OFF_WGU2), DM, DM, DM, (const int*)(C.ws + OFF_IDX)}; pg8::Sched S;
          S.init(l == 0 ? 272 : 256, 8, C.G, C.bid, 2);
          pg8::EpiSwiglu E{(bf16_t*)(C.ws + OFF_ARENA + AR_HID), DM}; pg8::gemm_phase<pg8::EpiSwiglu, true, true, true>(C.lds, g, S, E, C.tid); }
        GRID_SYNC();
        DSCAN(2 + l * 16 + 14, C.ws + OFF_ARENA + AR_HID, (size_t)(l == 0 ? XE_ROWS : XE_LROWS) * DM * 2, true);
        { pg8::Gemm g{(const bf16_t*)(C.ws + OFF_ARENA + AR_HID), (const bf16_t*)(C.ws + OFF_ARENA + AR_WD), DM, DM, DM, nullptr}; pg8::Sched S;
          S.init(l == 0 ? 272 : 256, 4, C.G, C.bid, 2);
          pg8::EpiGate E{(bf16_t*)(C.ws + OFF_ARENA + AR_XE), DM, (const float*)(C.ws + OFF_GATE)}; pg8::gemm_phase(C.lds, g, S, E, C.tid); }
        GRID_SYNC();
        phase_combine(C, l, C.out, C.xc());
        if (l == 0) GRID_SYNC(); else { TSTAMP(); }
        DSCAN(2 + l * 16 + 15, C.out, (size_t)NBATCH * SEQ * DM * 4, false);
    }
#ifdef DIAG
    GRID_SYNC();
    diag_out(C);
#endif
#ifdef DIAG_TS
    if (blockIdx.x == 0 && threadIdx.x == 0) { const unsigned long long* ts = (const unsigned long long*)(C.ws + OFF_CNT + 4096);
        const float tot = (float)(ts[ts_n - 1] - ts[0]); const float part = (float)(ts[DIAG_TS_B] - ts[DIAG_TS_A]);
#ifndef DIAG_TS_SCALE
#define DIAG_TS_SCALE 1.f
#endif
        C.out[0] += 1.f + 29.f * fminf(1.f, DIAG_TS_SCALE * part / tot); }
#endif
}

extern "C" void kernel_launch(void* const* d_in, const int* in_sizes, int n_in, void* d_out, int out_size, void* d_ws, size_t ws_size, hipStream_t stream) {
    static int grid = 0;
    if (grid == 0) {
        int dev = 0, cus = 0, per_cu = 0;
        (void)hipGetDevice(&dev); (void)hipDeviceGetAttribute(&cus, hipDeviceAttributeMultiprocessorCount, dev);
        if (hipFuncSetAttribute((const void*)hybrid_fwd, hipFuncAttributeMaxDynamicSharedMemorySize, LDS_BYTES) != hipSuccess) { fprintf(stderr, "kernel_launch: hipFuncSetAttribute failed\n"); grid = -1; return; }
        if (hipOccupancyMaxActiveBlocksPerMultiprocessor(&per_cu, (const void*)hybrid_fwd, NTHR, LDS_BYTES) != hipSuccess || per_cu < 1) { fprintf(stderr, "kernel_launch: occupancy query gives %d\n", per_cu); grid = -1; return; }
        if (n_in != 32 || ws_size < WS_END) { fprintf(stderr, "kernel_launch: n_in %d ws %zu (need %zu)\n", n_in, ws_size, (size_t)WS_END); grid = -1; return; }
        grid = cus;
    }
    if (grid < 0) return;
    (void)hipMemsetAsync((char*)d_ws + OFF_BAR, 0, 65536, stream);
    Params p{}; for (int i = 0; i < 32; ++i) p.in[i] = (const float*)d_in[i];
    p.out = (float*)d_out; p.ws = (unsigned char*)d_ws; p.G = grid; p.pad = 0;
    void* args[] = {&p};
    hipError_t e = hipLaunchCooperativeKernel((const void*)hybrid_fwd, dim3(grid), dim3(NTHR), args, LDS_BYTES, stream);
    if (e != hipSuccess) fprintf(stderr, "cooperative launch failed: %s (grid %d)\n", hipGetErrorString(e), grid);
}
```

```cpp
#include <hip/hip_runtime.h>
#include <hip/hip_cooperative_groups.h>
#include <cstdio>
#include <cstdint>
namespace cg = cooperative_groups;

typedef unsigned short bf16_t;
typedef short bf16x8 __attribute__((ext_vector_type(8)));
typedef short s16x4 __attribute__((ext_vector_type(4)));
typedef float f32x4 __attribute__((ext_vector_type(4)));
typedef float f32x2 __attribute__((ext_vector_type(2)));
typedef float f32x16 __attribute__((ext_vector_type(16)));
typedef unsigned u32x4 __attribute__((ext_vector_type(4)));
typedef unsigned u32x2 __attribute__((ext_vector_type(2)));
#define LAS __attribute__((address_space(3)))
#define DI __device__ __forceinline__

constexpr int DM = 1024, NBATCH = 8, SEQ = 4096, CTXL = 256, SB = 4352, T = 34816;
constexpr int NPC = 2816;
constexpr int INC = 2784;
constexpr int QKVC = 1792;
constexpr int C_KR = 640, C_RQ = 672, C_RK = 928, C_RV = 1184, C_RG = 1440, C_RW = 1696;
constexpr int C_OF = 1696, C_OB = 1952, C_YF = 2208, C_YB = 2464;
constexpr int NE = 16, CAPL = 512, CAPC = 32;
constexpr int XE_LROWS = 65536, XE_ROWS = 65536 + 4096;
constexpr int NTHR = 512;
constexpr int LDS_BYTES = 160 * 1024;

constexpr size_t MiB = 1048576;
constexpr size_t OFF_BAR = 0, OFF_CNT = 32768, OFF_MOD = 1 * MiB, OFF_BONUS = 2 * MiB, OFF_AFFL = 3 * MiB, OFF_AFFC = 5 * MiB,
                 OFF_IDX = 6 * MiB, OFF_GATE = 6 * MiB + 512 * 1024, OFF_INVL = 7 * MiB, OFF_INVC = 9 * MiB, OFF_WSM = 10 * MiB,
                 OFF_XC = 31 * MiB, OFF_ACT = 39 * MiB, OFF_ARENA = 107 * MiB;
constexpr size_t WSM_STRIDE = 11010048, WSM_WIN = 0, WSM_WQKV = 5767168, WSM_WOUT = 8060928, WSM_W2F = 10158080, WSM_W2B = 10190848,
                 WSM_A2 = 10223616, WSM_G2 = 10256384;
constexpr size_t AR_P = 0, AR_QKV = 187 * MiB, AR_KF = 306 * MiB, AR_OPS = 357 * MiB, OPS_STRIDE = 17 * MiB;
constexpr size_t AR_WGU = 0, AR_WD = 32 * MiB, AR_XE = 64 * MiB, AR_HID = 200 * MiB, AR_XMID = 357 * MiB;
constexpr size_t OFF_ROPE = OFF_ARENA + 425 * MiB;
constexpr size_t ROPE_AT = 4352 * 32 * 8;
constexpr size_t OFF_WGU2 = OFF_ROPE + 2 * MiB;
constexpr size_t WS_END = OFF_WGU2 + 64 * MiB;

struct Params { const float* in[32]; float* out; unsigned char* ws; int G; int pad; };

DI float bf2f(unsigned v) { return __uint_as_float(v << 16); }
DI bf16_t f2bf(float f) { return __builtin_bit_cast(bf16_t, (__bf16)f); }
typedef __bf16 bf16x2n __attribute__((ext_vector_type(2)));
DI unsigned pk2(float lo, float hi) { const f32x2 v = {lo, hi}; return __builtin_bit_cast(unsigned, __builtin_convertvector(v, bf16x2n)); }
DI float lo_f(unsigned w) { return __uint_as_float(w << 16); }
DI float hi_f(unsigned w) { return __uint_as_float(w & 0xffff0000u); }
DI float wave_sum(float v) { for (int o = 32; o >= 1; o >>= 1) v += __shfl_xor(v, o); return v; }
DI float dppf(float x, const int ctrl_sel) { return x; }
template <int CTRL> DI float dpp_mov(float x) { return __builtin_bit_cast(float, __builtin_amdgcn_update_dpp(0, __builtin_bit_cast(int, x), CTRL, 0xf, 0xf, true)); }
DI float row16_sum(float x) { x += dpp_mov<0xB1>(x); x += dpp_mov<0x4E>(x); x += dpp_mov<0x141>(x); x += dpp_mov<0x140>(x); return x; }
DI void row16_sum2(float& x, float& y) {
    asm("s_nop 1\n\t"
        "v_add_f32_dpp %0, %0, %0 quad_perm:[1,0,3,2] row_mask:0xf bank_mask:0xf bound_ctrl:1\n\t"
        "v_add_f32_dpp %1, %1, %1 quad_perm:[1,0,3,2] row_mask:0xf bank_mask:0xf bound_ctrl:1\n\t"
        "s_nop 0\n\t"
        "v_add_f32_dpp %0, %0, %0 quad_perm:[2,3,0,1] row_mask:0xf bank_mask:0xf bound_ctrl:1\n\t"
        "v_add_f32_dpp %1, %1, %1 quad_perm:[2,3,0,1] row_mask:0xf bank_mask:0xf bound_ctrl:1\n\t"
        "s_nop 0\n\t"
        "v_add_f32_dpp %0, %0, %0 row_half_mirror row_mask:0xf bank_mask:0xf bound_ctrl:1\n\t"
        "v_add_f32_dpp %1, %1, %1 row_half_mirror row_mask:0xf bank_mask:0xf bound_ctrl:1\n\t"
        "s_nop 0\n\t"
        "v_add_f32_dpp %0, %0, %0 row_mirror row_mask:0xf bank_mask:0xf bound_ctrl:1\n\t"
        "v_add_f32_dpp %1, %1, %1 row_mirror row_mask:0xf bank_mask:0xf bound_ctrl:1\n\t"
        "s_nop 0"
        : "+v"(x), "+v"(y));
}
DI float sigmoidf_(float x) { return __builtin_amdgcn_rcpf(1.f + __expf(-x)); }
DI float siluf_(float x) { return x * __builtin_amdgcn_rcpf(1.f + __expf(-x)); }
DI int tok_b(int tok) { return tok / SB; }

namespace pg8 {
constexpr int BM = 256, BK = 64, HALF = 128, HTB = HALF * BK * 2, STAGE_BYTES = 8 * HTB, NXCD = 8, WGM = 8;
DI int lds_byte(int r, int c) { const int st = (r >> 4) * 2 + (c >> 5), rr = r & 15, cc = c & 31, ob = rr * 64 + cc * 2; return st * 1024 + (ob ^ (((ob >> 9) & 1) << 5)); }
DI void stage_rc(int b, int& R, int& C) { const int st = b / 1024, sb = b % 1024, swz = sb ^ (((sb >> 9) & 1) << 5); R = (st >> 1) * 16 + swz / 64; C = (st & 1) * 32 + (swz % 64) / 2; }
DI int perm32(int rho) { const int n = rho >> 4, i = rho & 15; return 8 * (i >> 2) + 4 * n + (i & 3); }

struct Unit { int pm, pn, arow, brow; };
struct Gemm { const bf16_t* A; const bf16_t* Bt; int lda, ldb, K; const int* gidx; };

struct Sched {
    int nM, nN, nwg, G, c, mode;
    DI void init(int nM_, int nN_, int G_, int c_, int mode_) { nM = nM_; nN = nN_; nwg = nM * nN; G = G_; c = c_; mode = mode_; }
    DI bool next(int i, Unit& u) const {
        const long L = (long)i * G + c; if (L >= nwg) return false;
        int wgid = (int)L; { const int q = nwg / NXCD, r = nwg % NXCD, xcd = wgid % NXCD, off = wgid / NXCD; wgid = (xcd < r ? xcd * (q + 1) : r * (q + 1) + (xcd - r) * q) + off; }
        const int nig = WGM * nN, gid = wgid / nig, fm = gid * WGM, gsz = (nM - fm) < WGM ? (nM - fm) : WGM;
        int pm = fm + ((wgid % nig) % gsz); const int pn = (wgid % nig) / gsz;
        u.pn = pn;
        if (mode == 0) { u.pm = pm; u.arow = pm * 256; u.brow = pn * 256; }
        else if (mode == 1) { pm = pm + pm / 16 + 1; u.pm = pm; u.arow = pm * 256; u.brow = pn * 256; }
        else { const int e = pm < 256 ? (pm >> 4) : (pm - 256); u.pm = pm; u.arow = pm * 256; u.brow = e * (nN * 256) + pn * 256; }
        return true;
    }
};

struct EpiBf16 {
    static constexpr bool PERM = true;
    bf16_t* O; int ldc;
    DI void operator()(const f32x4 (&acc)[2][2][4][2], const Unit& u, int wr, int wc, int fr, int fq) const {
        const int row0 = u.pm * BM + wr * 64 + fr, col0 = u.pn * BM + wc * 32 + 8 * fq;
#pragma unroll
        for (int ai = 0; ai < 2; ++ai)
#pragma unroll
            for (int m = 0; m < 4; ++m) { bf16_t* rowp = O + (size_t)(row0 + ai * HALF + m * 16) * ldc + col0;
#pragma unroll
                for (int bj = 0; bj < 2; ++bj) { const f32x4 v0 = acc[ai][bj][m][0], v1 = acc[ai][bj][m][1];
                    u32x4 w; w.x = pk2(v0[0], v0[1]); w.y = pk2(v0[2], v0[3]); w.z = pk2(v1[0], v1[1]); w.w = pk2(v1[2], v1[3]);
                    *(u32x4*)(rowp + bj * HALF) = w; } }
    }
};
struct EpiGate {
    static constexpr bool PERM = true;
    bf16_t* O; int ldc; const float* gate;
    DI void operator()(const f32x4 (&acc)[2][2][4][2], const Unit& u, int wr, int wc, int fr, int fq) const {
        const int row0 = u.pm * BM + wr * 64 + fr, col0 = u.pn * BM + wc * 32 + 8 * fq;
#pragma unroll
        for (int ai = 0; ai < 2; ++ai)
#pragma unroll
            for (int m = 0; m < 4; ++m) { const int row = row0 + ai * HALF + m * 16; const float g = gate[row]; bf16_t* rowp = O + (size_t)row * ldc + col0;
#pragma unroll
                for (int bj = 0; bj < 2; ++bj) { const f32x4 v0 = acc[ai][bj][m][0] * g, v1 = acc[ai][bj][m][1] * g;
                    u32x4 w; w.x = pk2(v0[0], v0[1]); w.y = pk2(v0[2], v0[3]); w.z = pk2(v1[0], v1[1]); w.w = pk2(v1[2], v1[3]);
                    *(u32x4*)(rowp + bj * HALF) = w; } }
    }
};
struct EpiSwiglu {
    static constexpr bool PERM = true;
    bf16_t* O; int ldc;
    DI void operator()(const f32x4 (&acc)[2][2][4][2], const Unit& u, int wr, int wc, int fr, int fq) const {
        const int row0 = u.pm * BM + wr * 64 + fr, col0 = u.pn * 128 + wc * 16 + 4 * fq;
#pragma unroll
        for (int ai = 0; ai < 2; ++ai)
#pragma unroll
            for (int m = 0; m < 4; ++m) { bf16_t* rowp = O + (size_t)(row0 + ai * HALF + m * 16) * ldc + col0;
#pragma unroll
                for (int bj = 0; bj < 2; ++bj) { const f32x4 g = acc[ai][bj][m][0], up = acc[ai][bj][m][1];
                    u32x2 w; w.x = pk2(siluf_(g[0]) * up[0], siluf_(g[1]) * up[1]); w.y = pk2(siluf_(g[2]) * up[2], siluf_(g[3]) * up[3]);
                    *(u32x2*)(rowp + bj * 64) = w; } }
    }
};
struct EpiResid {
    static constexpr bool PERM = false;
    const float* xold_lat; const float* xold_ctx; bf16_t* xmid; const float* modl;
    DI void operator()(const f32x4 (&acc)[2][2][4][2], const Unit& u, int wr, int wc, int fr, int fq) const {
        const int b = u.pm / 17, w = u.pm % 17;
        const float* xo = (w == 0) ? xold_ctx + (size_t)(b * 256) * DM : xold_lat + (size_t)(b * 4096 + (w - 1) * 256) * DM;
        bf16_t* xn = xmid + (size_t)(u.pm * 256) * DM;
        const float* ga = modl + (size_t)((w == 0) ? 8 : b) * 6144 + 2048;
        const int r0 = wr * 64 + fr, col0 = u.pn * BM + wc * 32 + 4 * fq;
        f32x4 gv[2][2];
#pragma unroll
        for (int bj = 0; bj < 2; ++bj)
#pragma unroll
            for (int n = 0; n < 2; ++n) gv[bj][n] = *(const f32x4*)(ga + col0 + bj * HALF + n * 16);
        constexpr int EPD = 3;
        f32x4 xr[EPD][4];
#define ER_LOAD(i_) do { const unsigned ro_ = (unsigned)(r0 + ((i_) >> 2) * HALF + ((i_) & 3) * 16) * DM + col0; \
            _Pragma("unroll") for (int bj = 0; bj < 2; ++bj) _Pragma("unroll") for (int n = 0; n < 2; ++n) xr[(i_) % EPD][bj * 2 + n] = *(const f32x4*)(xo + ro_ + bj * HALF + n * 16); } while (0)
#pragma unroll
        for (int i = 0; i < EPD; ++i) ER_LOAD(i);
        asm volatile("" ::: "memory");
#pragma unroll
        for (int i = 0; i < 8; ++i) { const int ai = i >> 2, m = i & 3; const unsigned ro = (unsigned)(r0 + ai * HALF + m * 16) * DM + col0;
#pragma unroll
            for (int bj = 0; bj < 2; ++bj)
#pragma unroll
                for (int n = 0; n < 2; ++n) { const f32x4 o = xr[i % EPD][bj * 2 + n] + gv[bj][n] * acc[ai][bj][m][n];
                    u32x2 w2; w2.x = pk2(o[0], o[1]); w2.y = pk2(o[2], o[3]); *(u32x2*)(xn + ro + bj * HALF + n * 16) = w2; }
            asm volatile("" ::: "memory");
            if (i + EPD < 8) { ER_LOAD(i + EPD); }
            asm volatile("" ::: "memory"); }
#undef ER_LOAD
    }
};

template <class Epi, bool ALIGN_EPI = true, bool SP2 = true, bool GATHER = false>
DI void gemm_phase(LAS unsigned char* lds, const Gemm g, const Sched& S, const Epi& E, const int tid) {
    const int wid = __builtin_amdgcn_readfirstlane(tid >> 6), lane = tid & 63, wr = wid >> 2, wc = wid & 3, fr = lane & 15, fq = lane >> 4;
    const int K = g.K, nt = K / BK;
    unsigned voffA[2], voffB[2];
#pragma unroll
    for (int i = 0; i < 2; ++i) { int R, C; stage_rc(tid * 16 + i * 8192, R, C); const int Rb = Epi::PERM ? ((R & ~31) + perm32(R & 31)) : R;
        voffA[i] = (unsigned)(R * g.lda + C) * 2u; voffB[i] = (unsigned)(Rb * g.ldb + C) * 2u; }
    const size_t kstep = (size_t)(BK * 2);
    const size_t hstepA = GATHER ? (size_t)0 : (size_t)HALF * g.lda * 2, hstepB = (size_t)HALF * g.ldb * 2;
    unsigned vG[2][2], vN[2][2]; int gR[2], gC[2];
    LAS int* lidx = (LAS int*)(lds + STAGE_BYTES);
#pragma unroll
    for (int i = 0; i < 2; ++i) { int R, C; stage_rc(tid * 16 + i * 8192, R, C); gR[i] = R; gC[i] = C * 2; }
#define PG8_GOFF(V, ui_) do { _Pragma("unroll") for (int h_ = 0; h_ < 2; ++h_) _Pragma("unroll") for (int i_ = 0; i_ < 2; ++i_) \
        V[h_][i_] = (unsigned)lidx[(ui_) * 256 + h_ * 128 + gR[i_]] * (unsigned)(g.lda * 2) + (unsigned)gC[i_]; } while (0)
    const unsigned ldsw = (unsigned)wid * 1024u;
    const int aoff = lds_byte(wr * 64 + fr, fq * 8), boff = lds_byte(wc * 32 + fr, fq * 8);
#define PG8_SA(b, h) (((b) * 2 + (h)) * HTB)
#define PG8_SB(b, h) ((4 + (b) * 2 + (h)) * HTB)
#define PG8_STAGE(bufoff, gbase, voff) do { _Pragma("unroll") for (int _i = 0; _i < 2; ++_i) \
        __builtin_amdgcn_global_load_lds((const unsigned*)((const char*)(gbase) + (voff)[_i]), (LAS unsigned*)(lds + (bufoff) + ldsw + _i * 8192), 16, 0, 0); } while (0)
#define PG8_LDA(dst, b, h) do { _Pragma("unroll") for (int m = 0; m < 4; ++m) _Pragma("unroll") for (int k = 0; k < 2; ++k) dst[m][k] = *(const LAS bf16x8*)(lds + PG8_SA(b, h) + aoff + m * 2048 + k * 1024); } while (0)
#define PG8_LDB(dst, b, h) do { _Pragma("unroll") for (int n = 0; n < 2; ++n) _Pragma("unroll") for (int k = 0; k < 2; ++k) dst[n][k] = *(const LAS bf16x8*)(lds + PG8_SB(b, h) + boff + n * 2048 + k * 1024); } while (0)
#define PG8_MMA(ai, bj, At, Bt) do { __builtin_amdgcn_s_setprio(1); _Pragma("unroll") for (int m = 0; m < 4; ++m) _Pragma("unroll") for (int n = 0; n < 2; ++n) _Pragma("unroll") for (int k = 0; k < 2; ++k) \
        acc[ai][bj][m][n] = __builtin_amdgcn_mfma_f32_16x16x32_bf16(Bt[n][k], At[m][k], acc[ai][bj][m][n], 0, 0, 0); __builtin_amdgcn_s_setprio(0); } while (0)
#define PG8_WAIT_V(n) asm volatile("s_waitcnt vmcnt(" #n ")" ::: "memory")
#define PG8_WAIT_L(n) asm volatile("s_waitcnt lgkmcnt(" #n ")" ::: "memory")
#define PG8_BAR __builtin_amdgcn_s_barrier()
#define PG8_SCHED __builtin_amdgcn_sched_barrier(0)
    Unit cur, nxt; int ui = 0;
    if (!S.next(0, cur)) return;
    if constexpr (GATHER) { Unit u_; for (int q_ = 0; S.next(q_, u_); ++q_) if (tid < 256) lidx[q_ * 256 + tid] = g.gidx[u_.arow + tid];
        __syncthreads(); PG8_GOFF(vG, 0); }
    f32x4 acc[2][2][4][2];
#pragma unroll
    for (int a = 0; a < 2; ++a)
#pragma unroll
        for (int b = 0; b < 2; ++b)
#pragma unroll
            for (int m = 0; m < 4; ++m)
#pragma unroll
                for (int n = 0; n < 2; ++n) acc[a][b][m][n] = (f32x4){0.f, 0.f, 0.f, 0.f};
    bf16x8 At[4][2], B0[2][2], B1[2][2];
    const char* cA = GATHER ? (const char*)g.A : (const char*)g.A + (size_t)cur.arow * g.lda * 2; const char* cB = (const char*)g.Bt + (size_t)cur.brow * g.ldb * 2;
#define PG8_VA(h, nextu) (GATHER ? ((nextu) ? vN[h] : vG[h]) : voffA)
    if constexpr (SP2) {
        PG8_STAGE(PG8_SB(0, 0), cB, voffB); PG8_STAGE(PG8_SB(0, 1), cB + hstepB, voffB); PG8_STAGE(PG8_SA(0, 0), cA, PG8_VA(0, false)); PG8_STAGE(PG8_SA(0, 1), cA + hstepA, PG8_VA(1, false));
        if (wr == 1) PG8_BAR;
        PG8_WAIT_V(2); PG8_BAR;
        PG8_STAGE(PG8_SB(1, 0), cB + kstep, voffB); PG8_STAGE(PG8_SA(1, 0), cA + kstep, PG8_VA(0, false)); PG8_STAGE(PG8_SB(1, 1), cB + hstepB + kstep, voffB);
        PG8_WAIT_V(6); PG8_BAR;
    } else {
    PG8_STAGE(PG8_SB(0, 0), cB, voffB); PG8_STAGE(PG8_SA(0, 0), cA, voffA); PG8_STAGE(PG8_SB(0, 1), cB + hstepB, voffB); PG8_STAGE(PG8_SA(0, 1), cA + hstepA, voffA);
    if (wr == 1) PG8_BAR;
    PG8_WAIT_V(4); PG8_BAR;
    PG8_STAGE(PG8_SB(1, 0), cB + kstep, voffB); PG8_STAGE(PG8_SA(1, 0), cA + kstep, voffA); PG8_STAGE(PG8_SB(1, 1), cB + hstepB + kstep, voffB);
    PG8_WAIT_V(6); PG8_BAR;
    }
    for (;;) {
        const bool has_next = S.next(ui + 1, nxt);
        const char* nA = GATHER ? cA : (has_next ? (const char*)g.A + (size_t)nxt.arow * g.lda * 2 : cA); const char* nB = has_next ? (const char*)g.Bt + (size_t)nxt.brow * g.ldb * 2 : cB;
        if constexpr (GATHER) { if (has_next) PG8_GOFF(vN, ui + 1); else {
#pragma unroll
            for (int h_ = 0; h_ < 2; ++h_) { vN[h_][0] = vG[h_][0]; vN[h_][1] = vG[h_][1]; } } }
        for (int t = 0; t < nt; t += 2) {
            const bool last = (t == nt - 2);
            const char* a1 = cA + (size_t)(t + 1) * kstep;
            const char* a2 = last ? nA : cA + (size_t)(t + 2) * kstep; const char* b2 = last ? nB : cB + (size_t)(t + 2) * kstep;
            const char* a3 = a2 + kstep; const char* b3 = b2 + kstep;
            if constexpr (SP2) {
            PG8_LDB(B0, 0, 0); PG8_LDB(B1, 0, 1); PG8_SCHED; PG8_LDA(At, 0, 0); PG8_STAGE(PG8_SA(1, 1), a1 + hstepA, PG8_VA(1, false));
            PG8_WAIT_V(8); PG8_WAIT_L(0); PG8_BAR; PG8_MMA(0, 0, At, B0); PG8_MMA(0, 1, At, B1); PG8_BAR; PG8_SCHED;
            PG8_LDA(At, 0, 1); PG8_STAGE(PG8_SB(0, 0), b2, voffB); PG8_STAGE(PG8_SB(0, 1), b2 + hstepB, voffB); PG8_STAGE(PG8_SA(0, 0), a2, PG8_VA(0, last));
            PG8_WAIT_V(8); PG8_WAIT_L(0); PG8_BAR; PG8_MMA(1, 0, At, B0); PG8_MMA(1, 1, At, B1); PG8_BAR; PG8_SCHED;
            PG8_LDB(B0, 1, 0); PG8_LDB(B1, 1, 1); PG8_SCHED; PG8_LDA(At, 1, 0); PG8_STAGE(PG8_SA(0, 1), a2 + hstepA, PG8_VA(1, last));
            PG8_WAIT_V(8); PG8_WAIT_L(0); PG8_BAR; PG8_MMA(0, 0, At, B0); PG8_MMA(0, 1, At, B1); PG8_BAR; PG8_SCHED;
            PG8_LDA(At, 1, 1); PG8_STAGE(PG8_SB(1, 0), b3, voffB); PG8_STAGE(PG8_SB(1, 1), b3 + hstepB, voffB); PG8_STAGE(PG8_SA(1, 0), a3, PG8_VA(0, last));
            PG8_WAIT_V(8); PG8_WAIT_L(0); PG8_BAR; PG8_MMA(1, 0, At, B0); PG8_MMA(1, 1, At, B1); PG8_BAR; PG8_SCHED;
            } else {
            PG8_LDB(B0, 0, 0); PG8_SCHED; PG8_LDA(At, 0, 0); PG8_STAGE(PG8_SA(1, 1), a1 + hstepA, voffA);
            PG8_WAIT_L(8); PG8_BAR; PG8_WAIT_L(0); PG8_MMA(0, 0, At, B0); PG8_BAR; PG8_SCHED;
            PG8_LDB(B1, 0, 1); PG8_STAGE(PG8_SB(0, 0), b2, voffB);
            PG8_BAR; PG8_WAIT_L(0); PG8_MMA(0, 1, At, B1); PG8_BAR;
            PG8_LDA(At, 0, 1); PG8_STAGE(PG8_SA(0, 0), a2, voffA);
            PG8_BAR; PG8_WAIT_L(0); PG8_MMA(1, 0, At, B0); PG8_BAR; PG8_SCHED;
            PG8_STAGE(PG8_SB(0, 1), b2 + hstepB, voffB);
            PG8_WAIT_V(6); PG8_BAR; PG8_MMA(1, 1, At, B1); PG8_BAR;
            PG8_LDB(B0, 1, 0); PG8_SCHED; PG8_LDA(At, 1, 0); PG8_STAGE(PG8_SA(0, 1), a2 + hstepA, voffA);
            PG8_WAIT_L(8); PG8_BAR; PG8_WAIT_L(0); PG8_MMA(0, 0, At, B0); PG8_BAR; PG8_SCHED;
            PG8_LDB(B1, 1, 1); PG8_STAGE(PG8_SB(1, 0), b3, voffB);
            PG8_BAR; PG8_WAIT_L(0); PG8_MMA(0, 1, At, B1); PG8_BAR;
            PG8_LDA(At, 1, 1); PG8_STAGE(PG8_SA(1, 0), a3, voffA);
            PG8_BAR; PG8_WAIT_L(0); PG8_MMA(1, 0, At, B0); PG8_BAR; PG8_SCHED;
            PG8_STAGE(PG8_SB(1, 1), b3 + hstepB, voffB);
            PG8_WAIT_V(6); PG8_BAR; PG8_MMA(1, 1, At, B1); PG8_BAR;
            }
        }
        if constexpr (ALIGN_EPI) { if (wr == 0) PG8_BAR; }
        E(acc, cur, wr, wc, fr, fq);
        if (!has_next) break;
#pragma unroll
        for (int a = 0; a < 2; ++a)
#pragma unroll
            for (int b = 0; b < 2; ++b)
#pragma unroll
                for (int m = 0; m < 4; ++m)
#pragma unroll
                    for (int n = 0; n < 2; ++n) acc[a][b][m][n] = (f32x4){0.f, 0.f, 0.f, 0.f};
        cur = nxt; cA = nA; cB = nB; ++ui;
        if constexpr (GATHER) {
#pragma unroll
            for (int h_ = 0; h_ < 2; ++h_) { vG[h_][0] = vN[h_][0]; vG[h_][1] = vN[h_][1]; } }
        if constexpr (ALIGN_EPI) { if (wr == 1) PG8_BAR; }
    }
    PG8_WAIT_V(0);
    if constexpr (!ALIGN_EPI) { if (wr == 0) PG8_BAR; }
    PG8_BAR;
#undef PG8_SA
#undef PG8_VA
#undef PG8_GOFF
#undef PG8_SB
#undef PG8_STAGE
#undef PG8_LDA
#undef PG8_LDB
#undef PG8_MMA
#undef PG8_WAIT_V
#undef PG8_WAIT_L
#undef PG8_BAR
#undef PG8_SCHED
}
}


#define XB_TMO      128
#define XB_XCNT(j)  (256  + 64 * (j))
#define XB_XSUB(j)  (1280 + 64 * (j))
#define XB_XGEN(j)  (2304 + 64 * (j))
#define XB_TOP      3328
#define XB_TOPGEN   3392
#define XCD_BAR_WORDS 3456
#define XB_SPIN_CAP (1u << 22)
DI unsigned xb_ld(unsigned* p)              { return __hip_atomic_load(p, __ATOMIC_RELAXED, __HIP_MEMORY_SCOPE_AGENT); }
DI unsigned xb_add(unsigned* p, unsigned v) { return __hip_atomic_fetch_add(p, v, __ATOMIC_RELAXED, __HIP_MEMORY_SCOPE_AGENT); }
DI unsigned xb_xcc_id() { return (unsigned)__builtin_amdgcn_s_getreg((3 << 11) | 20) & 0xFu; }
#define XB_SPIN(cond, bar) do { unsigned _sp = 0; while (cond) { __builtin_amdgcn_s_sleep(1); \
    if ((++_sp & 255u) == 0u) { if (xb_ld(&(bar)[XB_TMO])) break; if (_sp > XB_SPIN_CAP) { atomicAdd(&(bar)[XB_TMO], 1u); break; } } } } while (0)
struct XcdBarrier { unsigned* bar; unsigned x; volatile LAS unsigned* st; };
DI XcdBarrier xcd_barrier_post(unsigned* bar, volatile LAS unsigned* st) {
    XcdBarrier b; b.bar = bar; b.x = xb_xcc_id(); b.st = st;
    if (threadIdx.x == 0) (void)xb_add(&bar[XB_XCNT(b.x)], 1u);
    return b;
}
DI void xcd_barrier_complete(unsigned* bar, unsigned x, unsigned& nloc, unsigned& nx) {
    const unsigned G = gridDim.x * gridDim.y * gridDim.z;
    unsigned sum, cnt, mine, sp = 0u;
    for (;;) {
        sum = 0u; cnt = 0u; mine = 0u;
#pragma unroll
        for (unsigned j = 0; j < 16; ++j) { const unsigned c = xb_ld(&bar[XB_XCNT(j)]); sum += c; cnt += (c > 0u) ? 1u : 0u; mine = (j == x) ? c : mine; }
        if (sum == G) break;
        __builtin_amdgcn_s_sleep(1);
        if ((++sp & 255u) == 0u) { if (xb_ld(&bar[XB_TMO])) break; if (sp > XB_SPIN_CAP) { atomicAdd(&bar[XB_TMO], 1u); break; } }
    }
    nloc = mine > 0u ? mine : 1u; nx = cnt > 0u ? cnt : 1u;
}
DI void xcd_barrier(const XcdBarrier& b) {
    asm volatile("s_waitcnt vmcnt(0)" ::: "memory");
    __syncthreads();
    if (threadIdx.x == 0) {
        unsigned* bar = b.bar;
        __builtin_amdgcn_s_waitcnt(0);
        unsigned nloc = b.st[0], nx = b.st[1];
        if (nloc == 0u) { xcd_barrier_complete(bar, b.x, nloc, nx); b.st[0] = nloc; b.st[1] = nx; }
        const unsigned old = xb_add(&bar[XB_XSUB(b.x)], 1u);
        const unsigned gen = old / nloc;
        if (old + 1u == (gen + 1u) * nloc) {
            __builtin_amdgcn_fence(__ATOMIC_RELEASE, "agent");
            asm volatile("s_waitcnt vmcnt(0)" ::: "memory");
            const unsigned og = xb_add(&bar[XB_TOP], 1u);
            const unsigned tg = og / nx;
            if (og + 1u == (tg + 1u) * nx) xb_add(&bar[XB_TOPGEN], 1u);
            else XB_SPIN(xb_ld(&bar[XB_TOPGEN]) == tg, bar);
            __builtin_amdgcn_fence(__ATOMIC_ACQUIRE, "agent");
            xb_add(&bar[XB_XGEN(b.x)], 1u);
            asm volatile("s_waitcnt vmcnt(0)" ::: "memory");
        } else {
            XB_SPIN(xb_ld(&bar[XB_XGEN(b.x)]) == gen, bar);
            __builtin_amdgcn_fence(__ATOMIC_ACQUIRE, "agent");
            asm volatile("s_waitcnt vmcnt(0)" ::: "memory");
        }
    }
    __syncthreads();
}

struct Ctx {
    const float* const* in; float* out; unsigned char* ws; int G, bid, tid, wave, lane; LAS unsigned char* lds;
    DI float* modv(int l) const { return (float*)(ws + OFF_MOD) + (size_t)l * 9 * 6144; }
    DI bf16_t* wsm(int l, size_t off) const { return (bf16_t*)(ws + OFF_WSM + (size_t)l * WSM_STRIDE + off); }
    DI bf16_t* act() const { return (bf16_t*)(ws + OFF_ACT); }
    DI bf16_t* pbuf() const { return (bf16_t*)(ws + OFF_ARENA + AR_P); }
    DI bf16_t* qkv() const { return (bf16_t*)(ws + OFF_ARENA + AR_QKV); }
    DI bf16_t* kf() const { return (bf16_t*)(ws + OFF_ARENA + AR_KF); }
    DI bf16_t* ops(int i) const { return (bf16_t*)(ws + OFF_ARENA + AR_OPS + (size_t)i * OPS_STRIDE); }
    DI float* xc() const { return (float*)(ws + OFF_XC); }
    DI float* bonus() const { return (float*)(ws + OFF_BONUS); }
    DI int* cnt() const { return (int*)(ws + OFF_CNT); }
};

DI void phase_mod(const Ctx& C) {
    LAS float* sl = (LAS float*)C.lds;
    LAS float* red = (LAS float*)(C.lds + 40960);
    const float* cv = C.in[1]; const float* ccx = C.in[3];
    for (int i = C.tid; i < 9 * 1024; i += NTHR) { const int s = i >> 10, k = i & 1023; const float v = (s < 8) ? cv[s * 1024 + k] : ccx[k]; sl[i] = siluf_(v); }
    __syncthreads();
    for (int item = C.bid; item < 192; item += C.G) {
        const int l = item / 96, col = (item % 96) * 64 + C.lane;
        const float* W = C.in[4] + (size_t)l * 1024 * 6144 + col;
        float acc[9];
#pragma unroll
        for (int j = 0; j < 9; ++j) acc[j] = 0.f;
        const int k0 = C.wave * 128;
        for (int kb = 0; kb < 128; kb += 16) { float wv[16];
#pragma unroll
            for (int k = 0; k < 16; ++k) wv[k] = W[(size_t)(k0 + kb + k) * 6144];
#pragma unroll
            for (int k = 0; k < 16; ++k)
#pragma unroll
                for (int j = 0; j < 9; ++j) acc[j] += sl[j * 1024 + k0 + kb + k] * wv[k]; }
#pragma unroll
        for (int j = 0; j < 9; ++j) red[(C.wave * 9 + j) * 64 + C.lane] = acc[j];
        __syncthreads();
        for (int o = C.tid; o < 9 * 64; o += NTHR) { const int j = o >> 6, ln = o & 63; float s = 0.f;
            for (int w = 0; w < 8; ++w) s += red[(w * 9 + j) * 64 + ln];
            const int cc = (item % 96) * 64 + ln;
            C.modv(l)[(size_t)j * 6144 + cc] = s + C.in[5][(size_t)l * 6144 + cc]; }
        __syncthreads();
    }
}

DI void phase_rope_tables(const Ctx& C) {
    f32x2* RT = (f32x2*)(C.ws + OFF_ROPE); f32x2* AT = (f32x2*)(C.ws + OFF_ROPE + ROPE_AT);
    const int n1 = SB * 32, n2 = SEQ * 16;
    for (int i = C.bid * NTHR + C.tid; i < n1 + n2; i += C.G * NTHR) {
        float sn, cs;
        if (i < n1) { const int pos = i >> 5, k = i & 31; const float inv = exp2f(-(float)k * (13.287712379549449f / 31.f)); sincosf((float)pos * inv, &sn, &cs); RT[i] = (f32x2){cs, sn}; }
        else { const int j = i - n1, t = j >> 4, p = j & 15, f = p & 7; const float inv = exp2f(-(float)f * (13.287712379549449f / 8.f)); const float pos = (p < 8) ? (float)(t >> 6) : (float)(t & 63);
            sincosf(pos * inv, &sn, &cs); AT[j] = (f32x2){cs, sn}; }
    }
}

struct TJob { const float* src; int ldsrc, Ks, Ns; const float* kscale; bf16_t* dst; int lddst, row0, col0, nkt, nnt, rowmap; };
DI void tconv_tile(const TJob& J, int kt, int nt, LAS float* lds, const int tid) {
    const int k0 = kt * 64, n0 = nt * 64;
    { const int kk = tid >> 3, nn = (tid & 7) * 8; const int k = k0 + kk; float v[8];
#pragma unroll
      for (int j = 0; j < 8; ++j) v[j] = 0.f;
      if (J.src && k < J.Ks) { const float* sp = J.src + (size_t)k * J.ldsrc + n0 + nn;
          if (n0 + nn + 7 < J.Ns) { const f32x4 a = *(const f32x4*)sp, b = *(const f32x4*)(sp + 4); v[0] = a[0]; v[1] = a[1]; v[2] = a[2]; v[3] = a[3]; v[4] = b[0]; v[5] = b[1]; v[6] = b[2]; v[7] = b[3]; }
          else {
#pragma unroll
              for (int j = 0; j < 8; ++j) if (n0 + nn + j < J.Ns) v[j] = sp[j]; }
          const float sc = J.kscale ? J.kscale[k] : 1.f;
#pragma unroll
          for (int j = 0; j < 8; ++j) v[j] *= sc; }
#pragma unroll
      for (int j = 0; j < 8; ++j) lds[kk * 65 + nn + j] = v[j]; }
    __syncthreads();
    { const int n = tid >> 3, kq = (tid & 7) * 8; float v[8];
#pragma unroll
      for (int j = 0; j < 8; ++j) v[j] = lds[(kq + j) * 65 + n];
      const int nl = n0 + n; int dr;
      if (J.rowmap == 0) dr = nl; else dr = 8 * (nl >> 2) + (nl & 3) + (J.rowmap == 2 ? 4 : 0);
      u32x4 w; w.x = pk2(v[0], v[1]); w.y = pk2(v[2], v[3]); w.z = pk2(v[4], v[5]); w.w = pk2(v[6], v[7]);
      *(u32x4*)(J.dst + (size_t)(J.row0 + dr) * J.lddst + J.col0 + k0 + kq) = w; }
    __syncthreads();
}
DI TJob small_job(const Ctx& C, int l, int j) {
    TJob J; J.kscale = nullptr; J.rowmap = 0; J.row0 = 0; J.col0 = 0;
    switch (j) {
    case 0: J.src = C.in[8] + (size_t)l * 1024 * INC; J.ldsrc = INC; J.Ks = 1024; J.Ns = INC; J.dst = C.wsm(l, WSM_WIN); J.lddst = 1024; J.nkt = 16; J.nnt = 44; break;
    case 1: J.src = C.in[10] + (size_t)l * 384 * 768; J.ldsrc = 768; J.Ks = 384; J.Ns = 768; J.kscale = C.in[9] + l * 384; J.dst = C.wsm(l, WSM_WQKV); J.lddst = 640; J.nkt = 6; J.nnt = 12; break;
    case 2: J.src = C.in[12] + (size_t)l * 256 * 1024; J.ldsrc = 1024; J.Ks = 256; J.Ns = 1024; J.kscale = C.in[11] + l * 256; J.dst = C.wsm(l, WSM_WQKV); J.lddst = 640; J.row0 = 768; J.col0 = 384; J.nkt = 4; J.nnt = 16; break;
    case 3: J.src = nullptr; J.ldsrc = 0; J.Ks = 0; J.Ns = 0; J.dst = C.wsm(l, WSM_WQKV); J.lddst = 640; J.row0 = 0; J.col0 = 384; J.nkt = 4; J.nnt = 12; break;
    case 4: J.src = nullptr; J.ldsrc = 0; J.Ks = 0; J.Ns = 0; J.dst = C.wsm(l, WSM_WQKV); J.lddst = 640; J.row0 = 768; J.col0 = 0; J.nkt = 6; J.nnt = 16; break;
    case 5: J.src = C.in[27] + (size_t)l * 1024 * 1024; J.ldsrc = 1024; J.Ks = 1024; J.Ns = 1024; J.dst = C.wsm(l, WSM_WOUT); J.lddst = 1024; J.nkt = 16; J.nnt = 16; break;
    case 6: J.src = C.in[19] + (size_t)(l * 2 + 0) * 64 * 256; J.ldsrc = 256; J.Ks = 64; J.Ns = 256; J.dst = C.wsm(l, WSM_W2F); J.lddst = 64; J.nkt = 1; J.nnt = 4; break;
    case 7: J.src = C.in[19] + (size_t)(l * 2 + 1) * 64 * 256; J.ldsrc = 256; J.Ks = 64; J.Ns = 256; J.dst = C.wsm(l, WSM_W2B); J.lddst = 64; J.nkt = 1; J.nnt = 4; break;
    case 8: J.src = C.in[21] + (size_t)l * 64 * 256; J.ldsrc = 256; J.Ks = 64; J.Ns = 256; J.dst = C.wsm(l, WSM_A2); J.lddst = 64; J.nkt = 1; J.nnt = 4; break;
    default: J.src = C.in[22] + (size_t)l * 128 * 256; J.ldsrc = 256; J.Ks = 128; J.Ns = 256; J.dst = C.wsm(l, WSM_G2); J.lddst = 128; J.nkt = 2; J.nnt = 4; break;
    }
    return J;
}
DI void phase_wconv_small(const Ctx& C) {
    LAS float* lds = (LAS float*)C.lds;
    int base = 0;
    for (int l = 0; l < 2; ++l)
        for (int j = 0; j < 10; ++j) {
            const TJob J = small_job(C, l, j); const int ntile = J.nkt * J.nnt;
            int first = (C.bid - base % C.G + C.G) % C.G;
            for (int t = first; t < ntile; t += C.G) tconv_tile(J, t / J.nnt, t % J.nnt, lds, C.tid);
            base += ntile;
        }
}
constexpr int SM_TILES = 1260, P0_NMOD = 96  , P0_NBALL = 2 * SM_TILES / 8, P0_NB = (SM_TILES + 7) / 8;
struct TDst { bf16_t* dp; int ld; };
DI TDst tconv_ld(const Ctx& C, int t, const int tid, f32x4& a, f32x4& b, float& sc) {
    int l = 0; if (t >= SM_TILES) { l = 1; t -= SM_TILES; }
    int j;
    if (t < 704) j = 0; else if (t < 776) { j = 1; t -= 704; } else if (t < 840) { j = 2; t -= 776; } else if (t < 888) { j = 3; t -= 840; } else if (t < 984) { j = 4; t -= 888; }
    else if (t < 1240) { j = 5; t -= 984; } else if (t < 1244) { j = 6; t -= 1240; } else if (t < 1248) { j = 7; t -= 1244; } else if (t < 1252) { j = 8; t -= 1248; } else { j = 9; t -= 1252; }
    const TJob J = small_job(C, l, j);
    const int kt = t / J.nnt, nt = t - kt * J.nnt; const int k0 = kt * 64, n0 = nt * 64; const int kk = tid >> 3, nn = (tid & 7) * 8;
    a = (f32x4){0.f, 0.f, 0.f, 0.f}; b = a; sc = 1.f;
    if (J.src) { if (n0 + nn < J.Ns) { const float* sp = J.src + (size_t)(k0 + kk) * J.ldsrc + n0 + nn; a = *(const f32x4*)sp; b = *(const f32x4*)(sp + 4); }
                 if (J.kscale) sc = J.kscale[k0 + kk]; }
    TDst r; r.dp = J.dst + (size_t)(J.row0 + n0) * J.lddst + J.col0 + k0; r.ld = J.lddst; return r;
}
DI void tconv_range8(const Ctx& C, int t0) {
    LAS float* lds = (LAS float*)(C.lds + 65536);
    const int tid = C.tid, kk = tid >> 3, nn = (tid & 7) * 8, n = tid >> 3, kq = (tid & 7) * 8;
    f32x4 A0[4], B0[4], A1[4], B1[4]; float s0[4], s1[4]; TDst d0[4], d1[4];
#define TQ_PROC(A, B, S, D) do { \
        _Pragma("unroll") for (int q_ = 0; q_ < 4; ++q_) { LAS float* d_ = lds + q_ * 4160 + kk * 65 + nn; const f32x4 a_ = A[q_] * S[q_], b_ = B[q_] * S[q_]; \
            d_[0] = a_[0]; d_[1] = a_[1]; d_[2] = a_[2]; d_[3] = a_[3]; d_[4] = b_[0]; d_[5] = b_[1]; d_[6] = b_[2]; d_[7] = b_[3]; } \
        __syncthreads(); \
        _Pragma("unroll") for (int q_ = 0; q_ < 4; ++q_) { const LAS float* s_ = lds + q_ * 4160 + kq * 65 + n; \
            u32x4 w_; w_.x = pk2(s_[0], s_[65]); w_.y = pk2(s_[130], s_[195]); w_.z = pk2(s_[260], s_[325]); w_.w = pk2(s_[390], s_[455]); \
            *(u32x4*)(D[q_].dp + (size_t)n * D[q_].ld + kq) = w_; } \
        __syncthreads(); } while (0)
#pragma unroll
    for (int q = 0; q < 4; ++q) d0[q] = tconv_ld(C, t0 + q, tid, A0[q], B0[q], s0[q]);
#pragma unroll
    for (int q = 0; q < 4; ++q) d1[q] = tconv_ld(C, t0 + 4 + q, tid, A1[q], B1[q], s1[q]);
    TQ_PROC(A0, B0, s0, d0);
    TQ_PROC(A1, B1, s1, d1);
#undef TQ_PROC
}
DI void mod_item(const Ctx& C, int item, bool need_sl) {
    LAS float* sl = (LAS float*)C.lds;
    LAS float* red = (LAS float*)(C.lds + 40960);
    const int l = item / 96, col = (item % 96) * 64 + C.lane;
    const int k0 = C.wave * 128;
    const float* W = C.in[4] + (size_t)l * 1024 * 6144 + (size_t)k0 * 6144 + col;
    float wv[128];
#pragma unroll
    for (int k = 0; k < 128; ++k) wv[k] = W[(size_t)k * 6144];
    if (need_sl) { const float* cv = C.in[1]; const float* ccx = C.in[3];
        float tv[18];
#pragma unroll
        for (int q = 0; q < 18; ++q) { const int i = C.tid + q * NTHR; const int s = i >> 10, k = i & 1023; tv[q] = (s < 8) ? cv[s * 1024 + k] : ccx[k]; }
#pragma unroll
        for (int q = 0; q < 18; ++q) sl[C.tid + q * NTHR] = siluf_(tv[q]);
        __syncthreads(); }
    float acc[9];
#pragma unroll
    for (int j = 0; j < 9; ++j) acc[j] = 0.f;
#pragma unroll
    for (int k = 0; k < 128; ++k)
#pragma unroll
        for (int j = 0; j < 9; ++j) acc[j] += sl[j * 1024 + k0 + k] * wv[k];
#pragma unroll
    for (int j = 0; j < 9; ++j) red[(C.wave * 9 + j) * 64 + C.lane] = acc[j];
    __syncthreads();
    for (int o = C.tid; o < 9 * 64; o += NTHR) { const int j = o >> 6, ln = o & 63; float s = 0.f;
        for (int w = 0; w < 8; ++w) s += red[(w * 9 + j) * 64 + ln];
        const int cc = (item % 96) * 64 + ln;
        C.modv(l)[(size_t)j * 6144 + cc] = s + C.in[5][(size_t)l * 6144 + cc]; }
    __syncthreads();
}
DI void phase_p0(const Ctx& C0) {
    LAS int* slot = (LAS int*)(C0.lds + LDS_BYTES - 16);
    bool have_sl = false;
    for (;;) {
        __syncthreads(); if (C0.tid == 0) *slot = atomicAdd(C0.cnt() + 16, 1); __syncthreads();
        const int it = *slot;
#ifdef DIAG_TS
        if (it >= P0_NMOD + P0_NB && C0.tid == 0) atomicMax(((unsigned long long*)(C0.ws + OFF_CNT + 4096)) + 52, (unsigned long long)__builtin_amdgcn_s_memrealtime());
#endif
        if (it >= P0_NMOD + P0_NB) break;
        Ctx C2 = C0; asm volatile("" : "+v"(C2.tid)); C2.lane = C2.tid & 63; C2.wave = __builtin_amdgcn_readfirstlane(C2.tid >> 6); const Ctx& C = C2;
        if (it < P0_NMOD) {
            mod_item(C, it, !have_sl); have_sl = true;
#ifdef DIAG_TS
            if (C.tid == 0) atomicMax(((unsigned long long*)(C.ws + OFF_CNT + 4096)) + 53, (unsigned long long)__builtin_amdgcn_s_memrealtime());
#endif
        } else tconv_range8(C, (it - P0_NMOD) * 8);
    }
}
constexpr int WX_NGU = 2048, WX_NALL = 3072;
DI void wconv_range(const Ctx& C, int l, int t0, int cnt) {
    LAS float* lds = (LAS float*)C.lds;
    const int tid = C.tid, kk = tid >> 3, nn = (tid & 7) * 8, n = tid >> 3, kq = (tid & 7) * 8;
    f32x4 RA[8], RB[8];
#define WX_DEC(t) const int mat_ = (t) >> 6, kt_ = ((t) >> 2) & 15, ng_ = (t) & 3; const int kind_ = (mat_ < 32) ? (mat_ & 1) : 2, e_ = (mat_ < 32) ? (mat_ >> 1) : mat_ - 32
#define WX_LD(R, t) do { WX_DEC(t); \
        const float* p_ = C.in[29 + kind_] + (size_t)(l * 16 + e_) * 1048576 + (size_t)(kt_ * 64 + kk) * 1024 + ng_ * 256 + nn; \
        _Pragma("unroll") for (int j_ = 0; j_ < 4; ++j_) { R[2 * j_] = *(const f32x4*)(p_ + j_ * 64); R[2 * j_ + 1] = *(const f32x4*)(p_ + j_ * 64 + 4); } } while (0)
#define WX_PROC(R, t) do { WX_DEC(t); \
        _Pragma("unroll") for (int j_ = 0; j_ < 4; ++j_) { LAS float* d_ = lds + j_ * 4160 + kk * 65 + nn; \
            d_[0] = R[2 * j_][0]; d_[1] = R[2 * j_][1]; d_[2] = R[2 * j_][2]; d_[3] = R[2 * j_][3]; d_[4] = R[2 * j_ + 1][0]; d_[5] = R[2 * j_ + 1][1]; d_[6] = R[2 * j_ + 1][2]; d_[7] = R[2 * j_ + 1][3]; } \
        __syncthreads(); \
        bf16_t* dst_ = (kind_ < 2) ? (bf16_t*)(C.ws + OFF_WGU2) + (size_t)(e_ * 2048) * 1024 : (bf16_t*)(C.ws + OFF_ARENA + AR_WD) + (size_t)(e_ * 1024) * 1024; \
        _Pragma("unroll") for (int j_ = 0; j_ < 4; ++j_) { const LAS float* s_ = lds + j_ * 4160 + kq * 65 + n; const int nl_ = ng_ * 256 + j_ * 64 + n; \
            const int dr_ = (kind_ == 2) ? nl_ : 8 * (nl_ >> 2) + (nl_ & 3) + (kind_ == 1 ? 4 : 0); \
            u32x4 w_; w_.x = pk2(s_[0], s_[65]); w_.y = pk2(s_[130], s_[195]); w_.z = pk2(s_[260], s_[325]); w_.w = pk2(s_[390], s_[455]); \
            *(u32x4*)(dst_ + (size_t)dr_ * 1024 + kt_ * 64 + kq) = w_; } \
        __syncthreads(); } while (0)
    __syncthreads();
    WX_LD(RA, t0);
    for (int i = 0; i < cnt; i += 2) {
        if (i + 1 < cnt) WX_LD(RB, t0 + i + 1);
        WX_PROC(RA, t0 + i);
        if (i + 2 < cnt) WX_LD(RA, t0 + i + 2);
        if (i + 1 < cnt) WX_PROC(RB, t0 + i + 1);
    }
#undef WX_DEC
#undef WX_LD
#undef WX_PROC
}
DI void phase_wconv_experts(const Ctx& C, int l) {
    LAS int* slot = (LAS int*)(C.lds + LDS_BYTES - 16);
    int* ctr = C.cnt() + 8 + l;
    for (;;) {
        __syncthreads(); if (C.tid == 0) *slot = atomicAdd(ctr, 1); __syncthreads();
        const int bt = *slot; if (bt >= (WX_NALL - WX_NGU) / 4) break;
        wconv_range(C, l, WX_NGU + bt * 4, 4);
    }
}

DI const float* tok_row(const float* lat, const float* ctxp, int tok) { const int b = tok / SB, s = tok - b * SB; return (s < CTXL) ? ctxp + (size_t)(b * CTXL + s) * DM : lat + (size_t)(b * SEQ + s - CTXL) * DM; }

DI void norm_mod_store(const f32x4 (&v)[4], const float* nw, const float* modrow, int shoff, int scoff, bf16_t* dst, int lane) {
    float ss = 0.f;
#pragma unroll
    for (int j = 0; j < 4; ++j) ss += v[j][0] * v[j][0] + v[j][1] * v[j][1] + v[j][2] * v[j][2] + v[j][3] * v[j][3];
    ss = wave_sum(ss);
    const float rstd = rsqrtf(ss * (1.f / 1024.f) + 1e-6f);
#pragma unroll
    for (int j = 0; j < 4; ++j) { const int c = j * 256 + lane * 4;
        const f32x4 w = *(const f32x4*)(nw + c), sc = *(const f32x4*)(modrow + scoff + c), sh = *(const f32x4*)(modrow + shoff + c);
        const f32x4 o = v[j] * rstd * w * (sc + 1.f) + sh;
        u32x2 pkd; pkd.x = pk2(o[0], o[1]); pkd.y = pk2(o[2], o[3]); *(u32x2*)(dst + c) = pkd; }
}

DI void phase_u(const Ctx& C, int l, const float* lat, const float* ctxp) {
    const int gw = C.bid * 8 + C.wave, GW = C.G * 8;
    f32x4 v[4], v2[4];
#define PU_LOAD(V, V2, t_) do { const int t2_ = ((t_) + GW < T) ? (t_) + GW : (t_); const float* xr_ = tok_row(lat, ctxp, (t_)); const float* xr2_ = tok_row(lat, ctxp, t2_); \
        _Pragma("unroll") for (int j_ = 0; j_ < 4; ++j_) { V[j_] = *(const f32x4*)(xr_ + j_ * 256 + C.lane * 4); V2[j_] = *(const f32x4*)(xr2_ + j_ * 256 + C.lane * 4); } } while (0)
    if (gw < T) PU_LOAD(v, v2, gw);
    for (int tok = gw; tok < T; tok += 2 * GW) {
        const int tok2 = (tok + GW < T) ? tok + GW : tok; const int nt = tok + 2 * GW;
        f32x4 n[4], n2[4]; if (nt < T) PU_LOAD(n, n2, nt);
        { const int b = tok / SB, s = tok - b * SB; norm_mod_store(v, C.in[6] + l * 1024, C.modv(l) + (size_t)((s < CTXL) ? 8 : b) * 6144, 0, 1024, C.act() + (size_t)tok * DM, C.lane); }
        if (tok2 != tok) { const int b = tok2 / SB, s = tok2 - b * SB; norm_mod_store(v2, C.in[6] + l * 1024, C.modv(l) + (size_t)((s < CTXL) ? 8 : b) * 6144, 0, 1024, C.act() + (size_t)tok2 * DM, C.lane); }
        if (nt < T) {
#pragma unroll
            for (int j = 0; j < 4; ++j) { v[j] = n[j]; v2[j] = n2[j]; } }
    }
#undef PU_LOAD
}

DI void phase_ret_prep(const Ctx& C) {
    const int gw = C.bid * 8 + C.wave, GW = C.G * 8;
    const int hh = C.lane >> 4, i2 = (C.lane & 15) * 2;
    const f32x4* RT = (const f32x4*)(C.ws + OFF_ROPE);
    for (int tok = gw; tok < T; tok += GW) {
        const int s = tok % SB; bf16_t* pr = C.pbuf() + (size_t)tok * NPC;
        const f32x4 cssn = RT[(s * 32 + i2) >> 1]; const float c0 = cssn[0], s0 = cssn[1], c1 = cssn[2], s1 = cssn[3];
#pragma unroll
        for (int qk = 0; qk < 2; ++qk) { bf16_t* base = pr + (qk ? C_RK : C_RQ) + hh * 64 + i2; const float sc = qk ? 0.125f : 1.f;
            const unsigned a = *(const unsigned*)base, bq = *(const unsigned*)(base + 32);
            const float x10 = lo_f(a), x11 = hi_f(a), x20 = lo_f(bq), x21 = hi_f(bq);
            *(unsigned*)base = pk2((x10 * c0 - x20 * s0) * sc, (x11 * c1 - x21 * s1) * sc);
            *(unsigned*)(base + 32) = pk2((x10 * s0 + x20 * c0) * sc, (x11 * s1 + x21 * c1) * sc); }
    }
}

DI float shift_val(float pc, float pp, float pn, float mu) { return pc + (0.5f * (pp + pn) - pc) * mu; }
DI void phase_rwkv_prep(const Ctx& C, int l, int budget) {
    LAS bf16_t* X = (LAS bf16_t*)C.lds;
    LAS bf16_t* AL = (LAS bf16_t*)(C.lds + 64 * 328 * 2);
    const float* mu = C.in[17] + l * 1088;
    const bf16_t* P = C.pbuf();
    const int wave = C.wave;
    LAS float* Lmu = (LAS float*)(C.lds + 80 * 1024);
    LAS float* Lw0 = Lmu + 1088; LAS float* La0 = Lw0 + 512;
    for (int i = C.tid; i < 1088; i += NTHR) Lmu[i] = mu[i];
    for (int i = C.tid; i < 512; i += NTHR) Lw0[i] = C.in[18][(size_t)l * 512 + i];
    for (int i = C.tid; i < 256; i += NTHR) La0[i] = C.in[20][l * 256 + i];
    __syncthreads();
    bf16x8 wf0[2][2], wf1[2][2], wf2[2][2], wf3[2][4];
    { const int l0 = C.lane;
#pragma unroll
      for (int nt2 = 0; nt2 < 2; ++nt2) { const int row = wave * 32 + nt2 * 16 + (l0 & 15);
#pragma unroll
          for (int ks = 0; ks < 2; ++ks) { wf0[nt2][ks] = *(const bf16x8*)(C.wsm(l, WSM_W2F) + (size_t)row * 64 + ks * 32 + 8 * (l0 >> 4));
              wf1[nt2][ks] = *(const bf16x8*)(C.wsm(l, WSM_W2B) + (size_t)row * 64 + ks * 32 + 8 * (l0 >> 4));
              wf2[nt2][ks] = *(const bf16x8*)(C.wsm(l, WSM_A2) + (size_t)row * 64 + ks * 32 + 8 * (l0 >> 4)); }
#pragma unroll
          for (int ks = 0; ks < 4; ++ks) wf3[nt2][ks] = *(const bf16x8*)(C.wsm(l, WSM_G2) + (size_t)row * 128 + ks * 32 + 8 * (l0 >> 4)); } }
    LAS int* slot = (LAS int*)(C.lds + LDS_BYTES - 16);
    __syncthreads(); if (C.tid == 0) *slot = atomicAdd(C.cnt() + 20 + l, 1); __syncthreads();
    int tile = *slot;
    for (; tile < 544;) {
        --budget; int nxt = 544; if (C.tid == 0 && budget > 0) nxt = atomicAdd(C.cnt() + 20 + l, 1);
        int tid_ = C.tid; asm volatile("" : "+v"(tid_)); const int lane = tid_ & 63;
        const int b = tile / 68, tt = tile % 68; const int s0 = tt * 64; const int tok0 = b * SB + s0;
        const int sfirst = (s0 < CTXL) ? 0 : CTXL, slast = (s0 < CTXL) ? CTXL - 1 : SB - 1;
#ifdef DIAG_TS
#define PSTAMP(k) do { if (l == 0 && tile == C.bid && C.bid == DIAG_BLK && C.tid == 0) ((unsigned long long*)(C.ws + OFF_CNT + 4096))[k] = __builtin_amdgcn_s_memrealtime(); } while (0)
#else
#define PSTAMP(k) do {} while (0)
#endif
        PSTAMP(42);
        { const int ti = tid_ >> 3, s = s0 + ti; const bf16_t* pc = P + (size_t)(tok0 + ti) * NPC + C_RW + 768;
          const bool hp = s > sfirst, hn = s < slast;
          const bf16_t* pp = hp ? pc - NPC : pc; const bf16_t* pn = hn ? pc + NPC : pc;
          u32x4 vc5[5], vp5[5], vn5[5];
#pragma unroll
          for (int jj = 0; jj < 5; ++jj) { const int col = (tid_ & 7) * 8 + 64 * jj; vc5[jj] = *(const u32x4*)(pc + col); vp5[jj] = *(const u32x4*)(pp + col); vn5[jj] = *(const u32x4*)(pn + col); }
          const unsigned mp = hp ? 0xFFFFFFFFu : 0u, mn = hn ? 0xFFFFFFFFu : 0u;
#pragma unroll
          for (int jj = 0; jj < 5; ++jj) { const int col = (tid_ & 7) * 8 + 64 * jj;
              const u32x4 vc = vc5[jj]; u32x4 vp = vp5[jj], vn = vn5[jj];
              vp.x &= mp; vp.y &= mp; vp.z &= mp; vp.w &= mp; vn.x &= mn; vn.y &= mn; vn.z &= mn; vn.w &= mn;
              unsigned o[4];
#pragma unroll
              for (int q = 0; q < 4; ++q) { float a = shift_val(lo_f(vc[q]), lo_f(vp[q]), lo_f(vn[q]), Lmu[768 + col + 2 * q]);
                  float bq = shift_val(hi_f(vc[q]), hi_f(vp[q]), hi_f(vn[q]), Lmu[768 + col + 2 * q + 1]);
                  if (col < 128) { a = 1.f - 2.f / (1.f + __expf(2.f * a)); bq = 1.f - 2.f / (1.f + __expf(2.f * bq)); } else if (col >= 192) { a = sigmoidf_(a); bq = sigmoidf_(bq); }
                  o[q] = pk2(a, bq); }
              *(LAS u32x4*)(X + ti * 328 + col) = (u32x4){o[0], o[1], o[2], o[3]}; } }
        __syncthreads();
        PSTAMP(43);
        const int c4 = lane * 4;
        u32x2 rowv[10][3];
#pragma unroll
        for (int rr = 0; rr < 10; ++rr) { const int sr = s0 + wave * 8 + rr - 1; const bool ok = (sr >= sfirst) && (sr <= slast);
            const bf16_t* pr_ = P + (size_t)(tok0 + wave * 8 + rr - 1) * NPC + C_RW + c4;
#pragma unroll
            for (int part = 0; part < 3; ++part) rowv[rr][part] = ok ? *(const u32x2*)(pr_ + part * 256) : (u32x2){0u, 0u}; }
        {
#pragma unroll
          for (int mat = 0; mat < 4; ++mat) {
              const int xoff = (mat == 3) ? 192 : mat * 64; const int nks = (mat == 3) ? 4 : 2;
#pragma unroll 2
              for (int tg = 0; tg < 4; ++tg) { const int tk = tg * 16 + (lane & 15); const int tok = tok0 + tk;
                  bf16x8 xfr[4];
#pragma unroll
                  for (int ks = 0; ks < 4; ++ks) if (ks < nks) xfr[ks] = *(const LAS bf16x8*)(X + tk * 328 + xoff + ks * 32 + 8 * (lane >> 4));
#pragma unroll
                  for (int nt2 = 0; nt2 < 2; ++nt2) { f32x4 acc = {0.f, 0.f, 0.f, 0.f};
#pragma unroll
                      for (int ks = 0; ks < 4; ++ks) if (ks < nks) acc = __builtin_amdgcn_mfma_f32_16x16x32_bf16(mat == 0 ? wf0[nt2][ks & 1] : mat == 1 ? wf1[nt2][ks & 1] : mat == 2 ? wf2[nt2][ks & 1] : wf3[nt2][ks], xfr[ks], acc, 0, 0, 0);
                      const int n0 = wave * 32 + nt2 * 16 + 4 * (lane >> 4);
                      float o[4];
                      if (mat < 2) { const LAS float* w0 = Lw0 + mat * 256 + n0;
#pragma unroll
                          for (int q = 0; q < 4; ++q) o[q] = 1.f - __expf(-0.606531f * __builtin_amdgcn_rcpf(1.f + __expf(-(w0[q] + acc[q]))));
                          u32x2 w; w.x = pk2(o[0], o[1]); w.y = pk2(o[2], o[3]); *(u32x2*)(C.ops(1 + mat) + (size_t)tok * 256 + n0) = w; }
                      else if (mat == 2) { const LAS float* a0 = La0 + n0;
#pragma unroll
                          for (int q = 0; q < 4; ++q) o[q] = __builtin_amdgcn_rcpf(1.f + __expf(-(a0[q] + acc[q])));
                          u32x2 w; w.x = pk2(o[0], o[1]); w.y = pk2(o[2], o[3]); *(LAS u32x2*)(AL + tk * 264 + n0) = w; }
                      else { u32x2 w; w.x = pk2(acc[0], acc[1]); w.y = pk2(acc[2], acc[3]); *(u32x2*)(C.ops(3) + (size_t)tok * 256 + n0) = w; } } } } }
        __syncthreads();
        PSTAMP(44);
        {
          const f32x4 mur = *(const f32x4*)(mu + c4), muk = *(const f32x4*)(mu + 256 + c4), muv = *(const f32x4*)(mu + 512 + c4);
          const f32x4 kkw = *(const f32x4*)(C.in[23] + l * 256 + c4), kaw = *(const f32x4*)(C.in[24] + l * 256 + c4), rkw = *(const f32x4*)(C.in[25] + l * 256 + c4);
#pragma unroll
          for (int q8 = 0; q8 < 8; ++q8) { const int ti = wave * 8 + q8, tok = tok0 + ti;
              f32x4 rs, ks_, vs;
#pragma unroll
              for (int part = 0; part < 3; ++part) { const u32x2 vc = rowv[q8 + 1][part], vp = rowv[q8][part], vn = rowv[q8 + 2][part];
                  const f32x4 m = part == 0 ? mur : part == 1 ? muk : muv; f32x4 o;
                  o[0] = shift_val(lo_f(vc.x), lo_f(vp.x), lo_f(vn.x), m[0]); o[1] = shift_val(hi_f(vc.x), hi_f(vp.x), hi_f(vn.x), m[1]);
                  o[2] = shift_val(lo_f(vc.y), lo_f(vp.y), lo_f(vn.y), m[2]); o[3] = shift_val(hi_f(vc.y), hi_f(vp.y), hi_f(vn.y), m[3]);
                  if (part == 0) rs = o; else if (part == 1) ks_ = o; else vs = o; }
              const u32x2 aw = *(const LAS u32x2*)(AL + ti * 264 + c4); const f32x4 a = {lo_f(aw.x), hi_f(aw.x), lo_f(aw.y), hi_f(aw.y)};
              f32x4 kk = ks_ * kkw; float nn = kk[0] * kk[0] + kk[1] * kk[1] + kk[2] * kk[2] + kk[3] * kk[3]; nn = row16_sum(nn);
              kk = kk * rsqrtf(fmaxf(nn, 1e-24f));
              const f32x4 kp = ks_ * ((a - 1.f) * kaw + 1.f); const f32x4 bb = kk * a;
              float bon = rs[0] * kp[0] * rkw[0] + rs[1] * kp[1] * rkw[1] + rs[2] * kp[2] * rkw[2] + rs[3] * kp[3] * rkw[3]; bon = row16_sum(bon);
              if ((lane & 15) == 0) C.bonus()[(size_t)tok * 4 + (lane >> 4)] = bon;
              bf16_t* ar = C.act() + (size_t)tok * DM + c4;
              u32x2 w; w.x = pk2(rs[0], rs[1]); w.y = pk2(rs[2], rs[3]); *(u32x2*)(ar) = w;
              w.x = pk2(kp[0], kp[1]); w.y = pk2(kp[2], kp[3]); *(u32x2*)(ar + 256) = w;
              w.x = pk2(vs[0], vs[1]); w.y = pk2(vs[2], vs[3]); *(u32x2*)(ar + 512) = w;
              w.x = pk2(bb[0], bb[1]); w.y = pk2(bb[2], bb[3]); *(u32x2*)(ar + 768) = w;
              w.x = pk2(kk[0], kk[1]); w.y = pk2(kk[2], kk[3]); *(u32x2*)(C.ops(0) + (size_t)tok * 256 + c4) = w; } }
        if (C.tid == 0) *slot = nxt;
        __syncthreads();
        tile = *slot;
        PSTAMP(45);
    }
}

DI float row8_sum(float x) { x += dpp_mov<0xB1>(x); x += dpp_mov<0x4E>(x); x += dpp_mov<0x141>(x); return x; }
struct QKTok { u32x4 cq, ckv, qn, kn, at; unsigned qr1, qr2, kr1, kr2, rq1, rq2, rk1, rk2; f32x4 rt; };
DI void qk_load(const Ctx& C, int tok, int lane, QKTok& R) {
    const int h = lane >> 3, sub = lane & 7; const int s = tok % SB;
    const bf16_t* pr = C.pbuf() + (size_t)tok * NPC; const bf16_t* qr = C.qkv() + (size_t)tok * QKVC;
    R.cq = (lane < 48) ? *(const u32x4*)(pr + lane * 8) : (u32x4){0u, 0u, 0u, 0u};
    R.ckv = (lane < 32) ? *(const u32x4*)(pr + 384 + lane * 8) : (u32x4){0u, 0u, 0u, 0u};
    R.qn = *(const u32x4*)(qr + h * 96 + sub * 8); R.qr1 = *(const unsigned*)(qr + h * 96 + 64 + 2 * sub); R.qr2 = *(const unsigned*)(qr + h * 96 + 80 + 2 * sub);
    R.kn = *(const u32x4*)(qr + 768 + h * 128 + sub * 8); R.kr1 = *(const unsigned*)(pr + C_KR + 2 * sub); R.kr2 = *(const unsigned*)(pr + C_KR + 16 + 2 * sub);
    R.at = *(const u32x4*)(C.ws + OFF_ROPE + ROPE_AT + ((size_t)((s >= CTXL) ? s - CTXL : 0) * 16 + 2 * sub) * 8);
    const int hh = lane >> 4, i2 = (lane & 15) * 2;
    R.rq1 = *(const unsigned*)(pr + C_RQ + hh * 64 + i2); R.rq2 = *(const unsigned*)(pr + C_RQ + hh * 64 + 32 + i2);
    R.rk1 = *(const unsigned*)(pr + C_RK + hh * 64 + i2); R.rk2 = *(const unsigned*)(pr + C_RK + hh * 64 + 32 + i2);
    R.rt = ((const f32x4*)(C.ws + OFF_ROPE))[(s * 32 + i2) >> 1];
}
DI float ssq4(u32x4 w) { float a = 0.f;
#pragma unroll
    for (int q = 0; q < 4; ++q) a += lo_f(w[q]) * lo_f(w[q]) + hi_f(w[q]) * hi_f(w[q]); return a; }
DI void qk_compute_store(const Ctx& C, int l, int tok, int lane, const QKTok& R, const float (&qgn)[8], const float (&kgn)[8], const float (&qgr)[4], const float (&kgr)[4]) {
    const int h = lane >> 3, sub = lane & 7;
    bf16_t* pr = C.pbuf() + (size_t)tok * NPC; bf16_t* qr = C.qkv() + (size_t)tok * QKVC; bf16_t* kr = C.kf() + (size_t)tok * 768;
    const float QS = 0.10206207261596577f * 1.4426950408889634f;
    const float sq = wave_sum(ssq4(R.cq)), sk = wave_sum(ssq4(R.ckv));
    const float rq = rsqrtf(sq * (1.f / 384.f) + 1e-6f), rk = rsqrtf(sk * (1.f / 256.f) + 1e-6f);
    const bool lat_ = (tok % SB) >= CTXL;
    const float cs0 = lat_ ? __uint_as_float(R.at[0]) : 1.f, sn0 = lat_ ? __uint_as_float(R.at[1]) : 0.f, cs1 = lat_ ? __uint_as_float(R.at[2]) : 1.f, sn1 = lat_ ? __uint_as_float(R.at[3]) : 0.f;
    { float n[8];
#pragma unroll
      for (int q = 0; q < 4; ++q) { n[2 * q] = lo_f(R.qn[q]) * rq; n[2 * q + 1] = hi_f(R.qn[q]) * rq; }
      const float a0 = lo_f(R.qr1) * rq, a1 = hi_f(R.qr1) * rq, b0 = lo_f(R.qr2) * rq, b1 = hi_f(R.qr2) * rq;
      float ss = a0 * a0 + a1 * a1 + b0 * b0 + b1 * b1;
#pragma unroll
      for (int q = 0; q < 8; ++q) ss += n[q] * n[q];
      ss = row8_sum(ss); const float rs = rsqrtf(ss * (1.f / 96.f) + 1e-6f) * QS;
      u32x4 w;
#pragma unroll
      for (int q = 0; q < 4; ++q) w[q] = pk2(n[2 * q] * rs * qgn[2 * q], n[2 * q + 1] * rs * qgn[2 * q + 1]);
      *(u32x4*)(qr + h * 96 + sub * 8) = w;
      const float x0 = a0 * rs * qgr[0], x1 = a1 * rs * qgr[1], y0 = b0 * rs * qgr[2], y1 = b1 * rs * qgr[3];
      *(unsigned*)(qr + h * 96 + 64 + 2 * sub) = pk2(x0 * cs0 - y0 * sn0, x1 * cs1 - y1 * sn1);
      *(unsigned*)(qr + h * 96 + 80 + 2 * sub) = pk2(x0 * sn0 + y0 * cs0, x1 * sn1 + y1 * cs1); }
    { float n[8];
#pragma unroll
      for (int q = 0; q < 4; ++q) { n[2 * q] = lo_f(R.kn[q]) * rk; n[2 * q + 1] = hi_f(R.kn[q]) * rk; }
      const float a0 = lo_f(R.kr1), a1 = hi_f(R.kr1), b0 = lo_f(R.kr2), b1 = hi_f(R.kr2);
      float ss = a0 * a0 + a1 * a1 + b0 * b0 + b1 * b1;
#pragma unroll
      for (int q = 0; q < 8; ++q) ss += n[q] * n[q];
      ss = row8_sum(ss); const float rs = rsqrtf(ss * (1.f / 96.f) + 1e-6f);
      u32x4 w;
#pragma unroll
      for (int q = 0; q < 4; ++q) w[q] = pk2(n[2 * q] * rs * kgn[2 * q], n[2 * q + 1] * rs * kgn[2 * q + 1]);
      *(u32x4*)(kr + h * 96 + sub * 8) = w;
      const float x0 = a0 * rs * kgr[0], x1 = a1 * rs * kgr[1], y0 = b0 * rs * kgr[2], y1 = b1 * rs * kgr[3];
      *(unsigned*)(kr + h * 96 + 64 + 2 * sub) = pk2(x0 * cs0 - y0 * sn0, x1 * cs1 - y1 * sn1);
      *(unsigned*)(kr + h * 96 + 80 + 2 * sub) = pk2(x0 * sn0 + y0 * cs0, x1 * sn1 + y1 * cs1); }
    { const int hh = lane >> 4, i2 = (lane & 15) * 2; const float c0 = R.rt[0], s0 = R.rt[1], c1 = R.rt[2], s1 = R.rt[3];
      { const float x10 = lo_f(R.rq1), x11 = hi_f(R.rq1), x20 = lo_f(R.rq2), x21 = hi_f(R.rq2);
        *(unsigned*)(pr + C_RQ + hh * 64 + i2) = pk2(x10 * c0 - x20 * s0, x11 * c1 - x21 * s1);
        *(unsigned*)(pr + C_RQ + hh * 64 + 32 + i2) = pk2(x10 * s0 + x20 * c0, x11 * s1 + x21 * c1); }
      { const float x10 = lo_f(R.rk1), x11 = hi_f(R.rk1), x20 = lo_f(R.rk2), x21 = hi_f(R.rk2);
        *(unsigned*)(pr + C_RK + hh * 64 + i2) = pk2((x10 * c0 - x20 * s0) * 0.125f, (x11 * c1 - x21 * s1) * 0.125f);
        *(unsigned*)(pr + C_RK + hh * 64 + 32 + i2) = pk2((x10 * s0 + x20 * c0) * 0.125f, (x11 * s1 + x21 * c1) * 0.125f); } }
}
DI void phase_qk_final(const Ctx& C, int l) {
    const int gw = C.bid * 8 + C.wave, GW = C.G * 8, lane = C.lane, sub = lane & 7;
    float qgn[8], kgn[8], qgr[4], kgr[4];
    { const float* qg = C.in[13] + l * 96; const float* kg = C.in[14] + l * 96;
#pragma unroll
      for (int q = 0; q < 8; ++q) { qgn[q] = qg[sub * 8 + q]; kgn[q] = kg[sub * 8 + q]; }
      qgr[0] = qg[64 + 2 * sub]; qgr[1] = qg[65 + 2 * sub]; qgr[2] = qg[80 + 2 * sub]; qgr[3] = qg[81 + 2 * sub];
      kgr[0] = kg[64 + 2 * sub]; kgr[1] = kg[65 + 2 * sub]; kgr[2] = kg[80 + 2 * sub]; kgr[3] = kg[81 + 2 * sub]; }
    QKTok A, B;
    int tok = gw;
    if (tok < T) qk_load(C, tok, lane, A);
    for (; tok < T; tok += 2 * GW) {
        const int tok2 = tok + GW; const bool has2 = tok2 < T;
        if (has2) qk_load(C, tok2, lane, B);
        qk_compute_store(C, l, tok, lane, A, qgn, kgn, qgr, kgr);
        if (tok2 + GW < T) qk_load(C, tok2 + GW, lane, A);
        if (has2) qk_compute_store(C, l, tok2, lane, B, qgn, kgn, qgr, kgr);
    }
}

namespace att {
constexpr int KVBLK = 64; constexpr int SHM_V = 64 * 128 * 2, SHM_K = 64 * 256;
#define KSWZ(row, colB) ((row) * 256 + ((colB) ^ (((row) & 7) << 4)))
#define SBAR() __builtin_amdgcn_sched_barrier(0)
DI int crow(int r, int hi) { return (r & 3) + 8 * (r >> 2) + 4 * hi; }
DI void partialSM(f32x16& p0, f32x16& p1) {
#pragma unroll
    for (int r = 0; r < 16; ++r) p0[r] = __builtin_amdgcn_exp2f(p0[r]);
}
DI void finishSM(f32x16& p0, f32x16& p1, float& l_reg, bf16x8& pa0, bf16x8& pa1, bf16x8& pa2, bf16x8& pa3) {
#pragma unroll
    for (int r = 0; r < 16; ++r) p1[r] = __builtin_amdgcn_exp2f(p1[r]);
    float ps = 0;
#pragma unroll
    for (int r = 0; r < 16; ++r) ps += p0[r];
#pragma unroll
    for (int r = 0; r < 16; ++r) ps += p1[r];
    l_reg += ps;
#define PK4(P, BASE, OUT) do { unsigned a0 = pk2(P[BASE + 0], P[BASE + 1]), a1 = pk2(P[BASE + 2], P[BASE + 3]);   \
    unsigned b0 = pk2(P[BASE + 4], P[BASE + 5]), b1 = pk2(P[BASE + 6], P[BASE + 7]);                              \
    auto r0 = __builtin_amdgcn_permlane32_swap(a0, b0, false, false); auto r1 = __builtin_amdgcn_permlane32_swap(a1, b1, false, false); \
    u32x4 w = {r0[0], r1[0], r0[1], r1[1]}; OUT = __builtin_bit_cast(bf16x8, w); } while (0)
    PK4(p0, 0, pa0); PK4(p0, 8, pa1); PK4(p1, 0, pa2); PK4(p1, 8, pa3);
#undef PK4
}
DI void qkt(f32x16& p0, f32x16& p1, const LAS char* Ks, const bf16x8* qr, int r32, int hi, float negM) {
#pragma unroll
    for (int r = 0; r < 16; ++r) { p0[r] = negM; p1[r] = negM; }
#pragma unroll
    for (int d0 = 0; d0 < 6; ++d0) { const int cb = (d0 * 16 + hi * 8) * 2;
        const bf16x8 b0 = *(const LAS bf16x8*)(Ks + KSWZ(r32, cb));
        const bf16x8 b1 = *(const LAS bf16x8*)(Ks + KSWZ(32 + r32, cb));
        p0 = __builtin_amdgcn_mfma_f32_32x32x16_bf16(b0, qr[d0], p0, 0, 0, 0);
        p1 = __builtin_amdgcn_mfma_f32_32x32x16_bf16(b1, qr[d0], p1, 0, 0, 0); }
}
DI int v_st(int k, int c) { const int kk = (k & ~0xC) | ((k & 4) << 1) | ((k & 8) >> 1); return ((kk >> 3) * 4 + (c >> 5)) * 512 + ((kk & 7) * 32 + (c & 31)) * 2; }
DI int v_rd_base(int lane) { return ((lane & 3) << 3) | (((lane >> 2) & 3) << 6) | (((lane >> 4) & 1) << 5) | (((lane >> 5) & 1) << 8); }
constexpr int v_rd_off(int d0, int ks, int half) { return d0 * 512 + ks * 4096 + half * 2048; }
template <int OFF> DI s16x4 tr_read(int vb) { s16x4 r; asm volatile("ds_read_b64_tr_b16 %0, %1 offset:%2" : "=&v"(r) : "v"(vb), "i"(OFF) : "memory"); return r; }
template <int D0> DI void pv_one(f32x16& od, int vb, bf16x8 pa0, bf16x8 pa1, bf16x8 pa2, bf16x8 pa3) {
    const s16x4 l0 = tr_read<v_rd_off(D0, 0, 0)>(vb), h0 = tr_read<v_rd_off(D0, 0, 1)>(vb), l1 = tr_read<v_rd_off(D0, 1, 0)>(vb), h1 = tr_read<v_rd_off(D0, 1, 1)>(vb);
    const s16x4 l2 = tr_read<v_rd_off(D0, 2, 0)>(vb), h2 = tr_read<v_rd_off(D0, 2, 1)>(vb), l3 = tr_read<v_rd_off(D0, 3, 0)>(vb), h3 = tr_read<v_rd_off(D0, 3, 1)>(vb);
    asm volatile("s_waitcnt lgkmcnt(0)" ::: "memory"); SBAR();
#define PKV(L, H) (bf16x8){L[0], L[1], L[2], L[3], H[0], H[1], H[2], H[3]}
    od = __builtin_amdgcn_mfma_f32_32x32x16_bf16(pa0, PKV(l0, h0), od, 0, 0, 0);
    od = __builtin_amdgcn_mfma_f32_32x32x16_bf16(pa1, PKV(l1, h1), od, 0, 0, 0);
    od = __builtin_amdgcn_mfma_f32_32x32x16_bf16(pa2, PKV(l2, h2), od, 0, 0, 0);
    od = __builtin_amdgcn_mfma_f32_32x32x16_bf16(pa3, PKV(l3, h3), od, 0, 0, 0);
#undef PKV
}
constexpr int LDQ = QKVC, LDK = 768, LDV = QKVC, LDO = NPC;
DI void attn_body(const bf16_t* __restrict__ Qb, const bf16_t* __restrict__ Kh, const bf16_t* __restrict__ Vh, bf16_t* __restrict__ Ob, int seq, LAS char* lds, const int tid, const float negM) {
    const int wid = tid >> 6, lane = tid & 63, r32 = lane & 31, hi = lane >> 5;
    LAS char* V_lds = lds; LAS char* K_lds = lds + 2 * SHM_V;
    LAS float* wsl = (LAS float*)(lds + 2 * SHM_V + 2 * SHM_K) + wid * 64; LAS float* li_l = wsl;
    float l_reg = 0; f32x16 o[2]; bf16x8 qr[6];
#pragma unroll
    for (int d = 0; d < 2; ++d)
#pragma unroll
        for (int r = 0; r < 16; ++r) o[d][r] = 0.f;
    const bf16_t* Qw = Qb + (size_t)(wid * 32 + r32) * LDQ + hi * 8;
#pragma unroll
    for (int d0 = 0; d0 < 6; ++d0) qr[d0] = *(const bf16x8*)(Qw + d0 * 16);
    const int kc1 = tid, kc2 = 512 + (tid & 255);
    const int kr1 = kc1 / 12, kq1 = kc1 % 12, kr2 = kc2 / 12, kq2 = kc2 % 12;
    const int vr = tid >> 3, vq = (tid & 7) * 8, vst = v_st(vr, vq);
    const int vb0 = (int)(uintptr_t)V_lds + v_rd_base(lane);
    struct { bf16x8 k1, k2, v; } sr_[2];
#define SLOAD(i, k0) do { sr_[i].k1 = *(const bf16x8*)(Kh + (size_t)((k0) + kr1) * LDK + kq1 * 8); sr_[i].k2 = *(const bf16x8*)(Kh + (size_t)((k0) + kr2) * LDK + kq2 * 8); \
    sr_[i].v = *(const bf16x8*)(Vh + (size_t)((k0) + vr) * LDV + vq); } while (0)
#define SWRITE(b, i) do { *(LAS bf16x8*)(V_lds + (b) * SHM_V + vst) = sr_[i].v; \
    *(LAS bf16x8*)(K_lds + (b) * SHM_K + KSWZ(kr1, kq1 * 16)) = sr_[i].k1; *(LAS bf16x8*)(K_lds + (b) * SHM_K + KSWZ(kr2, kq2 * 16)) = sr_[i].k2; } while (0)
#define SWAIT() asm volatile("s_waitcnt vmcnt(3)" ::: "memory")
    f32x16 pA0, pA1, pB0, pB1; bf16x8 pa0, pa1, pa2, pa3; const int NT = seq / KVBLK;
    constexpr int SE = 0, SO = 1;
    SLOAD(SE, 0); asm volatile("s_waitcnt vmcnt(0)" ::: "memory"); SWRITE(0, SE); __syncthreads();
    qkt(pA0, pA1, K_lds, qr, r32, hi, negM); partialSM(pA0, pA1);
    SLOAD(SO, KVBLK); if (2 < NT) SLOAD(SE, 2 * KVBLK);
    SWAIT(); SWRITE(1, SO); __syncthreads();
    for (int j = 1; j + 1 < NT; j += 2) {
        SBAR(); qkt(pB0, pB1, K_lds + SHM_K, qr, r32, hi, negM);
        finishSM(pA0, pA1, l_reg, pa0, pa1, pa2, pa3); SBAR();
        SLOAD(SO, (j + 2) * KVBLK); SBAR();
        pv_one<0>(o[0], vb0, pa0, pa1, pa2, pa3); pv_one<1>(o[1], vb0, pa0, pa1, pa2, pa3); partialSM(pB0, pB1);
        __syncthreads(); SWAIT(); SWRITE(0, SE);
        __syncthreads();
        SBAR(); qkt(pA0, pA1, K_lds, qr, r32, hi, negM);
        finishSM(pB0, pB1, l_reg, pa0, pa1, pa2, pa3); SBAR();
        if (j + 3 < NT) SLOAD(SE, (j + 3) * KVBLK); else SLOAD(SE, 0); SBAR();
        pv_one<0>(o[0], vb0 + SHM_V, pa0, pa1, pa2, pa3); pv_one<1>(o[1], vb0 + SHM_V, pa0, pa1, pa2, pa3); partialSM(pA0, pA1);
        __syncthreads(); SWAIT(); SWRITE(1, SO);
        __syncthreads();
    }
    SBAR(); qkt(pB0, pB1, K_lds + SHM_K, qr, r32, hi, negM);
    finishSM(pA0, pA1, l_reg, pa0, pa1, pa2, pa3); SBAR();
    pv_one<0>(o[0], vb0, pa0, pa1, pa2, pa3); pv_one<1>(o[1], vb0, pa0, pa1, pa2, pa3); partialSM(pB0, pB1);
    __syncthreads();
    finishSM(pB0, pB1, l_reg, pa0, pa1, pa2, pa3); SBAR();
    pv_one<0>(o[0], vb0 + SHM_V, pa0, pa1, pa2, pa3); pv_one<1>(o[1], vb0 + SHM_V, pa0, pa1, pa2, pa3);
    { auto rr = __builtin_amdgcn_permlane32_swap(__float_as_uint(l_reg), __float_as_uint(l_reg), false, false); l_reg = __uint_as_float(rr[0]) + __uint_as_float(rr[1]); }
    if (hi == 0) li_l[r32] = l_reg; asm volatile("s_waitcnt lgkmcnt(0)" ::: "memory");
    float rli[16];
#pragma unroll
    for (int r = 0; r < 16; ++r) rli[r] = __builtin_amdgcn_rcpf(li_l[crow(r, hi)]);
    bf16_t* Ow = Ob + (size_t)(wid * 32) * LDO;
#pragma unroll
    for (int r = 0; r < 16; ++r) { const int orow = crow(r, hi);
#pragma unroll
        for (int d0 = 0; d0 < 2; ++d0) Ow[(size_t)orow * LDO + d0 * 32 + r32] = f2bf(o[d0][r] * rli[r]); }
    asm volatile("s_waitcnt vmcnt(0)" ::: "memory");
    __syncthreads();
#undef SLOAD
#undef SWRITE
#undef SWAIT
}
}

DI int scan_tok(int base, int dir, int n) { return base + (dir == 0 ? n : (n < CTXL ? (CTXL - 1 - n) : (SB + CTXL - 1 - n))); }
DI void cvt8(const bf16x8 v, float (&f)[8]) {
    const u32x4 w = __builtin_bit_cast(u32x4, v);
    f[0] = lo_f(w.x); f[1] = hi_f(w.x); f[2] = lo_f(w.y); f[3] = hi_f(w.y); f[4] = lo_f(w.z); f[5] = hi_f(w.z); f[6] = lo_f(w.w); f[7] = hi_f(w.w);
}
DI float row16_sum1(float x) {
    asm("s_nop 1\n\t"
        "v_add_f32_dpp %0, %0, %0 quad_perm:[1,0,3,2] row_mask:0xf bank_mask:0xf bound_ctrl:1\n\t"
        "s_nop 1\n\t"
        "v_add_f32_dpp %0, %0, %0 quad_perm:[2,3,0,1] row_mask:0xf bank_mask:0xf bound_ctrl:1\n\t"
        "s_nop 1\n\t"
        "v_add_f32_dpp %0, %0, %0 row_half_mirror row_mask:0xf bank_mask:0xf bound_ctrl:1\n\t"
        "s_nop 1\n\t"
        "v_add_f32_dpp %0, %0, %0 row_mirror row_mask:0xf bank_mask:0xf bound_ctrl:1\n\t"
        "s_nop 0"
        : "+v"(x));
    return x;
}
DI void row16_sum4(float& a, float& b, float& c, float& d) {
#define R4_(MODE) "v_add_f32_dpp %0, %0, %0 " MODE " row_mask:0xf bank_mask:0xf bound_ctrl:1\n\t" "v_add_f32_dpp %1, %1, %1 " MODE " row_mask:0xf bank_mask:0xf bound_ctrl:1\n\t" \
                  "v_add_f32_dpp %2, %2, %2 " MODE " row_mask:0xf bank_mask:0xf bound_ctrl:1\n\t" "v_add_f32_dpp %3, %3, %3 " MODE " row_mask:0xf bank_mask:0xf bound_ctrl:1\n\t"
    asm("s_nop 1\n\t" R4_("quad_perm:[1,0,3,2]") R4_("quad_perm:[2,3,0,1]") R4_("row_half_mirror") R4_("row_mirror") "s_nop 0" : "+v"(a), "+v"(b), "+v"(c), "+v"(d));
#undef R4_
}
DI void rwkv_scan_item(const Ctx& C, int b, int h, int dir, int half) {
    constexpr int TC = 32, ARR = TC * 64;
    LAS float* buf = (LAS float*)C.lds;
    LAS float* yL = (LAS float*)(C.lds + 2 * 6 * ARR * 4);
    const int tid = C.tid, i0 = tid >> 4, cgp = tid & 15;
    const int base = b * SB;
    const bf16_t* ACT = C.act(); const bf16_t* O0 = C.ops(0); const bf16_t* OW = C.ops(1 + dir);
    bf16_t* ydst = C.pbuf() + (dir ? C_YB : C_YF) + h * 64 + half * 32;
    f32x2 S01 = {0.f, 0.f}, S23 = {0.f, 0.f};
    const int sidx = tid & 255, sti = sidx >> 3, spart = sidx & 7, styp = tid >> 8;
    bf16x8 la, lb, lc, ld; la = lb = lc = ld = (bf16x8){0, 0, 0, 0, 0, 0, 0, 0};
#define RW_LOAD(c) do { const int tk = scan_tok(base, dir, (c) * TC + sti); const bf16_t* ar = ACT + (size_t)tk * DM + h * 64 + spart * 8; \
        la = *(const bf16x8*)(ar + (styp ? 256 : 0)); \
        lb = styp ? *(const bf16x8*)(OW + (size_t)tk * 256 + h * 64 + spart * 8) : *(const bf16x8*)(ar + 512); \
        if (styp == 0) { lc = *(const bf16x8*)(O0 + (size_t)tk * 256 + h * 64 + spart * 8); ld = *(const bf16x8*)(ar + 768); } } while (0)
#define RW_WRITE(nb) do { LAS float* B = buf + (nb) * 6 * ARR; float f[8]; const int o = sti * 64 + spart * 8; \
        cvt8(la, f); { LAS float* d = B + (styp ? 3 : 4) * ARR + o; *(LAS f32x4*)d = (f32x4){f[0], f[1], f[2], f[3]}; *(LAS f32x4*)(d + 4) = (f32x4){f[4], f[5], f[6], f[7]}; } \
        cvt8(lb, f); if (styp) { LAS float* d = B + 1 * ARR + o; *(LAS f32x4*)d = (f32x4){1.f - f[0], 1.f - f[1], 1.f - f[2], 1.f - f[3]}; *(LAS f32x4*)(d + 4) = (f32x4){1.f - f[4], 1.f - f[5], 1.f - f[6], 1.f - f[7]}; } \
        else { LAS float* d = B + 5 * ARR + o; *(LAS f32x4*)d = (f32x4){f[0], f[1], f[2], f[3]}; *(LAS f32x4*)(d + 4) = (f32x4){f[4], f[5], f[6], f[7]}; } \
        if (styp == 0) { cvt8(lc, f); { LAS float* d = B + 0 * ARR + o; *(LAS f32x4*)d = (f32x4){f[0], f[1], f[2], f[3]}; *(LAS f32x4*)(d + 4) = (f32x4){f[4], f[5], f[6], f[7]}; } \
            cvt8(ld, f); { LAS float* d = B + 2 * ARR + o; *(LAS f32x4*)d = (f32x4){f[0], f[1], f[2], f[3]}; *(LAS f32x4*)(d + 4) = (f32x4){f[4], f[5], f[6], f[7]}; } } } while (0)
    constexpr int NCH = SB / TC;
    RW_LOAD(0); RW_WRITE(0); __syncthreads();
    for (int c = 0; c < NCH; ++c) {
        const int cur = c & 1;
        if (c + 1 < NCH) RW_LOAD(c + 1);
        const LAS float* B = buf + cur * 6 * ARR;
        const LAS float* Bq = B + cgp * 4; const LAS float* Bv = B + 5 * ARR + half * 32 + i0;
        float yk = 0.f;
#define RW_FETCH(P, t) const f32x4 P##kk = *(const LAS f32x4*)(Bq + (t) * 64), P##w = *(const LAS f32x4*)(Bq + ARR + (t) * 64), P##b = *(const LAS f32x4*)(Bq + 2 * ARR + (t) * 64), \
            P##k = *(const LAS f32x4*)(Bq + 3 * ARR + (t) * 64), P##r = *(const LAS f32x4*)(Bq + 4 * ARR + (t) * 64); const float P##v = Bv[(t) * 64]
#define RW_STEP(P, YP) do { const f32x2 kk01 = {P##kk[0], P##kk[1]}, kk23 = {P##kk[2], P##kk[3]}, w01 = {P##w[0], P##w[1]}, w23 = {P##w[2], P##w[3]}, b01 = {P##b[0], P##b[1]}, b23 = {P##b[2], P##b[3]}, \
                k01 = {P##k[0], P##k[1]}, k23 = {P##k[2], P##k[3]}, r01 = {P##r[0], P##r[1]}, r23 = {P##r[2], P##r[3]}; \
            const f32x2 d2 = S01 * kk01 + S23 * kk23; const float d = row16_sum1(d2.x + d2.y); \
            S01 = S01 * w01 + (k01 * P##v - b01 * d); S23 = S23 * w23 + (k23 * P##v - b23 * d); \
            const f32x2 y2 = S01 * r01 + S23 * r23; YP = y2.x + y2.y; } while (0)
#pragma unroll 1
        for (int g = 0; g < TC / 16; ++g) {
#pragma unroll 1
            for (int tt = 0; tt < 16; tt += 4) { const int t = g * 16 + tt;
                float y0, y1, y2_, y3;
                RW_FETCH(a_, t); RW_FETCH(b_, t + 1);
                __builtin_amdgcn_sched_barrier(0);
                RW_STEP(a_, y0);
                RW_FETCH(c_, t + 2);
                __builtin_amdgcn_sched_barrier(0);
                RW_STEP(b_, y1);
                RW_FETCH(d_, t + 3);
                __builtin_amdgcn_sched_barrier(0);
                RW_STEP(c_, y2_);
                __builtin_amdgcn_sched_barrier(0);
                RW_STEP(d_, y3);
                row16_sum4(y0, y1, y2_, y3);
                const int q = cgp - tt; yk = (q == 0) ? y0 : (q == 1) ? y1 : (q == 2) ? y2_ : (q == 3) ? y3 : yk; }
            yL[(g * 16 + cgp) * 32 + i0] = yk;
        }
#undef RW_FETCH
#undef RW_STEP
        __syncthreads();
        { const int ti = tid >> 4, c2 = (tid & 15) * 2; const f32x2 y = *(const LAS f32x2*)(yL + ti * 32 + c2);
          const int tk = scan_tok(base, dir, c * TC + ti);
          *(unsigned*)(ydst + (size_t)tk * NPC + c2) = pk2(y[0], y[1]); }
        if (c + 1 < NCH) RW_WRITE(cur ^ 1);
        __syncthreads();
    }
#undef RW_LOAD
#undef RW_WRITE
}

namespace rk {
constexpr int RAW_BYTES = 64 * 6 * 64 * 2;
constexpr int SL_KK = 0, SL_R = 2304, SL_K = 4608, SL_B = 6912, SL_KT = 9216, SL_BT = 11776, SL_VT = 14336, SL_P16 = 16896, SL_ABF = 17152,
              SL_T = 18304, SL_AK = 18944, SL_GK = 19584, SL_GB = 20224, SLOT = 20992;
typedef short s16x4v __attribute__((ext_vector_type(4)));
DI s16x4v pack4(const f32x4 v) { u32x2 w; w.x = pk2(v[0], v[1]); w.y = pk2(v[2], v[3]); return __builtin_bit_cast(s16x4v, w); }
DI f32x4 mm16(const s16x4v a, const s16x4v b, const f32x4 c) { return __builtin_amdgcn_mfma_f32_16x16x16bf16_1k(a, b, c, 0, 0, 0); }
DI void prep(LAS unsigned char* lds, int q, int lane) {
    const LAS bf16_t* raw = (const LAS bf16_t*)lds + (size_t)(16 * q) * 384;
    LAS unsigned char* sl = lds + RAW_BYTES + q * SLOT;
    LAS bf16_t* KKs = (LAS bf16_t*)(sl + SL_KK); LAS bf16_t* Rs = (LAS bf16_t*)(sl + SL_R); LAS bf16_t* Ks = (LAS bf16_t*)(sl + SL_K); LAS bf16_t* Bs = (LAS bf16_t*)(sl + SL_B);
    LAS bf16_t* KT = (LAS bf16_t*)(sl + SL_KT); LAS bf16_t* BT = (LAS bf16_t*)(sl + SL_BT); LAS bf16_t* VT = (LAS bf16_t*)(sl + SL_VT);
    LAS float* P16 = (LAS float*)(sl + SL_P16); LAS float* Abf = (LAS float*)(sl + SL_ABF);
    LAS bf16_t* Tb = (LAS bf16_t*)(sl + SL_T); LAS bf16_t* AKb = (LAS bf16_t*)(sl + SL_AK); LAS bf16_t* GKb = (LAS bf16_t*)(sl + SL_GK); LAS bf16_t* GBb = (LAS bf16_t*)(sl + SL_GB);
    float P = 1.f;
#pragma unroll
    for (int t4 = 0; t4 < 4; ++t4) { unsigned kq[4], bq[4], vq[4];
#pragma unroll
        for (int tj = 0; tj < 4; ++tj) { const int t = t4 * 4 + tj; const LAS bf16_t* rt = raw + t * 384 + lane;
            const float wv = 1.f - bf2f(rt[5 * 64]); const float Pp = P; P *= wv; const float ip = __builtin_amdgcn_rcpf(P);
            const float kkv = bf2f(rt[4 * 64]) * Pp, rv = bf2f(rt[0]) * P, kv = bf2f(rt[64]) * ip, bv = bf2f(rt[3 * 64]) * ip;
            const bf16_t kb = f2bf(kv), bbv = f2bf(bv);
            KKs[t * 72 + lane] = f2bf(kkv); Rs[t * 72 + lane] = f2bf(rv); Ks[t * 72 + lane] = kb; Bs[t * 72 + lane] = bbv;
            kq[tj] = kb; bq[tj] = f2bf(-bv); vq[tj] = rt[2 * 64]; }
        u32x2 w; w.x = kq[0] | (kq[1] << 16); w.y = kq[2] | (kq[3] << 16); *(LAS u32x2*)(KT + lane * 20 + t4 * 4) = w;
        w.x = bq[0] | (bq[1] << 16); w.y = bq[2] | (bq[3] << 16); *(LAS u32x2*)(BT + lane * 20 + t4 * 4) = w;
        w.x = vq[0] | (vq[1] << 16); w.y = vq[2] | (vq[3] << 16); *(LAS u32x2*)(VT + lane * 20 + t4 * 4) = w; }
    P16[lane] = P;
    asm volatile("s_waitcnt lgkmcnt(0)" ::: "memory"); __builtin_amdgcn_wave_barrier();
    const int r_ = lane & 15, g = lane >> 4;
    f32x4 ab = {0.f, 0.f, 0.f, 0.f}, ak = ab, gk = ab, gb = ab;
#pragma unroll
    for (int ks = 0; ks < 2; ++ks) { const int o = r_ * 72 + ks * 32 + 8 * g;
        const bf16x8 akk = *(const LAS bf16x8*)(KKs + o), ar = *(const LAS bf16x8*)(Rs + o), bk = *(const LAS bf16x8*)(Ks + o), bbf = *(const LAS bf16x8*)(Bs + o);
        ab = __builtin_amdgcn_mfma_f32_16x16x32_bf16(akk, bbf, ab, 0, 0, 0); ak = __builtin_amdgcn_mfma_f32_16x16x32_bf16(akk, bk, ak, 0, 0, 0);
        gk = __builtin_amdgcn_mfma_f32_16x16x32_bf16(ar, bk, gk, 0, 0, 0); gb = __builtin_amdgcn_mfma_f32_16x16x32_bf16(ar, bbf, gb, 0, 0, 0); }
#pragma unroll
    for (int rg = 0; rg < 4; ++rg) { const int t = 4 * g + rg, s_ = r_;
        Abf[t * 17 + s_] = (s_ < t) ? ab[rg] : 0.f;
        AKb[t * 20 + s_] = f2bf((s_ < t) ? ak[rg] : 0.f); GKb[t * 20 + s_] = f2bf((s_ <= t) ? gk[rg] : 0.f); GBb[t * 20 + s_] = f2bf((s_ <= t) ? -gb[rg] : 0.f); }
    asm volatile("s_waitcnt lgkmcnt(0)" ::: "memory"); __builtin_amdgcn_wave_barrier();
    float Tc[16];
#pragma unroll
    for (int t = 0; t < 16; ++t) { float a = (t == r_) ? 1.f : 0.f;
#pragma unroll
        for (int s_ = 0; s_ < t; ++s_) a -= Abf[t * 17 + s_] * Tc[s_];
        Tc[t] = a; }
    if (g == 0) {
#pragma unroll
        for (int t = 0; t < 16; ++t) Tb[t * 20 + r_] = f2bf(Tc[t]); }
}
DI void crit(LAS unsigned char* lds, int q, int vt, int lane, f32x4 (&ST)[4], bf16_t* ydst, int base, int dir, int n0) {
    LAS unsigned char* sl = lds + RAW_BYTES + q * SLOT;
    const LAS bf16_t* KKs = (const LAS bf16_t*)(sl + SL_KK); const LAS bf16_t* Rs = (const LAS bf16_t*)(sl + SL_R);
    const LAS bf16_t* KT = (const LAS bf16_t*)(sl + SL_KT); const LAS bf16_t* BT = (const LAS bf16_t*)(sl + SL_BT); const LAS bf16_t* VT = (const LAS bf16_t*)(sl + SL_VT);
    const LAS float* P16 = (const LAS float*)(sl + SL_P16);
    const LAS bf16_t* Tb = (const LAS bf16_t*)(sl + SL_T); const LAS bf16_t* AKb = (const LAS bf16_t*)(sl + SL_AK); const LAS bf16_t* GKb = (const LAS bf16_t*)(sl + SL_GK); const LAS bf16_t* GBb = (const LAS bf16_t*)(sl + SL_GB);
    const int r_ = lane & 15, g = lane >> 4; const f32x4 zero = {0.f, 0.f, 0.f, 0.f};
    const s16x4v vf = *(const LAS s16x4v*)(VT + (16 * vt + r_) * 20 + 4 * g);
    s16x4v ps[4];
#pragma unroll
    for (int kt = 0; kt < 4; ++kt) ps[kt] = pack4(ST[kt]);
    f32x4 x1 = mm16(*(const LAS s16x4v*)(AKb + r_ * 20 + 4 * g), vf, zero);
#pragma unroll
    for (int kt = 0; kt < 4; ++kt) x1 = mm16(*(const LAS s16x4v*)(KKs + r_ * 72 + 16 * kt + 4 * g), ps[kt], x1);
    const f32x4 u = mm16(*(const LAS s16x4v*)(Tb + r_ * 20 + 4 * g), pack4(x1), zero);
    const s16x4v pu = pack4(u);
    f32x4 y = mm16(*(const LAS s16x4v*)(GKb + r_ * 20 + 4 * g), vf, zero);
#pragma unroll
    for (int kt = 0; kt < 4; ++kt) y = mm16(*(const LAS s16x4v*)(Rs + r_ * 72 + 16 * kt + 4 * g), ps[kt], y);
    y = mm16(*(const LAS s16x4v*)(GBb + r_ * 20 + 4 * g), pu, y);
#pragma unroll
    for (int kt = 0; kt < 4; ++kt) { f32x4 a = mm16(*(const LAS s16x4v*)(KT + (16 * kt + r_) * 20 + 4 * g), vf, ST[kt]);
        a = mm16(*(const LAS s16x4v*)(BT + (16 * kt + r_) * 20 + 4 * g), pu, a);
        ST[kt] = a * *(const LAS f32x4*)(P16 + 16 * kt + 4 * g); }
#pragma unroll
    for (int rg = 0; rg < 4; ++rg) { const int tk = scan_tok(base, dir, n0 + 4 * g + rg); ydst[(size_t)tk * NPC + 16 * vt + r_] = f2bf(y[rg]); }
}
}
DI void rwkv_chunk_item(const Ctx& C, int b, int h, int dir) {
    LAS unsigned char* lds = C.lds; const int tid = C.tid, lane = C.lane, wave = C.wave;
    const int base = b * SB; const int tl = tid >> 3, part = tid & 7;
    const bf16_t* ACT = C.act() + h * 64 + part * 8; const bf16_t* O0 = C.ops(0) + h * 64 + part * 8; const bf16_t* OW = C.ops(1 + dir) + h * 64 + part * 8;
    bf16_t* ydst = C.pbuf() + (dir ? C_YB : C_YF) + h * 64;
    f32x4 ST[4];
#pragma unroll
    for (int kt = 0; kt < 4; ++kt) ST[kt] = (f32x4){0.f, 0.f, 0.f, 0.f};
    u32x4 RA[6], RB[6];
#define RK_LD(R, bt) do { const int tk = scan_tok(base, dir, (bt) * 64 + tl); const bf16_t* ar = ACT + (size_t)tk * DM; \
        R[0] = *(const u32x4*)(ar); R[1] = *(const u32x4*)(ar + 256); R[2] = *(const u32x4*)(ar + 512); R[3] = *(const u32x4*)(ar + 768); \
        R[4] = *(const u32x4*)(O0 + (size_t)tk * 256); R[5] = *(const u32x4*)(OW + (size_t)tk * 256); } while (0)
#define RK_WR(R) do { LAS unsigned char* d_ = lds + (tl * 6) * 128 + part * 16; _Pragma("unroll") for (int a_ = 0; a_ < 6; ++a_) *(LAS u32x4*)(d_ + a_ * 128) = R[a_]; } while (0)
    RK_LD(RA, 0); RK_WR(RA); __syncthreads();
    RK_LD(RA, 1); RK_LD(RB, 2);
    for (int i = 0; i < 68; i += 2) {
        if (wave < 4) rk::prep(lds, wave, lane);
        __syncthreads();
        RK_WR(RA); if (i + 3 < 68) RK_LD(RA, i + 3);
        if (wave < 4) {
#pragma unroll 1
            for (int q = 0; q < 4; ++q) rk::crit(lds, q, wave, lane, ST, ydst, base, dir, i * 64 + q * 16); }
        __syncthreads();
        if (wave < 4) rk::prep(lds, wave, lane);
        __syncthreads();
        if (i + 2 < 68) RK_WR(RB); if (i + 4 < 68) RK_LD(RB, i + 4);
        if (wave < 4) {
#pragma unroll 1
            for (int q = 0; q < 4; ++q) rk::crit(lds, q, wave, lane, ST, ydst, base, dir, (i + 1) * 64 + q * 16); }
        __syncthreads();
    }
#undef RK_LD
#undef RK_WR
}

DI f32x4 mma16(const LAS bf16_t* A, int lda, const LAS bf16_t* Bm, int ldb, int ksteps, int lane, f32x4 acc) {
    for (int ks = 0; ks < ksteps; ++ks) {
        const bf16x8 a = *(const LAS bf16x8*)(A + (lane & 15) * lda + ks * 32 + 8 * (lane >> 4));
        const bf16x8 b = *(const LAS bf16x8*)(Bm + (lane & 15) * ldb + ks * 32 + 8 * (lane >> 4));
        acc = __builtin_amdgcn_mfma_f32_16x16x32_bf16(a, b, acc, 0, 0, 0); }
    return acc;
}
struct TrFrag { s16x4 lo, hi; };
DI TrFrag tr_frag72(const LAS bf16_t* M, int row0, int col0, int lane) {
    const int vb = (int)(uintptr_t)(M + (row0 + 8 * (lane >> 4) + ((lane >> 2) & 3)) * 72 + col0 + 4 * (lane & 3));
    TrFrag f; f.lo = att::tr_read<0>(vb); f.hi = att::tr_read<4 * 72 * 2>(vb); return f;
}
#define TRF_PACK(F) ((bf16x8){F.lo[0], F.lo[1], F.lo[2], F.lo[3], F.hi[0], F.hi[1], F.hi[2], F.hi[3]})
DI void retention_item(const Ctx& C, int l, int b, int h, int dir) {
    constexpr int LQ = 72, LT = 136;
    LAS bf16_t* Qs = (LAS bf16_t*)C.lds;
    LAS bf16_t* Ks = Qs + 128 * LQ;
    LAS bf16_t* Kz = Ks + 128 * LQ;
    LAS bf16_t* Vr = Kz + 128 * LQ;
    LAS bf16_t* At = Vr + 128 * LQ;
    LAS bf16_t* rT = At + 128 * LT;
    const int tid = C.tid, lane = C.lane, lane0_ = C.lane, wave = C.wave; const int base = b * SB;
    const float x = C.in[15][(l * 2 + dir) * 4 + h];
    float lg2 = -log1pf(__expf(-x)) * 1.4426950408889634f;
    asm volatile("" : "+v"(lg2));
    const float gchunk = exp2f(lg2 * 128.f);
    const float zeta_c = exp2f(lg2 * (float)(127 - (tid >> 2)));
    float bs0[4]; const int iq = wave * 16 + (lane & 15);
#pragma unroll
    for (int r = 0; r < 4; ++r) bs0[r] = __builtin_amdgcn_exp2f(lg2 * (float)(iq - (4 * (lane >> 4) + r)));
    const float gstep = __builtin_amdgcn_exp2f(lg2 * -16.f);
    const float xi = __builtin_amdgcn_exp2f(lg2 * (float)(wave * 16 + (lane & 15) + 1));
    bf16_t* Pp = C.pbuf(); bf16_t* odst = Pp + (dir ? C_OB : C_OF) + h * 64;
    f32x4 rst[2] = {{0.f, 0.f, 0.f, 0.f}, {0.f, 0.f, 0.f, 0.f}};
    for (int i = tid; i < 64 * LQ; i += NTHR) rT[i] = 0;
    const int si = tid >> 2, sp = tid & 3;
    bf16x8 gq[2], gk[2], gv[2];
#define RT_LOAD(c) do { const int tk = scan_tok(base, dir, (c) * 128 + si); const bf16_t* pr = Pp + (size_t)tk * NPC + h * 64 + sp * 16; \
        gq[0] = *(const bf16x8*)(pr + C_RQ); gq[1] = *(const bf16x8*)(pr + C_RQ + 8); gk[0] = *(const bf16x8*)(pr + C_RK); gk[1] = *(const bf16x8*)(pr + C_RK + 8); \
        gv[0] = *(const bf16x8*)(pr + C_RV); gv[1] = *(const bf16x8*)(pr + C_RV + 8); } while (0)
    RT_LOAD(0);
    __syncthreads();
    for (int c = 0; c < 34; ++c) {
        int lane = lane0_; asm volatile("" : "+v"(lane));
        { *(LAS bf16x8*)(Qs + si * LQ + sp * 16) = gq[0]; *(LAS bf16x8*)(Qs + si * LQ + sp * 16 + 8) = gq[1];
          *(LAS bf16x8*)(Ks + si * LQ + sp * 16) = gk[0]; *(LAS bf16x8*)(Ks + si * LQ + sp * 16 + 8) = gk[1];
          *(LAS bf16x8*)(Vr + si * LQ + sp * 16) = gv[0]; *(LAS bf16x8*)(Vr + si * LQ + sp * 16 + 8) = gv[1];
          const float zeta = zeta_c;
#pragma unroll
          for (int hh = 0; hh < 2; ++hh) { float f[8]; cvt8(gk[hh], f);
              u32x4 w; w.x = pk2(f[0] * zeta, f[1] * zeta); w.y = pk2(f[2] * zeta, f[3] * zeta); w.z = pk2(f[4] * zeta, f[5] * zeta); w.w = pk2(f[6] * zeta, f[7] * zeta);
              *(LAS u32x4*)(Kz + si * LQ + sp * 16 + hh * 8) = w; } }
        __syncthreads();
        if (c + 1 < 34) RT_LOAD(c + 1);
        { const LAS bf16_t* Aq = Qs + (wave * 16) * LQ;
          float bs[4] = {bs0[0], bs0[1], bs0[2], bs0[3]};
#pragma unroll
          for (int nt = 0; nt < 8; ++nt) { f32x4 acc = {0.f, 0.f, 0.f, 0.f}; acc = mma16(Ks + (nt * 16) * LQ, LQ, Aq, LQ, 2, lane, acc);
              const int i = wave * 16 + (lane & 15), j0 = nt * 16 + 4 * (lane >> 4); float d[4];
#pragma unroll
              for (int r = 0; r < 4; ++r) { d[r] = (i >= j0 + r) ? acc[r] * bs[r] : 0.f; bs[r] *= gstep; }
              u32x2 w; w.x = pk2(d[0], d[1]); w.y = pk2(d[2], d[3]);
              *(LAS u32x2*)(At + i * LT + j0) = w; } }
        asm volatile("s_waitcnt lgkmcnt(0)" ::: "memory");
        __builtin_amdgcn_wave_barrier();
        { const LAS bf16_t* Aa = At + (wave * 16) * LT; const LAS bf16_t* Aq = Qs + (wave * 16) * LQ;
#pragma unroll
          for (int nt = 0; nt < 4; ++nt) { f32x4 a1 = {0.f, 0.f, 0.f, 0.f}, a2 = {0.f, 0.f, 0.f, 0.f};
              { TrFrag va[4]; bf16x8 ab[4];
#pragma unroll
                for (int ks = 0; ks < 4; ++ks) { va[ks] = tr_frag72(Vr, ks * 32, nt * 16, lane); ab[ks] = *(const LAS bf16x8*)(Aa + (lane & 15) * LT + ks * 32 + 8 * (lane >> 4)); }
                asm volatile("s_waitcnt lgkmcnt(0)" ::: "memory"); __builtin_amdgcn_sched_barrier(0);
#pragma unroll
                for (int ks = 0; ks < 4; ++ks) a1 = __builtin_amdgcn_mfma_f32_16x16x32_bf16(TRF_PACK(va[ks]), ab[ks], a1, 0, 0, 0); }
              a2 = mma16(rT + (nt * 16) * LQ, LQ, Aq, LQ, 2, lane, a2);
              const int tk = scan_tok(base, dir, c * 128 + wave * 16 + (lane & 15));
              u32x2 w; w.x = pk2(a1[0] + a2[0] * xi, a1[1] + a2[1] * xi); w.y = pk2(a1[2] + a2[2] * xi, a1[3] + a2[3] * xi);
              *(u32x2*)(odst + (size_t)tk * NPC + nt * 16 + 4 * (lane >> 4)) = w; } }
        __syncthreads();
        { const int mt = wave >> 1;
#pragma unroll
          for (int i2 = 0; i2 < 2; ++i2) { const int nt = 2 * (wave & 1) + i2; f32x4 acc = {0.f, 0.f, 0.f, 0.f};
              { TrFrag ka[4], vb4[4];
#pragma unroll
                for (int ks = 0; ks < 4; ++ks) { ka[ks] = tr_frag72(Kz, ks * 32, mt * 16, lane); vb4[ks] = tr_frag72(Vr, ks * 32, nt * 16, lane); }
                asm volatile("s_waitcnt lgkmcnt(0)" ::: "memory"); __builtin_amdgcn_sched_barrier(0);
#pragma unroll
                for (int ks = 0; ks < 4; ++ks) acc = __builtin_amdgcn_mfma_f32_16x16x32_bf16(TRF_PACK(ka[ks]), TRF_PACK(vb4[ks]), acc, 0, 0, 0); }
              rst[i2] = rst[i2] * gchunk + acc;
              const int dv = nt * 16 + (lane & 15), dk0 = mt * 16 + 4 * (lane >> 4);
              u32x2 w; w.x = pk2(rst[i2][0], rst[i2][1]); w.y = pk2(rst[i2][2], rst[i2][3]);
              *(LAS u32x2*)(rT + dv * LQ + dk0) = w; } }
        __syncthreads();
    }
#undef RT_LOAD
}

DI void phase_mixers(const Ctx& C0, int l, const float negM) {
    LAS int* slot = (LAS int*)(C0.lds + LDS_BYTES - 16);
    const int n_att = (l == 0) ? 1024 + 64 : 1024;
    const int total = 128 + n_att + WX_NGU / 8;
#ifdef DIAG_ITEMS
    int nit = 0;
#endif
    bool first = true;
    for (;;) {
        __syncthreads();
        if (C0.tid == 0) *slot = (first && C0.bid < 128) ? C0.bid : 128 + atomicAdd(C0.cnt() + l, 1);
        first = false;
        __syncthreads();
        const int it = *slot;
#ifdef DIAG_ITEMS
        if (l == 0 && C0.bid == DIAG_BLK && C0.tid == 0 && nit < 6) ((unsigned long long*)(C0.ws + OFF_CNT + 4096))[32 + nit] = __builtin_amdgcn_s_memrealtime();
        ++nit;
#endif
        if (it >= total) break;
        Ctx C2 = C0; asm volatile("" : "+v"(C2.tid)); C2.lane = C2.tid & 63; C2.wave = __builtin_amdgcn_readfirstlane(C2.tid >> 6); const Ctx& C = C2;
        if (it < 64) rwkv_chunk_item(C, it >> 3, (it >> 1) & 3, it & 1);
        else if (it < 128) { const int r = it - 64; retention_item(C, l, r >> 3, (r >> 1) & 3, r & 1); }
        else if (it >= 128 + n_att) wconv_range(C, l, (it - 128 - n_att) * 8, 8);
        else {
            int a = it - 128; int b, h, q0, seq;
            if (a < 1024) { b = a >> 7; h = (a >> 4) & 7; q0 = CTXL + (a & 15) * 256; seq = SB; }
            else { a -= 1024; b = a >> 3; h = a & 7; q0 = 0; seq = CTXL; }
            const size_t tb = (size_t)b * SB;
            att::attn_body(C.qkv() + (tb + q0) * QKVC + h * 96, C.kf() + tb * 768 + h * 96, C.qkv() + tb * QKVC + 768 + h * 128 + 64,
                           C.pbuf() + (tb + q0) * NPC + h * 64, seq, (LAS char*)C.lds, C.tid, negM);
        }
    }
}

struct FinTok { u32x2 of, ob, gg, yf, yb, vv, gt; float bon; };
DI void fin_load(const Ctx& C, int tok, int lane, FinTok& R) {
    const int c4 = lane * 4; const bf16_t* pr = C.pbuf() + (size_t)tok * NPC; const bf16_t* ar = C.act() + (size_t)tok * DM;
    R.of = *(const u32x2*)(pr + C_OF + c4); R.ob = *(const u32x2*)(pr + C_OB + c4); R.gg = *(const u32x2*)(pr + C_RG + c4);
    R.yf = *(const u32x2*)(pr + C_YF + c4); R.yb = *(const u32x2*)(pr + C_YB + c4);
    R.vv = *(const u32x2*)(ar + 512 + c4); R.gt = *(const u32x2*)(C.ops(3) + (size_t)tok * 256 + c4);
    R.bon = C.bonus()[(size_t)tok * 4 + (lane >> 4)];
}
DI void fin_store(const Ctx& C, int tok, int lane, const FinTok& R, const f32x4 gnw, const f32x4 lnw) {
    const int c4 = lane * 4;
    const u32x2 of = R.of, ob = R.ob, gg = R.gg, yf = R.yf, yb = R.yb, vv = R.vv, gt = R.gt; const float bon = R.bon;
    f32x4 o = {lo_f(of.x) + lo_f(ob.x), hi_f(of.x) + hi_f(ob.x), lo_f(of.y) + lo_f(ob.y), hi_f(of.y) + hi_f(ob.y)};
    float mu = row16_sum(o[0] + o[1] + o[2] + o[3]) * (1.f / 64.f);
    f32x4 d = o - mu; float var = row16_sum(d[0] * d[0] + d[1] * d[1] + d[2] * d[2] + d[3] * d[3]) * (1.f / 64.f);
    float eps1 = 1e-5f, eps2 = 64e-5f; asm volatile("" : "+v"(eps1), "+v"(eps2));
    float rs = rsqrtf(var + eps1);
    const f32x4 g = {lo_f(gg.x), hi_f(gg.x), lo_f(gg.y), hi_f(gg.y)};
    f32x4 r1; r1[0] = d[0] * rs * gnw[0] * siluf_(g[0]); r1[1] = d[1] * rs * gnw[1] * siluf_(g[1]); r1[2] = d[2] * rs * gnw[2] * siluf_(g[2]); r1[3] = d[3] * rs * gnw[3] * siluf_(g[3]);
    f32x4 y = {lo_f(yf.x) + lo_f(yb.x), hi_f(yf.x) + hi_f(yb.x), lo_f(yf.y) + lo_f(yb.y), hi_f(yf.y) + hi_f(yb.y)};
    mu = row16_sum(y[0] + y[1] + y[2] + y[3]) * (1.f / 64.f);
    d = y - mu; var = row16_sum(d[0] * d[0] + d[1] * d[1] + d[2] * d[2] + d[3] * d[3]) * (1.f / 64.f);
    rs = rsqrtf(var + eps2);
    const f32x4 v = {lo_f(vv.x), hi_f(vv.x), lo_f(vv.y), hi_f(vv.y)}, gate = {lo_f(gt.x), hi_f(gt.x), lo_f(gt.y), hi_f(gt.y)};
    const f32x4 r2 = (d * rs * lnw + v * bon) * gate;
    bf16_t* pw = C.pbuf() + (size_t)tok * NPC;
    u32x2 w; w.x = pk2(r1[0], r1[1]); w.y = pk2(r1[2], r1[3]); *(u32x2*)(pw + 512 + c4) = w;
    w.x = pk2(r2[0], r2[1]); w.y = pk2(r2[2], r2[3]); *(u32x2*)(pw + 768 + c4) = w;
}
DI void phase_finish(const Ctx& C, int l) {
    const int gw = C.bid * 8 + C.wave, GW = C.G * 8, lane = C.lane, c4 = lane * 4;
    const f32x4 gnw = *(const f32x4*)(C.in[16] + l * 256 + c4), lnw = *(const f32x4*)(C.in[26] + l * 256 + c4);
    const int NT_ = (l == 1) ? NBATCH * SEQ : T;
#define FN_TOK(i_) (((l == 1) ? ((i_) / SEQ) * SB + CTXL + ((i_) % SEQ) : (i_)))
    FinTok A, B, NA, NB;
    if (gw < NT_) { fin_load(C, FN_TOK(gw), lane, A); const int i2 = gw + GW; fin_load(C, FN_TOK(i2 < NT_ ? i2 : gw), lane, B); }
    for (int i = gw; i < NT_; i += 2 * GW) {
        const int i2 = i + GW; const bool has2 = i2 < NT_; const int j = i + 2 * GW; const bool hasn = j < NT_;
        if (hasn) { fin_load(C, FN_TOK(j), lane, NA); const int j2 = j + GW; fin_load(C, FN_TOK(j2 < NT_ ? j2 : j), lane, NB); }
        fin_store(C, FN_TOK(i), lane, A, gnw, lnw);
        if (has2) fin_store(C, FN_TOK(i2), lane, B, gnw, lnw);
        if (hasn) { A = NA; B = NB; }
    }
#undef FN_TOK
}

DI float wave_sum2(float v) { v = row16_sum(v); v += __shfl_xor(v, 16); v += __shfl_xor(v, 32); return v; }
DI float row16_max(float x) { x = fmaxf(x, dpp_mov<0xB1>(x)); x = fmaxf(x, dpp_mov<0x4E>(x)); x = fmaxf(x, dpp_mov<0x141>(x)); x = fmaxf(x, dpp_mov<0x140>(x)); return x; }
DI void router_token(const Ctx& C, int l, int tok, int lane, const float (&v)[16], const LAS float* rw, const float* nw) {
    const int b = tok / SB, s = tok - b * SB; const float* modrow = C.modv(l) + (size_t)((s < CTXL) ? 8 : b) * 6144;
    float ss = 0.f;
#pragma unroll
    for (int m = 0; m < 16; ++m) ss += v[m] * v[m];
    ss = wave_sum2(ss); const float rstd = rsqrtf(ss * (1.f / 1024.f) + 1e-6f);
    float lg[16];
#pragma unroll
    for (int e = 0; e < 16; ++e) lg[e] = 0.f;
    bf16_t* dst = C.act() + (size_t)tok * DM;
#pragma unroll
    for (int m = 0; m < 16; ++m) { const int c = m * 64 + lane;
        const float hv = v[m] * rstd * nw[c] * (modrow[4096 + c] + 1.f) + modrow[3072 + c];
        dst[c] = f2bf(hv);
        const LAS float* rr = rw + c * 20;
        const f32x4 r0 = *(const LAS f32x4*)rr, r1 = *(const LAS f32x4*)(rr + 4), r2 = *(const LAS f32x4*)(rr + 8), r3 = *(const LAS f32x4*)(rr + 12);
        lg[0] += hv * r0[0]; lg[1] += hv * r0[1]; lg[2] += hv * r0[2]; lg[3] += hv * r0[3];
        lg[4] += hv * r1[0]; lg[5] += hv * r1[1]; lg[6] += hv * r1[2]; lg[7] += hv * r1[3];
        lg[8] += hv * r2[0]; lg[9] += hv * r2[1]; lg[10] += hv * r2[2]; lg[11] += hv * r2[3];
        lg[12] += hv * r3[0]; lg[13] += hv * r3[1]; lg[14] += hv * r3[2]; lg[15] += hv * r3[3]; }
    float sel = 0.f; const int li = lane & 15;
#pragma unroll
    for (int e = 0; e < 16; ++e) { const float r = row16_sum(lg[e]); sel = (li == e) ? r : sel; }
    sel += __shfl_xor(sel, 16); sel += __shfl_xor(sel, 32);
    const float mx = row16_max(sel); const float ex = __expf(sel - mx); const float den = row16_sum(ex);
    if (lane < 16) { const float a = ex / den;
        if (s < CTXL) ((float*)(C.ws + OFF_AFFC))[(size_t)(b * 16 + lane) * CTXL + s] = a;
        else ((float*)(C.ws + OFF_AFFL))[(size_t)(b * 16 + lane) * SEQ + (s - CTXL)] = a; }
}
template <class SyncF>
DI void phase_h_router(const Ctx& C, int l, const float* lat, const float* ctxp, SyncF&& sync) {
    __syncthreads();
    LAS float* stat = (LAS float*)C.lds;
    LAS f32x4* part = (LAS f32x4*)(C.lds + 1024);
    LAS float* Lnw = (LAS float*)(C.lds + 16384); LAS float* Lsc = Lnw + 1024; LAS float* Lsh = Lsc + 9 * 1024;
    for (int i = C.tid; i < 1024; i += NTHR) Lnw[i] = C.in[7][l * 1024 + i];
    for (int i = C.tid; i < 9 * 1024; i += NTHR) { const int r = i >> 10, c = i & 1023; Lsc[i] = C.modv(l)[(size_t)r * 6144 + 4096 + c] + 1.f; Lsh[i] = C.modv(l)[(size_t)r * 6144 + 3072 + c]; }
    __syncthreads();
    const int lane = C.lane, wave = C.wave, tl = lane & 15, g = lane >> 4;
    const int kw = wave * 128 + 8 * g;
    bf16x8 whi[4], wlo[4];
    { const float* W = C.in[28] + (size_t)l * 16384;
#pragma unroll
      for (int s = 0; s < 4; ++s) { unsigned hh[4], ll[4];
#pragma unroll
          for (int j = 0; j < 4; ++j) { const float w0 = W[(size_t)(kw + 32 * s + 2 * j) * 16 + tl], w1 = W[(size_t)(kw + 32 * s + 2 * j + 1) * 16 + tl];
              const unsigned hp = pk2(w0, w1); hh[j] = hp; ll[j] = pk2(w0 - lo_f(hp), w1 - hi_f(hp)); }
          whi[s] = __builtin_bit_cast(bf16x8, (u32x4){hh[0], hh[1], hh[2], hh[3]}); wlo[s] = __builtin_bit_cast(bf16x8, (u32x4){ll[0], ll[1], ll[2], ll[3]}); } }
    const int NG = (l == 1) ? NBATCH * SEQ / 16 : T / 16;
#define RT_TOK0(gi_) ((l == 1) ? ((gi_) >> 8) * SB + CTXL + ((gi_) & 255) * 16 : (gi_) * 16)
    const bf16_t* XM = (const bf16_t*)(C.ws + OFF_ARENA + AR_XMID);
#define RT_LOAD(X_, gi_) do { const bf16_t* xr_ = XM + (size_t)(RT_TOK0(gi_) + tl) * DM + kw; \
        _Pragma("unroll") for (int s_ = 0; s_ < 4; ++s_) X_[s_] = *(const u32x4*)(xr_ + 32 * s_); } while (0)
#define RT_X(X_, q_) ((f32x4){lo_f(X_[(q_) >> 1][((q_) & 1) * 2]), hi_f(X_[(q_) >> 1][((q_) & 1) * 2]), lo_f(X_[(q_) >> 1][((q_) & 1) * 2 + 1]), hi_f(X_[(q_) >> 1][((q_) & 1) * 2 + 1])})
    sync();
    u32x4 xv[4];
    int gi = C.bid;
    if (gi < NG) RT_LOAD(xv, gi);
    for (; gi < NG; gi += C.G) {
        const int tok0 = RT_TOK0(gi); const int b = tok0 / SB, s0 = tok0 - b * SB; const bool isctx = s0 < CTXL;
        const int mrow = (isctx ? 8 : b) * 1024 + kw;
        u32x4 xn[4]; const int gn = gi + C.G; if (gn < NG) RT_LOAD(xn, gn);
        float ss = 0.f;
#pragma unroll
        for (int q = 0; q < 8; ++q) { const f32x4 xq = RT_X(xv, q); ss += xq[0] * xq[0] + xq[1] * xq[1] + xq[2] * xq[2] + xq[3] * xq[3]; }
        ss += __shfl_xor(ss, 16); ss += __shfl_xor(ss, 32);
        if (lane < 16) stat[wave * 16 + lane] = ss;
        __syncthreads();
        float tot = 0.f;
#pragma unroll
        for (int w = 0; w < 8; ++w) tot += stat[w * 16 + tl];
        const float rstd = rsqrtf(tot * (1.f / 1024.f) + 1e-6f);
        bf16_t* hdst = C.act() + (size_t)(tok0 + tl) * DM + kw;
        f32x4 acc = {0.f, 0.f, 0.f, 0.f};
#pragma unroll
        for (int s = 0; s < 4; ++s) { unsigned hh[4], ll[4];
#pragma unroll
            for (int half = 0; half < 2; ++half) { const int c = 32 * s + 4 * half;
                const f32x4 w4 = *(const LAS f32x4*)(Lnw + kw + c), sc4 = *(const LAS f32x4*)(Lsc + mrow + c), sh4 = *(const LAS f32x4*)(Lsh + mrow + c);
                const f32x4 h4 = RT_X(xv, 2 * s + half) * rstd * w4 * sc4 + sh4;
                const unsigned p0 = pk2(h4[0], h4[1]), p1 = pk2(h4[2], h4[3]);
                hh[2 * half] = p0; hh[2 * half + 1] = p1;
                ll[2 * half] = pk2(h4[0] - lo_f(p0), h4[1] - hi_f(p0)); ll[2 * half + 1] = pk2(h4[2] - lo_f(p1), h4[3] - hi_f(p1)); }
            const u32x4 hw = {hh[0], hh[1], hh[2], hh[3]};
            *(u32x4*)(hdst + 32 * s) = hw;
            const bf16x8 hhi = __builtin_bit_cast(bf16x8, hw), hlo = __builtin_bit_cast(bf16x8, (u32x4){ll[0], ll[1], ll[2], ll[3]});
            acc = __builtin_amdgcn_mfma_f32_16x16x32_bf16(whi[s], hhi, acc, 0, 0, 0);
            acc = __builtin_amdgcn_mfma_f32_16x16x32_bf16(wlo[s], hhi, acc, 0, 0, 0);
            acc = __builtin_amdgcn_mfma_f32_16x16x32_bf16(whi[s], hlo, acc, 0, 0, 0); }
        if (gn < NG) { xv[0] = xn[0]; xv[1] = xn[1]; xv[2] = xn[2]; xv[3] = xn[3]; }
        part[wave * 64 + lane] = acc;
        __syncthreads();
        if (wave == 0) {
            f32x4 lg = part[lane];
#pragma unroll
            for (int w = 1; w < 8; ++w) lg += part[w * 64 + lane];
            float mx = fmaxf(fmaxf(lg[0], lg[1]), fmaxf(lg[2], lg[3])); mx = fmaxf(mx, __shfl_xor(mx, 16)); mx = fmaxf(mx, __shfl_xor(mx, 32));
            const f32x4 ex = {__expf(lg[0] - mx), __expf(lg[1] - mx), __expf(lg[2] - mx), __expf(lg[3] - mx)};
            float den = ex[0] + ex[1] + ex[2] + ex[3]; den += __shfl_xor(den, 16); den += __shfl_xor(den, 32);
            const float inv = 1.f / den;
            float* aff = isctx ? (float*)(C.ws + OFF_AFFC) + (size_t)(b * 16 + 4 * g) * CTXL + s0 + tl : (float*)(C.ws + OFF_AFFL) + (size_t)(b * 16 + 4 * g) * SEQ + (s0 - CTXL) + tl;
            const size_t es = isctx ? CTXL : SEQ;
#pragma unroll
            for (int r = 0; r < 4; ++r) aff[r * es] = ex[r] * inv; }
    }
#undef RT_TOK0
#undef RT_LOAD
#undef RT_X
}

DI void select_item(const Ctx& C, const float* aff, int n, int cap, int rowbase, int tokbase, int* inv  ) {
    LAS unsigned* keys = (LAS unsigned*)C.lds;
    LAS int* cnt = (LAS int*)(C.lds + 16384);
    LAS int* wsum = cnt + 64;
    const int tid = C.tid; const int m = (n + NTHR - 1) / NTHR;
    for (int i = tid; i < n; i += NTHR) keys[i] = __float_as_uint(aff[i]);
    __syncthreads();
    unsigned prefix = 0u; int krem = cap;
    LAS int* hist = cnt + 128;
    LAS int* selw = cnt + 96;
#pragma unroll 1
    for (int pass = 0; pass < 4; ++pass) { const int shift = 24 - 8 * pass;
        if (tid < 256) hist[tid] = 0;
        __syncthreads();
        for (int i = tid; i < n; i += NTHR) { const unsigned k = keys[i];
            if (pass == 0 || (k >> (shift + 8)) == (prefix >> (shift + 8))) __hip_atomic_fetch_add(&hist[(k >> shift) & 255u], 1, __ATOMIC_RELAXED, __HIP_MEMORY_SCOPE_WORKGROUP); }
        __syncthreads();
        if (C.wave == 0) { const int l4 = C.lane * 4; const int h0 = hist[l4], h1 = hist[l4 + 1], h2 = hist[l4 + 2], h3 = hist[l4 + 3]; const int s4 = h0 + h1 + h2 + h3;
            int incl = s4;
            for (int o = 1; o < 64; o <<= 1) { const int v = __shfl_down(incl, o); if (C.lane + o < 64) incl += v; }
            const int above = incl - s4;
            if (above < krem && incl >= krem) { int d = 3, a = above;
                if (a + h3 >= krem) d = 3; else { a += h3; if (a + h2 >= krem) d = 2; else { a += h2; if (a + h1 >= krem) d = 1; else { a += h1; d = 0; } } }
                selw[0] = l4 + d; selw[1] = krem - a; } }
        __syncthreads();
        prefix |= (unsigned)selw[0] << shift; krem = selw[1];
        __syncthreads();
    }
    const unsigned thr = prefix;
    int gtc = 0, eqc = 0;
    for (int q = 0; q < m; ++q) { const int i = tid * m + q; if (i < n) { const unsigned k = keys[i]; gtc += (k > thr); eqc += (k == thr); } }
    int g = gtc, e = eqc;
    for (int o = 1; o < 64; o <<= 1) { const int g2 = __shfl_up(g, o), e2 = __shfl_up(e, o); if (C.lane >= o) { g += g2; e += e2; } }
    if (C.lane == 63) { wsum[C.wave] = g; wsum[8 + C.wave] = e; }
    __syncthreads();
    int gb = 0, eb = 0, gtot = 0;
    for (int w = 0; w < 8; ++w) { if (w < C.wave) { gb += wsum[w]; eb += wsum[8 + w]; } gtot += wsum[w]; }
    int gpre = gb + g - gtc, epre = eb + e - eqc;
    const int need_eq = cap - gtot;
    int* idx = (int*)(C.ws + OFF_IDX); float* gate = (float*)(C.ws + OFF_GATE);
    for (int q = 0; q < m; ++q) { const int i = tid * m + q; if (i < n) { const unsigned k = keys[i];
        const bool sel = (k > thr) || (k == thr && epre < need_eq);
        const int sl = gpre + (epre < need_eq ? epre : need_eq);
        if (sel) { idx[rowbase + sl] = tokbase + i; gate[rowbase + sl] = __uint_as_float(k); }
        inv[(size_t)i * 16] = sel ? (rowbase + sl) : -1;
        gpre += (k > thr); epre += (k == thr); } }
    asm volatile("s_waitcnt vmcnt(0)" ::: "memory");
    __syncthreads();
    __syncthreads();
}
DI void phase_select(const Ctx& C, int l) {
    const int nitems = (l == 0) ? 256 : 128;
    for (int it = C.bid; it < nitems; it += C.G) {
        if (it < 128) { const int b = it >> 4, e = it & 15;
            select_item(C, (const float*)(C.ws + OFF_AFFL) + (size_t)(b * 16 + e) * SEQ, SEQ, CAPL, e * 4096 + b * 512, b * SB + CTXL, (int*)(C.ws + OFF_INVL) + (size_t)b * SEQ * 16 + e); }
        else { const int a = it - 128, b = a >> 4, e = a & 15;
            select_item(C, (const float*)(C.ws + OFF_AFFC) + (size_t)(b * 16 + e) * CTXL, CTXL, CAPC, XE_LROWS + e * 256 + b * 32, b * SB, (int*)(C.ws + OFF_INVC) + (size_t)b * CTXL * 16 + e); }
    }
#ifdef DIAG_TS
    if (l == 0 && C.bid == DIAG_BLK && C.tid == 0) ((unsigned long long*)(C.ws + OFF_CNT + 4096))[40] = __builtin_amdgcn_s_memrealtime();
#endif
    if (l != 0) { Ctx C2 = C; asm volatile("" : "+v"(C2.tid)); C2.lane = C2.tid & 63; C2.wave = __builtin_amdgcn_readfirstlane(C2.tid >> 6); phase_wconv_experts(C2, l); }
}

struct CombTok { u32x2 x[4]; u32x2 y[4][4]; int myinv; int r[4]; unsigned long long rest; };
DI const int* comb_inv_ptr(const Ctx& C, int tok) { const int b = tok / SB, s = tok - b * SB;
    return (s < CTXL) ? (const int*)(C.ws + OFF_INVC) + (size_t)(b * CTXL + s) * 16 : (const int*)(C.ws + OFF_INVL) + (size_t)(b * SEQ + s - CTXL) * 16; }
DI void comb_issue_ye(const Ctx& C, int lane, CombTok& R) {
    const bf16_t* ye = (const bf16_t*)(C.ws + OFF_ARENA + AR_XE);
    unsigned long long msk = __ballot(R.myinv >= 0) & 0xffffull;
#pragma unroll
    for (int k = 0; k < 4; ++k) { R.r[k] = -1; if (msk) { const int e = __builtin_ctzll(msk); msk &= msk - 1; R.r[k] = __builtin_amdgcn_readlane(R.myinv, e); } }
    R.rest = msk;
#pragma unroll
    for (int k = 0; k < 4; ++k) if (R.r[k] >= 0) { const bf16_t* yr = ye + (size_t)R.r[k] * DM + lane * 4;
#pragma unroll
        for (int j = 0; j < 4; ++j) R.y[k][j] = *(const u32x2*)(yr + j * 256); }
}
DI void comb_finish(const Ctx& C, int l, int tok, int lane, float* lat, float* ctxp, const CombTok& R, const LAS float* Lga, const LAS float* Lnw1, const LAS float* Lsc1, const LAS float* Lsh1) {
    const bf16_t* ye = (const bf16_t*)(C.ws + OFF_ARENA + AR_XE);
    const int b = tok / SB, s = tok - b * SB;
    float* xr = (s < CTXL) ? ctxp + (size_t)(b * CTXL + s) * DM : lat + (size_t)(b * SEQ + s - CTXL) * DM;
    const int mrow = ((s < CTXL) ? 8 : b) * 1024;
    f32x4 acc[4];
#pragma unroll
    for (int j = 0; j < 4; ++j) acc[j] = (f32x4){0.f, 0.f, 0.f, 0.f};
#pragma unroll
    for (int k = 0; k < 4; ++k) if (R.r[k] >= 0) {
#pragma unroll
        for (int j = 0; j < 4; ++j) { const u32x2 w = R.y[k][j]; acc[j][0] += lo_f(w.x); acc[j][1] += hi_f(w.x); acc[j][2] += lo_f(w.y); acc[j][3] += hi_f(w.y); } }
    unsigned long long msk = R.rest;
    while (msk) { const int e = __builtin_ctzll(msk); msk &= msk - 1; const int r = __builtin_amdgcn_readlane(R.myinv, e); const bf16_t* yr = ye + (size_t)r * DM + lane * 4;
#pragma unroll
        for (int j = 0; j < 4; ++j) { const u32x2 w = *(const u32x2*)(yr + j * 256); acc[j][0] += lo_f(w.x); acc[j][1] += hi_f(w.x); acc[j][2] += lo_f(w.y); acc[j][3] += hi_f(w.y); } }
    f32x4 v[4];
#pragma unroll
    for (int j = 0; j < 4; ++j) { const int c = j * 256 + lane * 4; const f32x4 ga = *(const LAS f32x4*)(Lga + mrow + c);
        const f32x4 xm = {lo_f(R.x[j].x), hi_f(R.x[j].x), lo_f(R.x[j].y), hi_f(R.x[j].y)};
        v[j] = xm + ga * acc[j]; *(f32x4*)(xr + c) = v[j]; }
    if (l == 0) {
        float ss = 0.f;
#pragma unroll
        for (int j = 0; j < 4; ++j) ss += v[j][0] * v[j][0] + v[j][1] * v[j][1] + v[j][2] * v[j][2] + v[j][3] * v[j][3];
        ss = wave_sum(ss);
        const float rstd = rsqrtf(ss * (1.f / 1024.f) + 1e-6f); bf16_t* dst = C.act() + (size_t)tok * DM;
#pragma unroll
        for (int j = 0; j < 4; ++j) { const int c = j * 256 + lane * 4;
            const f32x4 o = v[j] * rstd * *(const LAS f32x4*)(Lnw1 + c) * *(const LAS f32x4*)(Lsc1 + mrow + c) + *(const LAS f32x4*)(Lsh1 + mrow + c);
            u32x2 pkd; pkd.x = pk2(o[0], o[1]); pkd.y = pk2(o[2], o[3]); *(u32x2*)(dst + c) = pkd; } }
}
template <class SyncF>
DI void phase_combine(const Ctx& C, int l, float* lat, float* ctxp, SyncF&& sync) {
    __syncthreads();
    const int gw = C.bid * 8 + C.wave, GW = C.G * 8, lane = C.lane;
    const int NT_ = (l == 1) ? NBATCH * SEQ : T;
    const bf16_t* XM = (const bf16_t*)(C.ws + OFF_ARENA + AR_XMID);
    LAS float* Lga = (LAS float*)C.lds; LAS float* Lnw1 = Lga + 9 * 1024; LAS float* Lsc1 = Lnw1 + 1024; LAS float* Lsh1 = Lsc1 + 9 * 1024;
    for (int i = C.tid; i < 9 * 1024; i += NTHR) { const int r = i >> 10, c = i & 1023; Lga[i] = C.modv(l)[(size_t)r * 6144 + 5120 + c];
        if (l == 0) { Lsh1[i] = C.modv(1)[(size_t)r * 6144 + c]; Lsc1[i] = C.modv(1)[(size_t)r * 6144 + 1024 + c] + 1.f; } }
    if (l == 0) for (int i = C.tid; i < 1024; i += NTHR) Lnw1[i] = C.in[6][1024 + i];
    __syncthreads();
#define CB_TOK(i_) (((l == 1) ? ((i_) / SEQ) * SB + CTXL + ((i_) % SEQ) : (i_)))
#define CB_LOAD(A_, B_, i_) do { const int tA_ = CB_TOK(i_); const int i2_ = (i_) + GW; const int tB_ = (i2_ < NT_) ? CB_TOK(i2_) : tA_; \
        A_.myinv = comb_inv_ptr(C, tA_)[lane & 15]; B_.myinv = comb_inv_ptr(C, tB_)[lane & 15]; \
        const bf16_t* xa_ = XM + (size_t)tA_ * DM; const bf16_t* xb_ = XM + (size_t)tB_ * DM; \
        _Pragma("unroll") for (int j_ = 0; j_ < 4; ++j_) { A_.x[j_] = *(const u32x2*)(xa_ + j_ * 256 + lane * 4); B_.x[j_] = *(const u32x2*)(xb_ + j_ * 256 + lane * 4); } } while (0)
    sync();
    CombTok A, B;
    if (gw < NT_) CB_LOAD(A, B, gw);
    for (int i = gw; i < NT_; i += 2 * GW) {
        const int i2 = i + GW; const bool has2 = i2 < NT_;
        const int tokA = CB_TOK(i); const int tokB = has2 ? CB_TOK(i2) : tokA;
        comb_issue_ye(C, lane, A); comb_issue_ye(C, lane, B);
        int nIa = 0, nIb = 0; u32x2 nxa[4], nxb[4]; const int j = i + 2 * GW; const bool hasn = j < NT_;
        if (hasn) { const int tA_ = CB_TOK(j); const int j2 = j + GW; const int tB_ = (j2 < NT_) ? CB_TOK(j2) : tA_;
            nIa = comb_inv_ptr(C, tA_)[lane & 15]; nIb = comb_inv_ptr(C, tB_)[lane & 15];
            const bf16_t* xa_ = XM + (size_t)tA_ * DM; const bf16_t* xb_ = XM + (size_t)tB_ * DM;
#pragma unroll
            for (int q = 0; q < 4; ++q) { nxa[q] = *(const u32x2*)(xa_ + q * 256 + lane * 4); nxb[q] = *(const u32x2*)(xb_ + q * 256 + lane * 4); } }
        comb_finish(C, l, tokA, lane, lat, ctxp, A, Lga, Lnw1, Lsc1, Lsh1);
        if (has2) comb_finish(C, l, tokB, lane, lat, ctxp, B, Lga, Lnw1, Lsc1, Lsh1);
        if (hasn) { A.myinv = nIa; B.myinv = nIb;
#pragma unroll
            for (int q = 0; q < 4; ++q) { A.x[q] = nxa[q]; B.x[q] = nxb[q]; } }
    }
#undef CB_TOK
#undef CB_LOAD
}

#ifdef DIAG
DI void diag_scan(const Ctx& C, int code, const void* ptr, size_t bytes, bool isbf) {
    const u32x4* p = (const u32x4*)ptr; const size_t n = bytes / 16; bool bad = false;
    for (size_t i = (size_t)C.bid * NTHR + C.tid; i < n; i += (size_t)C.G * NTHR) { const u32x4 v = p[i];
#pragma unroll
        for (int q = 0; q < 4; ++q) { const unsigned w = v[q];
            if (isbf) { const unsigned a = w & 0x7fffu, b = (w >> 16) & 0x7fffu; bad |= (a >= 0x5000u) || (b >= 0x5000u); }
            else bad |= ((w & 0x7fffffffu) >= 0x50000000u); } }
    if (__any(bad) && C.lane == 0) atomicAdd((int*)(C.ws + OFF_CNT) + 64 + code, 1);
}
DI void diag_maxexp(const Ctx& C, int code, const void* ptr, size_t bytes) {
    const u32x4* p = (const u32x4*)ptr; const size_t n = bytes / 16; unsigned mx = 0; int nb = 0;
    for (size_t i = (size_t)C.bid * NTHR + C.tid; i < n; i += (size_t)C.G * NTHR) { const u32x4 v = p[i]; unsigned m = 0;
#pragma unroll
        for (int q = 0; q < 4; ++q) { const unsigned w = v[q]; const unsigned a = (w >> 7) & 0xffu, b = (w >> 23) & 0xffu; m = m > a ? m : a; m = m > b ? m : b; }
        mx = mx > m ? mx : m; nb += (m >= 160u); }
    atomicMax((int*)(C.ws + OFF_CNT) + 64 + code, (int)mx); if (nb) atomicAdd((int*)(C.ws + OFF_CNT) + 64 + code + 1, nb);
}
DI void diag_out(const Ctx& C) {
    const int* cnts = (const int*)(C.ws + OFF_CNT) + 64; int first = -1;
    for (int i = 0; i < 40; ++i) { const int v = __hip_atomic_load(cnts + i, __ATOMIC_RELAXED, __HIP_MEMORY_SCOPE_AGENT); if (v != 0 && first < 0) first = i; }
#ifdef DIAG_VAL
    const float K = 1000.f * (1.f + (float)__hip_atomic_load(cnts + DIAG_VAL, __ATOMIC_RELAXED, __HIP_MEMORY_SCOPE_AGENT));
#elif defined(DIAG_SEL)
    int mask = 0; for (int i = 0; i < 4; ++i) if (__hip_atomic_load(cnts + DIAG_SEL + i, __ATOMIC_RELAXED, __HIP_MEMORY_SCOPE_AGENT) != 0) mask |= 1 << i;
    const float K = 1000.f * (float)(1 + mask);
#else
    const float K = (first < 0) ? 1000.f : 1000.f * exp2f((float)(first + 1));
#endif
    const size_t n = (size_t)NBATCH * SEQ * DM / 4;
    for (size_t i = (size_t)C.bid * NTHR + C.tid; i < n; i += (size_t)C.G * NTHR) { const f32x4 v = ((const f32x4*)C.in[0])[i]; ((f32x4*)C.out)[i] = v * K; }
}
#define DSCAN(code, ptr, bytes, isbf) diag_scan(C, code, ptr, bytes, isbf)
#else
#define DSCAN(code, ptr, bytes, isbf) do {} while (0)
#endif

#ifdef PHASE_TEST
#define MKCTX() extern __shared__ __attribute__((aligned(16))) unsigned char smem[]; Ctx C; C.in = prm.in; C.out = prm.out; C.ws = prm.ws; C.G = gridDim.x; C.bid = blockIdx.x; C.tid = threadIdx.x; \
    C.wave = __builtin_amdgcn_readfirstlane(threadIdx.x >> 6); C.lane = threadIdx.x & 63; C.lds = (LAS unsigned char*)smem;
__global__ void __launch_bounds__(NTHR, 2) t_mod(Params prm) { MKCTX(); phase_mod(C); }
__global__ void __launch_bounds__(NTHR, 2) t_wconv(Params prm) { MKCTX(); phase_wconv_small(C); phase_wconv_experts(C, 1); }
__global__ void __launch_bounds__(NTHR, 2) t_u(Params prm) { MKCTX(); phase_u(C, 0, C.in[0], C.in[2]); }
__global__ void __launch_bounds__(NTHR, 2) t_gemm_bf(Params prm) { MKCTX(); pg8::Gemm g{C.act(), C.wsm(0, WSM_WIN), DM, DM, DM, nullptr}; pg8::Sched S; S.init(T / 256, NPC / 256, C.G, C.bid, 0); pg8::EpiBf16 E{C.pbuf(), NPC}; pg8::gemm_phase(C.lds, g, S, E, C.tid); }
__global__ void __launch_bounds__(NTHR, 2) t_gemm_res(Params prm) { MKCTX(); pg8::Gemm g{C.act(), C.wsm(0, WSM_WOUT), DM, DM, DM, nullptr}; pg8::Sched S; S.init(128, 4, C.G, C.bid, 1); pg8::EpiResid E{C.in[0], C.in[2], C.out, C.xc(), C.modv(0)}; pg8::gemm_phase(C.lds, g, S, E, C.tid); }
__global__ void __launch_bounds__(NTHR, 2) t_gemm_sw(Params prm) { MKCTX(); pg8::Gemm g{C.act(), C.wsm(0, WSM_WOUT), DM, DM, DM, nullptr}; pg8::Sched S; S.init(272, 8, C.G, C.bid, 2); pg8::EpiSwiglu E{C.pbuf(), DM}; pg8::gemm_phase(C.lds, g, S, E, C.tid); }
__global__ void __launch_bounds__(NTHR, 2) t_gemm_gate(Params prm) { MKCTX(); pg8::Gemm g{C.act(), C.wsm(0, WSM_WOUT), DM, DM, DM, nullptr}; pg8::Sched S; S.init(272, 4, C.G, C.bid, 2); pg8::EpiGate E{C.pbuf(), DM, (const float*)(C.ws + OFF_GATE)}; pg8::gemm_phase(C.lds, g, S, E, C.tid); }
__global__ void __launch_bounds__(NTHR, 2) t_rwkv_prep(Params prm) { MKCTX(); phase_rwkv_prep(C, 0, 1 << 20); }
__global__ void __launch_bounds__(NTHR, 2) t_ret_prep(Params prm) { MKCTX(); phase_ret_prep(C); }
__global__ void __launch_bounds__(NTHR, 2) t_qk(Params prm) { MKCTX(); phase_qk_final(C, 0); }
__global__ void __launch_bounds__(NTHR, 2) t_attn(Params prm) { MKCTX(); att::attn_body(C.qkv(), C.kf(), C.qkv(), C.pbuf(), SB, (LAS char*)C.lds, C.tid, -16.f); }
__global__ void __launch_bounds__(NTHR, 2) t_rwkv(Params prm) { MKCTX(); rwkv_scan_item(C, 0, 1, C.bid & 1, 0); }
__global__ void __launch_bounds__(NTHR, 2) t_rwkvc(Params prm) { MKCTX(); rwkv_chunk_item(C, 0, 1, C.bid & 1); }
__global__ void __launch_bounds__(NTHR, 2) t_ret(Params prm) { MKCTX(); retention_item(C, 0, 0, 1, C.bid & 1); }
__global__ void __launch_bounds__(NTHR, 2) t_finish(Params prm) { MKCTX(); phase_finish(C, 0); }
__global__ void __launch_bounds__(NTHR, 2) t_router(Params prm) { MKCTX(); phase_h_router(C, 0, C.out, C.xc()); }
__global__ void __launch_bounds__(NTHR, 2) t_select(Params prm) { MKCTX(); phase_select(C, 0); }
__global__ void __launch_bounds__(NTHR, 2) t_combine(Params prm) { MKCTX(); phase_combine(C, 0, C.out, C.xc()); }
#endif

__global__ void __launch_bounds__(NTHR, 2) hybrid_fwd(Params prm) {
    extern __shared__ __attribute__((aligned(16))) unsigned char smem[];
    cg::grid_group grid = cg::this_grid();
    Ctx C; C.in = prm.in; C.out = prm.out; C.ws = prm.ws; C.G = gridDim.x; C.bid = blockIdx.x; C.tid = threadIdx.x;
    C.wave = __builtin_amdgcn_readfirstlane(threadIdx.x >> 6); C.lane = threadIdx.x & 63; C.lds = (LAS unsigned char*)smem;
#define CG_SYNC() do { asm volatile("s_waitcnt vmcnt(0) lgkmcnt(0)" ::: "memory"); __syncthreads(); grid.sync(); asm volatile("s_waitcnt vmcnt(0)" ::: "memory"); __syncthreads(); PH(); } while (0)
#ifdef DIAG_TS
#define TSTAMP() do { if (blockIdx.x == 0 && threadIdx.x == 0) { ((unsigned long long*)(C.ws + OFF_CNT + 4096))[ts_n] = __builtin_amdgcn_s_memrealtime(); } ++ts_n; } while (0)
#else
#define TSTAMP() do {} while (0)
#endif
#define GRID_SYNC() do { XcdBarrier xb_; xb_.bar = (unsigned*)(C.ws + OFF_BAR); xb_.x = xb_xcc_id(); xb_.st = (volatile LAS unsigned*)(smem + LDS_BYTES - 32); xcd_barrier(xb_); TSTAMP(); PH(); } while (0)
#define GRID_SYNC_NP() do { XcdBarrier xb_; xb_.bar = (unsigned*)(C.ws + OFF_BAR); xb_.x = xb_xcc_id(); xb_.st = (volatile LAS unsigned*)(smem + LDS_BYTES - 32); xcd_barrier(xb_); TSTAMP(); } while (0)
#define PH() do { asm volatile("" : "+v"(C.tid)); C.lane = C.tid & 63; C.wave = __builtin_amdgcn_readfirstlane(C.tid >> 6); } while (0)
    { volatile LAS unsigned* st = (volatile LAS unsigned*)(smem + LDS_BYTES - 32); if (threadIdx.x == 0) { st[0] = 0u; st[1] = 0u; } __syncthreads(); }
    (void)xcd_barrier_post((unsigned*)(C.ws + OFF_BAR), (volatile LAS unsigned*)(smem + LDS_BYTES - 32));
    int ts_n = 0; TSTAMP();
#ifdef DIAG_TS
    if (C.tid == 0) atomicMax(((unsigned long long*)(C.ws + OFF_CNT + 4096)) + 54, (unsigned long long)__builtin_amdgcn_s_memrealtime());
#endif
    PH();
    phase_p0(C);
#ifdef DIAG_TS
    if (C.bid == DIAG_BLK && C.tid == 0) ((unsigned long long*)(C.ws + OFF_CNT + 4096))[50] = __builtin_amdgcn_s_memrealtime();
#endif
    PH();
    phase_rope_tables(C);
#ifdef DIAG_TS
    if (C.bid == DIAG_BLK && C.tid == 0) ((unsigned long long*)(C.ws + OFF_CNT + 4096))[51] = __builtin_amdgcn_s_memrealtime();
#endif
    if (prm.pad != 0) { CG_SYNC(); }
    GRID_SYNC();
    DSCAN(0, C.ws + OFF_MOD, 2 * 9 * 6144 * 4, false); DSCAN(1, C.ws + OFF_WSM, 2 * WSM_STRIDE, true);
#pragma unroll 1
    for (int l = 0; l < 2; ++l) {
#define xl_in ((l == 0) ? C.in[0] : C.out)
#define xc_in ((l == 0) ? C.in[2] : C.xc())
        if (l == 0) { phase_u(C, 0, xl_in, xc_in); GRID_SYNC(); }
        DSCAN(2 + l * 16 + 0, C.act(), (size_t)T * DM * 2, true);
        { pg8::Gemm g{C.act(), C.wsm(l, WSM_WIN), DM, DM, DM, nullptr}; pg8::Sched S; S.init(T / 256, NPC / 256, C.G, C.bid, 0);
          pg8::EpiBf16 E{C.pbuf(), NPC}; pg8::gemm_phase(C.lds, g, S, E, C.tid); }
        GRID_SYNC();
        DSCAN(2 + l * 16 + 1, C.pbuf(), (size_t)T * NPC * 2, true);
        if ((C.bid >> 3) & 1) { PH(); phase_rwkv_prep(C, l, 2); PH(); }
        { pg8::Gemm g{C.pbuf(), C.wsm(l, WSM_WQKV), NPC, 640, 384, nullptr}; pg8::Sched S; S.init(T / 256, 3, C.G, C.bid, 0);
          pg8::EpiBf16 E{C.qkv(), QKVC}; pg8::gemm_phase(C.lds, g, S, E, C.tid); }
        PH();
        { pg8::Gemm g{C.pbuf() + 384, C.wsm(l, WSM_WQKV) + (size_t)768 * 640 + 384, NPC, 640, 256, nullptr}; pg8::Sched S;
          S.init(T / 256, 4, C.G, (C.G == 256) ? ((C.bid + 104) & 255) : C.bid, 0);
          pg8::EpiBf16 E{C.qkv() + 768, QKVC}; pg8::gemm_phase(C.lds, g, S, E, C.tid); }
#ifdef DIAG_TS
        if (l == 0 && C.bid == DIAG_BLK && C.tid == 0) ((unsigned long long*)(C.ws + OFF_CNT + 4096))[41] = __builtin_amdgcn_s_memrealtime();
#endif
        PH();
        phase_rwkv_prep(C, l, 1 << 20);
        GRID_SYNC();
        DSCAN(2 + l * 16 + 2, C.qkv(), (size_t)T * QKVC * 2, true); DSCAN(2 + l * 16 + 3, C.ops(0), 4 * OPS_STRIDE, true); if (l == 0) { DSCAN(40, C.ops(0), OPS_STRIDE, true); DSCAN(41, C.ops(1), OPS_STRIDE, true); DSCAN(42, C.ops(2), OPS_STRIDE, true); DSCAN(43, C.ops(3), OPS_STRIDE, true); } DSCAN(2 + l * 16 + 4, C.act(), (size_t)T * DM * 2, true);
        phase_qk_final(C, l);
        float negM;
        { float gqm = 0.f, gkm = 0.f;
          for (int i = 0; i < 96; ++i) { gqm = fmaxf(gqm, fabsf(C.in[13][l * 96 + i])); gkm = fmaxf(gkm, fabsf(C.in[14][l * 96 + i])); }
          negM = -(96.f * 0.10206207261596577f * 1.4426950408889634f) * gqm * gkm; }
        GRID_SYNC();
        DSCAN(2 + l * 16 + 5, C.qkv(), (size_t)T * QKVC * 2, true); DSCAN(2 + l * 16 + 6, C.kf(), (size_t)T * 768 * 2, true); DSCAN(2 + l * 16 + 7, C.pbuf(), (size_t)T * NPC * 2, true);
        phase_mixers(C, l, negM);
        GRID_SYNC();
        if (l == 0) DSCAN(2 + l * 16 + 8, C.pbuf(), (size_t)T * NPC * 2, true);
        phase_finish(C, l);
        GRID_SYNC();
        if (l == 0) DSCAN(2 + l * 16 + 9, C.act(), (size_t)T * DM * 2, true);
        { pg8::Gemm g{C.pbuf(), C.wsm(l, WSM_WOUT), NPC, DM, DM, nullptr}; pg8::Sched S;
          if (l == 0) S.init(T / 256, 4, C.G, C.bid, 0); else S.init(128, 4, C.G, C.bid, 1);
          pg8::EpiResid E{xl_in, xc_in, (bf16_t*)(C.ws + OFF_ARENA + AR_XMID), C.modv(l)}; pg8::gemm_phase(C.lds, g, S, E, C.tid); }
        if (l == 0) {
            PH(); LAS int* slot = (LAS int*)(C.lds + LDS_BYTES - 16); bool have_sl = false;
            for (;;) { __syncthreads(); if (C.tid == 0) *slot = atomicAdd(C.cnt() + 18, 1); __syncthreads();
                const int it = *slot;
                if (it < 96) { mod_item(C, 96 + it, !have_sl); have_sl = true; continue; }
                const int bt = P0_NB + it - 96; if (bt >= P0_NBALL) break;
                tconv_range8(C, bt * 8); } }
        PH();
        phase_h_router(C, l, C.out, C.xc(), [&]() { GRID_SYNC_NP(); });
        PH();
        GRID_SYNC();
        DSCAN(2 + l * 16 + 11, C.ws + OFF_AFFL, 2 * MiB, false);
        phase_select(C, l);
        GRID_SYNC();
        DSCAN(2 + l * 16 + 12, C.ws + OFF_ARENA + AR_WGU, 96 * MiB, true); DSCAN(2 + l * 16 + 13, C.ws + OFF_ARENA + AR_XE, (size_t)(l == 0 ? XE_ROWS : XE_LROWS) * DM * 2, true);
        { pg8::Gemm g{C.act(), (const bf16_t*)(C.ws + OFF_WGU2), DM, DM, DM, (const int*)(C.ws + OFF_IDX)}; pg8::Sched S;
          S.init(l == 0 ? 272 : 256, 8, C.G, C.bid, 2);
          pg8::EpiSwiglu E{(bf16_t*)(C.ws + OFF_ARENA + AR_HID), DM}; pg8::gemm_phase<pg8::EpiSwiglu, true, true, true>(C.lds, g, S, E, C.tid); }
        if (l == 0) { PH(); phase_wconv_experts(C, 0); }
        GRID_SYNC();
        DSCAN(2 + l * 16 + 14, C.ws + OFF_ARENA + AR_HID, (size_t)(l == 0 ? XE_ROWS : XE_LROWS) * DM * 2, true);
        { pg8::Gemm g{(const bf16_t*)(C.ws + OFF_ARENA + AR_HID), (const bf16_t*)(C.ws + OFF_ARENA + AR_WD), DM, DM, DM, nullptr}; pg8::Sched S;
          S.init(l == 0 ? 272 : 256, 4, C.G, C.bid, 2);
          pg8::EpiGate E{(bf16_t*)(C.ws + OFF_ARENA + AR_XE), DM, (const float*)(C.ws + OFF_GATE)}; pg8::gemm_phase(C.lds, g, S, E, C.tid); }
        PH();
        phase_combine(C, l, C.out, C.xc(), [&]() { GRID_SYNC_NP(); });
        PH();
        if (l == 0) GRID_SYNC(); else { TSTAMP(); }
        DSCAN(2 + l * 16 + 15, C.out, (size_t)NBATCH * SEQ * DM * 4, false);
    }
#ifdef DIAG
    GRID_SYNC();
    diag_out(C);
#endif
#ifdef DIAG_TS
    if (blockIdx.x == 0 && threadIdx.x == 0) { const unsigned long long* ts = (const unsigned long long*)(C.ws + OFF_CNT + 4096);
        const float tot = (float)(ts[ts_n - 1] - ts[0]); const float part = (float)(ts[DIAG_TS_B] - ts[DIAG_TS_A]);
#ifndef DIAG_TS_SCALE
#define DIAG_TS_SCALE 1.f
#endif
        C.out[0] += 1.f + 29.f * fminf(1.f, DIAG_TS_SCALE * part / tot); }
#endif
}

extern "C" void kernel_launch(void* const* d_in, const int* in_sizes, int n_in, void* d_out, int out_size, void* d_ws, size_t ws_size, hipStream_t stream) {
    static int grid = 0;
    if (grid == 0) {
        int dev = 0, cus = 0, per_cu = 0;
        (void)hipGetDevice(&dev); (void)hipDeviceGetAttribute(&cus, hipDeviceAttributeMultiprocessorCount, dev);
        if (hipFuncSetAttribute((const void*)hybrid_fwd, hipFuncAttributeMaxDynamicSharedMemorySize, LDS_BYTES) != hipSuccess) { fprintf(stderr, "kernel_launch: hipFuncSetAttribute failed\n"); grid = -1; return; }
        if (hipOccupancyMaxActiveBlocksPerMultiprocessor(&per_cu, (const void*)hybrid_fwd, NTHR, LDS_BYTES) != hipSuccess || per_cu < 1) { fprintf(stderr, "kernel_launch: occupancy query gives %d\n", per_cu); grid = -1; return; }
        if (n_in != 32 || ws_size < WS_END) { fprintf(stderr, "kernel_launch: n_in %d ws %zu (need %zu)\n", n_in, ws_size, (size_t)WS_END); grid = -1; return; }
        grid = cus;
    }
    if (grid < 0) return;
    (void)hipMemsetAsync((char*)d_ws + OFF_BAR, 0, 65536, stream);
    Params p{}; for (int i = 0; i < 32; ++i) p.in[i] = (const float*)d_in[i];
    p.out = (float*)d_out; p.ws = (unsigned char*)d_ws; p.G = grid; p.pad = 0;
    void* args[] = {&p};
    hipError_t e = hipLaunchCooperativeKernel((const void*)hybrid_fwd, dim3(grid), dim3(NTHR), args, LDS_BYTES, stream);
    if (e != hipSuccess) fprintf(stderr, "cooperative launch failed: %s (grid %d)\n", hipGetErrorString(e), grid);
}
```
